# Optimizing an MI355X kernel written in HIP

```python
import math
import jax, jax.numpy as jnp
from jax import lax
import numpy as np

D_MODEL = 2048
BATCH = 2
SEQ = 8192
DEPTH = 2

N_Q_HEADS = 8
N_KV_HEADS = 2
HEAD_DIM = 128
Q_PER_KV = N_Q_HEADS // N_KV_HEADS
WINDOW = 128
ATTN_BLOCK = 128
ATTN_W = N_Q_HEADS * HEAD_DIM
KV_W = N_KV_HEADS * HEAD_DIM

SG_GROUPS = 4
SG_CHUNK = 128
SG_GROUP_CH = 128
SG_W = SG_GROUPS * SG_GROUP_CH

SSM_GROUP_CH = 16
SSM_GROUPS = 32
SSM_W = SSM_GROUPS * SSM_GROUP_CH
SSM_STATE = 64
DT_MIN = 0.001
DT_MAX = 0.1

N_BRANCH = 3
GATE_W = N_BRANCH * D_MODEL
SPLIT_POINTS = (
    ATTN_W,
    ATTN_W + KV_W,
    ATTN_W + 2 * KV_W,
    ATTN_W + 2 * KV_W + SG_W,
    ATTN_W + 2 * KV_W + 2 * SG_W,
    ATTN_W + 2 * KV_W + 2 * SG_W + SSM_W,
)
IN_W = SPLIT_POINTS[-1] + GATE_W

D_FF = 5632
CONV_W = 3
EPS = 1e-6

kernel_name = "hybrid_swa_gmlp_s5_convffn"


def rms_norm(x, g):
    xf = x.astype(jnp.float32)
    y = xf * lax.rsqrt(jnp.mean(xf * xf, axis=-1, keepdims=True) + EPS)
    return (y * g.astype(jnp.float32)).astype(x.dtype)


def layer_norm(x, g, b):
    xf = x.astype(jnp.float32)
    xc = xf - jnp.mean(xf, axis=-1, keepdims=True)
    var = jnp.mean(xc * xc, axis=-1, keepdims=True)
    y = xc * lax.rsqrt(var + EPS) * g.astype(jnp.float32) + b.astype(jnp.float32)
    return y.astype(x.dtype)


def alibi_slopes():
    return 2.0 ** (-8.0 * jnp.arange(1, N_Q_HEADS + 1, dtype=jnp.float32) / N_Q_HEADS)


def _with_prev_block(t):
    prev = jnp.pad(t, ((0, 0), (1, 0), (0, 0), (0, 0), (0, 0)))[:, :-1]
    return jnp.concatenate([prev, t], axis=2)


def sliding_window_attention(q, k, v, q_gain, k_gain, sinks):
    B, L = q.shape[0], q.shape[1]
    nb = L // ATTN_BLOCK
    q = rms_norm(q.reshape(B, nb, ATTN_BLOCK, N_KV_HEADS, Q_PER_KV, HEAD_DIM), q_gain)
    k = rms_norm(k.reshape(B, nb, ATTN_BLOCK, N_KV_HEADS, HEAD_DIM), k_gain)
    v = v.reshape(B, nb, ATTN_BLOCK, N_KV_HEADS, HEAD_DIM)
    kw = _with_prev_block(k)
    vw = _with_prev_block(v)
    s = jnp.einsum("bnqhgd,bnkhd->bhgnqk", q, kw,
                   preferred_element_type=jnp.float32) * (HEAD_DIM ** -0.5)
    q_idx = jnp.arange(ATTN_BLOCK) + ATTN_BLOCK
    k_idx = jnp.arange(2 * ATTN_BLOCK)
    dist = q_idx[:, None] - k_idx[None, :]
    k_abs = jnp.arange(nb)[:, None] * ATTN_BLOCK + k_idx[None, :] - ATTN_BLOCK
    valid = ((dist >= 0) & (dist < WINDOW))[None] & (k_abs >= 0)[:, None, :]
    slopes = alibi_slopes().reshape(N_KV_HEADS, Q_PER_KV, 1, 1, 1)
    s = s - slopes * dist.astype(jnp.float32)
    s = jnp.where(valid, s, -jnp.inf)
    sink = sinks.astype(jnp.float32).reshape(N_KV_HEADS, Q_PER_KV, 1, 1, 1)
    m = jnp.maximum(jnp.max(s, axis=-1, keepdims=True), sink)
    p = jnp.exp(s - m)
    probs = p / (jnp.sum(p, axis=-1, keepdims=True) + jnp.exp(sink - m))
    o = jnp.einsum("bhgnqk,bnkhd->bnqhgd", probs.astype(vw.dtype), vw)
    return o.reshape(B, L, ATTN_W)


def spatial_gating(z_u, z_v, ln_g, ln_b, w_s, b_s):
    B, L = z_u.shape[0], z_u.shape[1]
    nc = L // SG_CHUNK
    zv = layer_norm(z_v.reshape(B, nc, SG_CHUNK, SG_GROUPS, SG_GROUP_CH), ln_g, ln_b)
    w = w_s * jnp.tril(jnp.ones((SG_CHUNK, SG_CHUNK), dtype=w_s.dtype))
    mixed = jnp.einsum("gts,bnsgc->bntgc", w, zv) + b_s.T[:, :, None]
    return z_u * mixed.reshape(B, L, SG_W)


def s5_glu(u, a_re, a_im, log_dt, b_re, b_im, c_re, c_im, d_skip, w_glu, b_glu):
    B, L = u.shape[0], u.shape[1]
    f32 = jnp.float32
    uf = u.astype(f32).reshape(B, L, SSM_GROUPS, SSM_GROUP_CH)
    lam = lax.complex(a_re.astype(f32), a_im.astype(f32))
    dt = jnp.exp(log_dt.astype(f32))[:, None]
    a_bar = jnp.exp(lam * dt)
    b_mat = lax.complex(b_re.astype(f32), b_im.astype(f32))
    b_bar = ((a_bar - 1.0) / lam)[..., None] * b_mat
    bu = jnp.einsum("gpc,blgc->blgp", b_bar, uf.astype(jnp.complex64))
    a_seq = jnp.broadcast_to(a_bar, bu.shape)

    def combine(left, right):
        a1, x1 = left
        a2, x2 = right
        return a1 * a2, a2 * x1 + x2

    _, h = lax.associative_scan(combine, (a_seq, bu), axis=1)
    c_mat = lax.complex(c_re.astype(f32), c_im.astype(f32))
    y = jnp.real(jnp.einsum("gcp,blgp->blgc", c_mat, h))
    y = y + d_skip.astype(f32).reshape(SSM_GROUPS, SSM_GROUP_CH) * uf
    y = jax.nn.gelu(y.reshape(B, L, SSM_W))
    out = y * jax.nn.sigmoid(y @ w_glu.astype(f32) + b_glu.astype(f32))
    return out.astype(u.dtype)


def conv_ffn(h, w_up, conv_w, conv_b, w_down):
    L = h.shape[1]
    up = h @ w_up
    up_pad = jnp.pad(up, ((0, 0), (CONV_W - 1, 0), (0, 0)))
    conv = conv_b + conv_w[0] * up
    for lag in range(1, CONV_W):
        conv = conv + conv_w[lag] * up_pad[:, CONV_W - 1 - lag:CONV_W - 1 - lag + L]
    gate, val = jnp.split(conv, 2, axis=-1)
    return (jax.nn.gelu(gate) * val) @ w_down


def setup_inputs(seed: int = 0) -> dict:
    key = jax.random.key(seed)
    ks = jax.random.split(key, 32)
    f32 = jnp.float32

    def nrm(k, shape, scale):
        return scale * jax.random.normal(k, shape, f32)

    def gain(k, shape):
        return 1.0 + 0.02 * jax.random.normal(k, shape, f32)

    P = SSM_STATE
    n_idx = jnp.arange(P, dtype=f32)
    return {
        "x": nrm(ks[0], (BATCH, SEQ, D_MODEL), 1.0),
        "norm1_g": gain(ks[1], (DEPTH, D_MODEL)),
        "w_in": nrm(ks[2], (DEPTH, D_MODEL, IN_W), D_MODEL ** -0.5),
        "b_gate": nrm(ks[3], (DEPTH, GATE_W), 0.02),
        "q_norm_g": gain(ks[4], (DEPTH, HEAD_DIM)),
        "k_norm_g": gain(ks[5], (DEPTH, HEAD_DIM)),
        "attn_sinks": nrm(ks[6], (DEPTH, N_Q_HEADS), 0.5),
        "sg_ln_g": gain(ks[7], (DEPTH, SG_GROUPS, SG_GROUP_CH)),
        "sg_ln_b": nrm(ks[8], (DEPTH, SG_GROUPS, SG_GROUP_CH), 0.02),
        "sg_w": nrm(ks[9], (DEPTH, SG_GROUPS, SG_CHUNK, SG_CHUNK), 0.5 * SG_CHUNK ** -0.5),
        "sg_b": 1.0 + nrm(ks[10], (DEPTH, SG_GROUPS, SG_CHUNK), 0.02),
        "ssm_a_re": -0.5 + nrm(ks[11], (DEPTH, SSM_GROUPS, P), 0.01),
        "ssm_a_im": jnp.pi * n_idx + nrm(ks[12], (DEPTH, SSM_GROUPS, P), 0.01),
        "ssm_log_dt": jax.random.uniform(ks[13], (DEPTH, SSM_GROUPS), f32,
                                         math.log(DT_MIN), math.log(DT_MAX)),
        "ssm_b_re": nrm(ks[14], (DEPTH, SSM_GROUPS, P, SSM_GROUP_CH), (2 * SSM_GROUP_CH) ** -0.5),
        "ssm_b_im": nrm(ks[15], (DEPTH, SSM_GROUPS, P, SSM_GROUP_CH), (2 * SSM_GROUP_CH) ** -0.5),
        "ssm_c_re": nrm(ks[16], (DEPTH, SSM_GROUPS, SSM_GROUP_CH, P), (2 * P) ** -0.5),
        "ssm_c_im": nrm(ks[17], (DEPTH, SSM_GROUPS, SSM_GROUP_CH, P), (2 * P) ** -0.5),
        "ssm_d": nrm(ks[18], (DEPTH, SSM_W), 0.5),
        "ssm_w_glu": nrm(ks[19], (DEPTH, SSM_W, SSM_W), SSM_W ** -0.5),
        "ssm_b_glu": nrm(ks[20], (DEPTH, SSM_W), 0.02),
        "w_proj_attn": nrm(ks[21], (DEPTH, ATTN_W, D_MODEL), ATTN_W ** -0.5),
        "w_proj_sg": nrm(ks[22], (DEPTH, SG_W, D_MODEL), SG_W ** -0.5),
        "w_proj_ssm": nrm(ks[23], (DEPTH, SSM_W, D_MODEL), SSM_W ** -0.5),
        "w_out": nrm(ks[24], (DEPTH, D_MODEL, D_MODEL), D_MODEL ** -0.5),
        "norm2_g": gain(ks[25], (DEPTH, D_MODEL)),
        "ffn_w_up": nrm(ks[26], (DEPTH, D_MODEL, 2 * D_FF), D_MODEL ** -0.5),
        "ffn_conv_w": nrm(ks[27], (DEPTH, CONV_W, 2 * D_FF), CONV_W ** -0.5),
        "ffn_conv_b": nrm(ks[28], (DEPTH, 2 * D_FF), 0.02),
        "ffn_w_down": nrm(ks[29], (DEPTH, D_FF, D_MODEL), D_FF ** -0.5),
    }


def reference(x, norm1_g, w_in, b_gate, q_norm_g, k_norm_g, attn_sinks, sg_ln_g, sg_ln_b,
              sg_w, sg_b, ssm_a_re, ssm_a_im, ssm_log_dt, ssm_b_re, ssm_b_im, ssm_c_re,
              ssm_c_im, ssm_d, ssm_w_glu, ssm_b_glu, w_proj_attn, w_proj_sg, w_proj_ssm,
              w_out, norm2_g, ffn_w_up, ffn_conv_w, ffn_conv_b, ffn_w_down):
    B, L = x.shape[0], x.shape[1]
    for l in range(DEPTH):
        h = rms_norm(x, norm1_g[l])
        proj = h @ w_in[l]
        q, k, v, sg_u, sg_v, s_in, gates = jnp.split(proj, SPLIT_POINTS, axis=-1)
        y_attn = sliding_window_attention(q, k, v, q_norm_g[l], k_norm_g[l], attn_sinks[l])
        y_sg = spatial_gating(jax.nn.gelu(sg_u), jax.nn.gelu(sg_v),
                              sg_ln_g[l], sg_ln_b[l], sg_w[l], sg_b[l])
        y_ssm = s5_glu(s_in, ssm_a_re[l], ssm_a_im[l], ssm_log_dt[l], ssm_b_re[l], ssm_b_im[l],
                       ssm_c_re[l], ssm_c_im[l], ssm_d[l], ssm_w_glu[l], ssm_b_glu[l])
        g = jax.nn.sigmoid(gates + b_gate[l]).reshape(B, L, N_BRANCH, D_MODEL)
        merged = (g[:, :, 0] * (y_attn @ w_proj_attn[l])
                  + g[:, :, 1] * (y_sg @ w_proj_sg[l])
                  + g[:, :, 2] * (y_ssm @ w_proj_ssm[l]))
        x = x + merged @ w_out[l]
        x = x + conv_ffn(rms_norm(x, norm2_g[l]), ffn_w_up[l], ffn_conv_w[l],
                         ffn_conv_b[l], ffn_w_down[l])
    return x
```

```cpp
#include <hip/hip_runtime.h>
#include <hip/hip_cooperative_groups.h>
#include <cstdio>
#include <cstdint>
#include <cmath>
namespace cg = cooperative_groups;
#ifndef REP_CONVERT
#define REP_CONVERT 1
#endif
#ifndef REP_SSM
#define REP_SSM 1
#endif
#ifndef REP_ATT
#define REP_ATT 1
#endif
#ifndef MK_MULTI
#define MK_MULTI 0
#endif
namespace pg8 {
#define PG8_LAS __attribute__((address_space(3)))
typedef unsigned short bf16_t;
typedef short bf16x8 __attribute__((ext_vector_type(8)));
typedef float f32x4 __attribute__((ext_vector_type(4)));
typedef unsigned u32x4 __attribute__((ext_vector_type(4)));
constexpr int BM = 256, BK = 64, HALF = 128, HTB = HALF * BK * 2  , STAGE_BYTES = 8 * HTB, NXCD = 8, WGM = 8;

__host__ __device__ __forceinline__ int lds_byte(int r, int c) { const int st = (r >> 4) * 2 + (c >> 5), rr = r & 15, cc = c & 31, ob = rr * 64 + cc * 2; return st * 1024 + (ob ^ (((ob >> 9) & 1) << 5)); }
__host__ __device__ __forceinline__ void stage_rc(int b, int& R, int& C) { const int st = b / 1024, sb = b % 1024, swz = sb ^ (((sb >> 9) & 1) << 5); R = (st >> 1) * 16 + swz / 64; C = (st & 1) * 32 + (swz % 64) / 2; }
__host__ __device__ __forceinline__ int perm32(int rho) { const int n = rho >> 4, i = rho & 15; return 8 * (i >> 2) + 4 * n + (i & 3); }

struct Unit { int pm, pn; };
struct Gemm { const bf16_t* A; const bf16_t* Bt; int M, N, K, lda; };

struct StaticOrder {
    int nM, nN, nwg, G, c;
    __host__ __device__ void init(int M, int N, int G_, int c_) { nM = M / BM; nN = N / BM; nwg = nM * nN; G = G_; c = c_; }
    __host__ __device__ bool next(int i, Unit& u) const {
        const long L = (long)i * G + c; if (L >= nwg) return false;
        int wgid = (int)L; { const int q = nwg / NXCD, r = nwg % NXCD, xcd = wgid % NXCD, off = wgid / NXCD; wgid = (xcd < r ? xcd * (q + 1) : r * (q + 1) + (xcd - r) * q) + off; }
        const int nig = WGM * nN, gid = wgid / nig, fm = gid * WGM, gsz = (nM - fm) < WGM ? (nM - fm) : WGM;
        u.pm = fm + ((wgid % nig) % gsz); u.pn = (wgid % nig) / gsz; return true;
    }
    __device__ __forceinline__ void a_ready(const Unit&) const {}
    __device__ __forceinline__ void done(const Unit&) const {}
};

__device__ __forceinline__ unsigned cvt_pk_bf16(float lo, float hi) { unsigned r; asm volatile("v_cvt_pk_bf16_f32 %0, %1, %2" : "=v"(r) : "v"(lo), "v"(hi)); return r; }
__device__ __forceinline__ float bf_lo(unsigned w) { return __uint_as_float(w << 16); }
__device__ __forceinline__ float bf_hi(unsigned w) { return __uint_as_float(w & 0xffff0000u); }
__device__ __forceinline__ float sigm(float x) { return __builtin_amdgcn_rcpf(1.f + __expf(-x)); }
__device__ __forceinline__ float gelu_t(float x) { const float p = __builtin_fmaf(x * x, -0.10294324f, -2.30220819f); return x * __builtin_amdgcn_rcpf(1.f + __builtin_amdgcn_exp2f(x * p)); }
__device__ __forceinline__ f32x4 sigm4(f32x4 v) { return (f32x4){sigm(v[0]), sigm(v[1]), sigm(v[2]), sigm(v[3])}; }
__device__ __forceinline__ f32x4 gelu4(f32x4 v) { return (f32x4){gelu_t(v[0]), gelu_t(v[1]), gelu_t(v[2]), gelu_t(v[3])}; }
__device__ __forceinline__ u32x4 pack8(f32x4 a, f32x4 b) { u32x4 w; w.x = cvt_pk_bf16(a[0], a[1]); w.y = cvt_pk_bf16(a[2], a[3]); w.z = cvt_pk_bf16(b[0], b[1]); w.w = cvt_pk_bf16(b[2], b[3]); return w; }
__device__ __forceinline__ void unpack8(u32x4 w, f32x4& a, f32x4& b) { a = (f32x4){bf_lo(w.x), bf_hi(w.x), bf_lo(w.y), bf_hi(w.y)}; b = (f32x4){bf_lo(w.z), bf_hi(w.z), bf_lo(w.w), bf_hi(w.w)}; }
enum { EP_INPROJ = 0, EP_GLU = 1, EP_MERGE0 = 2, EP_MERGE1 = 3, EP_RESID = 4, EP_RAW = 5, EP_UPCONV = 6 };
template <int CTRL> __device__ __forceinline__ float dpp_f(float x) { return __builtin_bit_cast(float, __builtin_amdgcn_update_dpp(0, __builtin_bit_cast(int, x), CTRL, 0xf, 0xf, false)); }
template <int CTRL> __device__ __forceinline__ f32x4 dpp4(f32x4 v) { return (f32x4){dpp_f<CTRL>(v[0]), dpp_f<CTRL>(v[1]), dpp_f<CTRL>(v[2]), dpp_f<CTRL>(v[3])}; }
template <int MODE> struct Epi {
    static constexpr bool PERM = true, AFTER_DRAIN = false;
    void* O; int ldc; const float* bias; const bf16_t* aux; int ldaux; const float* xin; float* raw; const float* ss; bf16_t* xb; float* ssout;
    __device__ __forceinline__ void operator()(const f32x4 (&acc)[2][2][4][2], const Unit& u, int wr, int wc, int fr, int fq) const {
        const int row0 = u.pm * BM + wr * 64 + fr, col0 = u.pn * BM + wc * 32 + 8 * fq;
        if constexpr (MODE == EP_UPCONV) {
            constexpr int NUPc = 11264, DFFc = 5632;
            const int cgl = u.pn * 128 + wc * 32 + 8 * fq, tcol = u.pn * 256 + wc * 32 + 8 * fq;
            float rs[2][4];
#pragma unroll
            for (int ai = 0; ai < 2; ++ai)
#pragma unroll
                for (int m = 0; m < 4; ++m) rs[ai][m] = rsqrtf(ss[row0 + ai * HALF + m * 16] * (1.f / 2048.f) + 1e-6f);
#pragma unroll
            for (int ai = 0; ai < 2; ++ai) {
                const int slab = u.pm * 4 + ai * 2 + wr;
                if (fr < 2) {
#pragma unroll
                    for (int bj = 0; bj < 2; ++bj)
#pragma unroll
                        for (int n = 0; n < 2; ++n) *(f32x4*)(raw + (size_t)(slab * 4 + fr) * NUPc + tcol + bj * 128 + 4 * n) = acc[ai][bj][0][n] * rs[ai][0];
                }
                if (fr >= 14) {
#pragma unroll
                    for (int bj = 0; bj < 2; ++bj)
#pragma unroll
                        for (int n = 0; n < 2; ++n) *(f32x4*)(raw + (size_t)(slab * 4 + fr - 12) * NUPc + tcol + bj * 128 + 4 * n) = acc[ai][bj][3][n] * rs[ai][3];
                }
            }
#pragma unroll
            for (int n = 0; n < 2; ++n) {
                const int c = cgl + 4 * n;
                const f32x4 wg0 = *(const f32x4*)(bias + c), wg1 = *(const f32x4*)(bias + NUPc + c), wg2 = *(const f32x4*)(bias + 2 * NUPc + c), bg = *(const f32x4*)(xin + c);
                const f32x4 wv0 = *(const f32x4*)(bias + DFFc + c), wv1 = *(const f32x4*)(bias + NUPc + DFFc + c), wv2 = *(const f32x4*)(bias + 2 * NUPc + DFFc + c), bv = *(const f32x4*)(xin + DFFc + c);
#pragma unroll
                for (int ai = 0; ai < 2; ++ai) {
                    f32x4 pg1 = (f32x4){0.f, 0.f, 0.f, 0.f}, pg2 = pg1, pv1 = pg1, pv2 = pg1;
#pragma unroll
                    for (int m = 0; m < 4; ++m) {
                        const f32x4 g = acc[ai][0][m][n] * rs[ai][m], v = acc[ai][1][m][n] * rs[ai][m];
                        const f32x4 g1 = dpp4<0x121>(g), g2 = dpp4<0x122>(g), v1 = dpp4<0x121>(v), v2 = dpp4<0x122>(v);
                        const f32x4 gp1 = (fr >= 1) ? g1 : pg1, gp2 = (fr >= 2) ? g2 : pg2, vp1 = (fr >= 1) ? v1 : pv1, vp2 = (fr >= 2) ? v2 : pv2;
                        const f32x4 cgt = bg + wg0 * g + wg1 * gp1 + wg2 * gp2, cvl = bv + wv0 * v + wv1 * vp1 + wv2 * vp2;
                        const f32x4 o = gelu4(cgt) * cvl;
                        typedef unsigned u32x2e __attribute__((ext_vector_type(2)));
                        u32x2e w; w.x = cvt_pk_bf16(o[0], o[1]); w.y = cvt_pk_bf16(o[2], o[3]);
                        if (!(m == 0 && fr < 2)) *(u32x2e*)((bf16_t*)O + (size_t)(row0 + ai * HALF + m * 16) * DFFc + c) = w;
                        pg1 = g1; pg2 = g2; pv1 = v1; pv2 = v2;
                    }
                }
            }
            return;
        }
        int kind = 0;
        if (MODE == EP_INPROJ) kind = (u.pn >= 12) ? 2 : ((u.pn >= 6 && u.pn < 10) ? 1 : 0);
        float rsr[2][4]; f32x4 cb0[2], cb1[2];
#pragma unroll
        for (int bj = 0; bj < 2; ++bj) { cb0[bj] = (f32x4){0.f, 0.f, 0.f, 0.f}; cb1[bj] = cb0[bj]; }
        if (MODE == EP_INPROJ) {
#pragma unroll
            for (int ai = 0; ai < 2; ++ai)
#pragma unroll
                for (int m = 0; m < 4; ++m) rsr[ai][m] = rsqrtf(ss[row0 + ai * HALF + m * 16] * (1.f / 2048.f) + 1e-6f);
            if (kind == 2) {
#pragma unroll
                for (int bj = 0; bj < 2; ++bj) { cb0[bj] = *(const f32x4*)(bias + (col0 + bj * HALF - 3072)); cb1[bj] = *(const f32x4*)(bias + (col0 + bj * HALF - 3072) + 4); }
            }
        }
        if (MODE == EP_GLU) {
#pragma unroll
            for (int bj = 0; bj < 2; ++bj) { cb0[bj] = *(const f32x4*)(bias + col0 + bj * HALF); cb1[bj] = *(const f32x4*)(bias + col0 + bj * HALF + 4); }
        }
#pragma unroll
        for (int ai = 0; ai < 2; ++ai)
#pragma unroll
            for (int m = 0; m < 4; ++m) {
                const size_t row = (size_t)(row0 + ai * HALF + m * 16);
                float ssq = 0.f;
#pragma unroll
                for (int bj = 0; bj < 2; ++bj) {
                    const int col = col0 + bj * HALF;
                    f32x4 v0 = acc[ai][bj][m][0], v1 = acc[ai][bj][m][1];
                    if (MODE == EP_INPROJ) {
                        const float rs = rsr[ai][m];
                        v0 = v0 * rs; v1 = v1 * rs;
                        if (kind == 1) { v0 = gelu4(v0); v1 = gelu4(v1); }
                        else if (kind == 2) { v0 = sigm4(v0 + cb0[bj]); v1 = sigm4(v1 + cb1[bj]); }
                        *(u32x4*)((bf16_t*)O + row * ldc + col) = pack8(v0, v1);
                    } else if (MODE == EP_GLU) {
                        f32x4 y0, y1; unpack8(*(const u32x4*)(aux + row * ldaux + col), y0, y1);
                        v0 = y0 * sigm4(v0 + cb0[bj]); v1 = y1 * sigm4(v1 + cb1[bj]);
                        *(u32x4*)((bf16_t*)O + row * ldc + col) = pack8(v0, v1);
                    } else if (MODE == EP_MERGE0 || MODE == EP_MERGE1) {
                        f32x4 g0, g1; unpack8(*(const u32x4*)(aux + row * ldaux + col), g0, g1);
                        v0 = g0 * v0; v1 = g1 * v1;
                        if (MODE == EP_MERGE1) { f32x4 o0, o1; unpack8(*(const u32x4*)((const bf16_t*)O + row * ldc + col), o0, o1); v0 = v0 + o0; v1 = v1 + o1; }
                        *(u32x4*)((bf16_t*)O + row * ldc + col) = pack8(v0, v1);
                    } else if (MODE == EP_RESID) {
                        f32x4 x0, x1; unpack8(*(const u32x4*)(xb + row * ldc + col), x0, x1); x0 = x0 + v0; x1 = x1 + v1;
                        if (O) { *(f32x4*)((float*)O + row * ldc + col) = x0; *(f32x4*)((float*)O + row * ldc + col + 4) = x1; }
                        if (ssout) {
                            *(u32x4*)(xb + row * ldc + col) = pack8(x0, x1);
                            const float q = (x0[0] * x0[0] + x0[1] * x0[1]) + (x0[2] * x0[2] + x0[3] * x0[3]) + (x1[0] * x1[0] + x1[1] * x1[1]) + (x1[2] * x1[2] + x1[3] * x1[3]);
                            if (bj == 0) ssq = q; else ssq += q;
                        }
                    } else {
                        *(u32x4*)((bf16_t*)O + row * ldc + col) = pack8(v0, v1);
                    }
                }
                if (MODE == EP_RESID) { if (ssout) { ssq += __shfl_xor(ssq, 16); ssq += __shfl_xor(ssq, 32); if (fq == 0) unsafeAtomicAdd(ssout + row, ssq); } }
                if (m == 3) asm volatile("" ::: "memory");
            }
    }
};
template <class Epi, class Sched, bool ALIGN_EPI = false, bool SP2 = false>
__device__ __forceinline__ void gemm_phase(PG8_LAS unsigned char* lds, const Gemm g, const Sched& S, const Epi& E, int wave_in) {
    int tid_ = wave_in * 64 + (int)__builtin_amdgcn_mbcnt_hi(~0u, __builtin_amdgcn_mbcnt_lo(~0u, 0u)); asm volatile("" : "+v"(tid_));
    const int tid = tid_, wid = __builtin_amdgcn_readfirstlane(tid >> 6), lane = tid & 63, wr = wid >> 2, wc = wid & 3, fr = lane & 15, fq = lane >> 4;
    const int K = g.K, nt = K / BK;
    unsigned voffA[2], voffB[2];
#pragma unroll
    for (int i = 0; i < 2; ++i) { int R, C; stage_rc(tid * 16 + i * 8192, R, C); const int Rb = Epi::PERM ? ((R & ~31) + perm32(R & 31)) : R;
        voffA[i] = (unsigned)(R * g.lda + C) * 2u; voffB[i] = (unsigned)(Rb * K + C) * 2u; }
    const size_t kstep = (size_t)(BK * 2);
    const size_t hstep = (size_t)HALF * K * 2;
    const size_t tstep = 2 * hstep; const size_t hstepA = (size_t)HALF * g.lda * 2, tstepA = 2 * hstepA;
    const unsigned ldsw = (unsigned)wid * 1024u;
    const int aoff = lds_byte(wr * 64 + fr, fq * 8), boff = lds_byte(wc * 32 + fr, fq * 8);
#define PG8_SA(b, h) (((b) * 2 + (h)) * HTB)
#define PG8_SB(b, h) ((4 + (b) * 2 + (h)) * HTB)
#define PG8_STAGE(bufoff, gbase, voff) do { _Pragma("unroll") for (int _i = 0; _i < 2; ++_i) \
        __builtin_amdgcn_global_load_lds((const unsigned*)((const char*)(gbase) + (voff)[_i]), (PG8_LAS unsigned*)(lds + (bufoff) + ldsw + _i * 8192), 16, 0, 0); } while (0)
#define PG8_LDA(dst, b, h) do { _Pragma("unroll") for (int m = 0; m < 4; ++m) _Pragma("unroll") for (int k = 0; k < 2; ++k) dst[m][k] = *(const PG8_LAS bf16x8*)(lds + PG8_SA(b, h) + aoff + m * 2048 + k * 1024); } while (0)
#define PG8_LDB(dst, b, h) do { _Pragma("unroll") for (int n = 0; n < 2; ++n) _Pragma("unroll") for (int k = 0; k < 2; ++k) dst[n][k] = *(const PG8_LAS bf16x8*)(lds + PG8_SB(b, h) + boff + n * 2048 + k * 1024); } while (0)
#define PG8_MMA(ai, bj, At, Bt) do { __builtin_amdgcn_s_setprio(1); _Pragma("unroll") for (int m = 0; m < 4; ++m) _Pragma("unroll") for (int n = 0; n < 2; ++n) _Pragma("unroll") for (int k = 0; k < 2; ++k) \
        acc[ai][bj][m][n] = __builtin_amdgcn_mfma_f32_16x16x32_bf16(Bt[n][k], At[m][k], acc[ai][bj][m][n], 0, 0, 0); __builtin_amdgcn_s_setprio(0); } while (0)
#define PG8_WAIT_V(n) asm volatile("s_waitcnt vmcnt(" #n ")" ::: "memory")
#define PG8_WAIT_L(n) asm volatile("s_waitcnt lgkmcnt(" #n ")" ::: "memory")
#define PG8_BAR __builtin_amdgcn_s_barrier()
#define PG8_SCHED __builtin_amdgcn_sched_barrier(0)
    Unit cur, nxt; int ui = 0;
    if (!S.next(0, cur)) return;
    f32x4 acc[2][2][4][2];
#pragma unroll
    for (int a = 0; a < 2; ++a)
#pragma unroll
        for (int b = 0; b < 2; ++b)
#pragma unroll
            for (int m = 0; m < 4; ++m)
#pragma unroll
                for (int n = 0; n < 2; ++n) acc[a][b][m][n] = (f32x4){0.f, 0.f, 0.f, 0.f};
    bf16x8 At[4][2], B0[2][2], B1[2][2];
    const char* cA = (const char*)g.A + (size_t)cur.pm * tstepA; const char* cB = (const char*)g.Bt + (size_t)cur.pn * tstep;
    S.a_ready(cur);
    if constexpr (SP2) {
        PG8_STAGE(PG8_SB(0, 0), cB, voffB); PG8_STAGE(PG8_SB(0, 1), cB + hstep, voffB); PG8_STAGE(PG8_SA(0, 0), cA, voffA); PG8_STAGE(PG8_SA(0, 1), cA + hstepA, voffA);
        if (wr == 1) PG8_BAR;
        PG8_WAIT_V(2); PG8_BAR;
        PG8_STAGE(PG8_SB(1, 0), cB + kstep, voffB); PG8_STAGE(PG8_SA(1, 0), cA + kstep, voffA); PG8_STAGE(PG8_SB(1, 1), cB + hstep + kstep, voffB);
        PG8_WAIT_V(6); PG8_BAR;
    } else {
        PG8_STAGE(PG8_SB(0, 0), cB, voffB); PG8_STAGE(PG8_SA(0, 0), cA, voffA); PG8_STAGE(PG8_SB(0, 1), cB + hstep, voffB); PG8_STAGE(PG8_SA(0, 1), cA + hstepA, voffA);
        if (wr == 1) PG8_BAR;
        PG8_WAIT_V(4); PG8_BAR;
        PG8_STAGE(PG8_SB(1, 0), cB + kstep, voffB); PG8_STAGE(PG8_SA(1, 0), cA + kstep, voffA); PG8_STAGE(PG8_SB(1, 1), cB + hstep + kstep, voffB);
        PG8_WAIT_V(6); PG8_BAR;
    }
    for (;;) {
        const bool has_next = S.next(ui + 1, nxt);
        const char* nA = has_next ? (const char*)g.A + (size_t)nxt.pm * tstepA : cA; const char* nB = has_next ? (const char*)g.Bt + (size_t)nxt.pn * tstep : cB;
        for (int t = 0; t < nt; t += 2) {
            const bool last = (t == nt - 2);
            const char* a1 = cA + (size_t)(t + 1) * kstep;
            const char* a2 = last ? nA : cA + (size_t)(t + 2) * kstep; const char* b2 = last ? nB : cB + (size_t)(t + 2) * kstep;
            const char* a3 = a2 + kstep; const char* b3 = b2 + kstep;
            if (last && has_next) S.a_ready(nxt);
            if constexpr (SP2) {
            PG8_LDB(B0, 0, 0); PG8_LDB(B1, 0, 1); PG8_SCHED; PG8_LDA(At, 0, 0); PG8_STAGE(PG8_SA(1, 1), a1 + hstepA, voffA);
            PG8_WAIT_V(8); PG8_WAIT_L(0); PG8_BAR; PG8_MMA(0, 0, At, B0); PG8_MMA(0, 1, At, B1); PG8_BAR; PG8_SCHED;
            PG8_LDA(At, 0, 1); PG8_STAGE(PG8_SB(0, 0), b2, voffB); PG8_STAGE(PG8_SB(0, 1), b2 + hstep, voffB); PG8_STAGE(PG8_SA(0, 0), a2, voffA);
            PG8_WAIT_V(8); PG8_WAIT_L(0); PG8_BAR; PG8_MMA(1, 0, At, B0); PG8_MMA(1, 1, At, B1); PG8_BAR; PG8_SCHED;
            PG8_LDB(B0, 1, 0); PG8_LDB(B1, 1, 1); PG8_SCHED; PG8_LDA(At, 1, 0); PG8_STAGE(PG8_SA(0, 1), a2 + hstepA, voffA);
            PG8_WAIT_V(8); PG8_WAIT_L(0); PG8_BAR; PG8_MMA(0, 0, At, B0); PG8_MMA(0, 1, At, B1); PG8_BAR; PG8_SCHED;
            PG8_LDA(At, 1, 1); PG8_STAGE(PG8_SB(1, 0), b3, voffB); PG8_STAGE(PG8_SB(1, 1), b3 + hstep, voffB); PG8_STAGE(PG8_SA(1, 0), a3, voffA);
            PG8_WAIT_V(8); PG8_WAIT_L(0); PG8_BAR; PG8_MMA(1, 0, At, B0); PG8_MMA(1, 1, At, B1); PG8_BAR; PG8_SCHED;
            } else {
            PG8_LDB(B0, 0, 0); PG8_SCHED; PG8_LDA(At, 0, 0); PG8_STAGE(PG8_SA(1, 1), a1 + hstepA, voffA);
            PG8_WAIT_L(8); PG8_BAR; PG8_WAIT_L(0); PG8_MMA(0, 0, At, B0); PG8_BAR; PG8_SCHED;
            PG8_LDB(B1, 0, 1); PG8_STAGE(PG8_SB(0, 0), b2, voffB);
            PG8_BAR; PG8_WAIT_L(0); PG8_MMA(0, 1, At, B1); PG8_BAR;
            PG8_LDA(At, 0, 1); PG8_STAGE(PG8_SA(0, 0), a2, voffA);
            PG8_BAR; PG8_WAIT_L(0); PG8_MMA(1, 0, At, B0); PG8_BAR; PG8_SCHED;
            PG8_STAGE(PG8_SB(0, 1), b2 + hstep, voffB);
            PG8_WAIT_V(6); PG8_BAR; PG8_MMA(1, 1, At, B1); PG8_BAR;
            PG8_LDB(B0, 1, 0); PG8_SCHED; PG8_LDA(At, 1, 0); PG8_STAGE(PG8_SA(0, 1), a2 + hstepA, voffA);
            PG8_WAIT_L(8); PG8_BAR; PG8_WAIT_L(0); PG8_MMA(0, 0, At, B0); PG8_BAR; PG8_SCHED;
            PG8_LDB(B1, 1, 1); PG8_STAGE(PG8_SB(1, 0), b3, voffB);
            PG8_BAR; PG8_WAIT_L(0); PG8_MMA(0, 1, At, B1); PG8_BAR;
            PG8_LDA(At, 1, 1); PG8_STAGE(PG8_SA(1, 0), a3, voffA);
            PG8_BAR; PG8_WAIT_L(0); PG8_MMA(1, 0, At, B0); PG8_BAR; PG8_SCHED;
            PG8_STAGE(PG8_SB(1, 1), b3 + hstep, voffB);
            PG8_WAIT_V(6); PG8_BAR; PG8_MMA(1, 1, At, B1); PG8_BAR;
            }
        }
        if constexpr (ALIGN_EPI) { if (wr == 0) PG8_BAR; }
        if constexpr (!Epi::AFTER_DRAIN) { E(acc, cur, wr, wc, fr, fq); S.done(cur); }
        if (!has_next) break;
#pragma unroll
        for (int a = 0; a < 2; ++a)
#pragma unroll
            for (int b = 0; b < 2; ++b)
#pragma unroll
                for (int m = 0; m < 4; ++m)
#pragma unroll
                    for (int n = 0; n < 2; ++n) acc[a][b][m][n] = (f32x4){0.f, 0.f, 0.f, 0.f};
        cur = nxt; cA = nA; cB = nB; ++ui;
        if constexpr (ALIGN_EPI) { if (wr == 1) PG8_BAR; }
    }
    PG8_WAIT_V(0);
    if constexpr (!ALIGN_EPI) { if (wr == 0) PG8_BAR; }
    PG8_BAR;
    if constexpr (Epi::AFTER_DRAIN) { E.fused(acc, cur, wr, wc, fr, fq, lds, wid, lane); S.done(cur); }
#undef PG8_SA
#undef PG8_SB
#undef PG8_STAGE
#undef PG8_LDA
#undef PG8_LDB
#undef PG8_MMA
#undef PG8_WAIT_V
#undef PG8_WAIT_L
#undef PG8_BAR
#undef PG8_SCHED
}
}

namespace mk {
using pg8::bf16_t; using pg8::bf16x8; using pg8::f32x4; using pg8::u32x4; using pg8::bf_lo; using pg8::bf_hi; using pg8::cvt_pk_bf16; using pg8::gelu_t;
#define LAS __attribute__((address_space(3)))
typedef unsigned u32x2 __attribute__((ext_vector_type(2)));
constexpr int M = 16384, D = 2048, SEQ = 8192, INW = 9216, DFF = 5632, NUP = 11264, MH = 8192;
constexpr int NWAVES = 8, NTHR = 512;
constexpr int LDS_BYTES = 143360;
constexpr float EPS = 1e-6f;
constexpr size_t O_WIN = 0, O_WA = O_WIN + (size_t)INW * D * 2, O_WSG = O_WA + (size_t)D * 1024 * 2, O_WSSM = O_WSG + (size_t)D * 512 * 2, O_WOUT = O_WSSM + (size_t)D * 512 * 2,
                 O_WUP = O_WOUT + (size_t)D * D * 2, O_WDN = O_WUP + (size_t)NUP * D * 2, O_WGLU = O_WDN + (size_t)D * DFF * 2, WLAYER = O_WGLU + (size_t)512 * 512 * 2;
constexpr size_t MiB = 1u << 20;
constexpr size_t WS_W = 0, WS_XB = 119 * MiB, WS_MRG = WS_XB + 64 * MiB, WS_PROJ = WS_MRG + 64 * MiB, WS_YCAT = WS_PROJ + 288 * MiB, WS_YS = WS_YCAT + 64 * MiB, WS_SST = WS_YS + 16 * MiB, WS_SS = WS_SST + 2 * MiB, WS_BAR = WS_SS + 512 * 1024, WS_END = WS_SS + 1 * MiB;
static_assert(WLAYER <= 119 * MiB, "one layer of bf16 weights");
constexpr size_t WS_ACT = WS_PROJ, WS_RAW = WS_PROJ + 176 * MiB;
static_assert(WLAYER % 256 == 0 && (size_t)M * INW * 2 == 288 * MiB && (size_t)M * DFF * 2 == 176 * MiB && (size_t)256 * 4 * NUP * 4 <= 112 * MiB, "ws map");
constexpr int PPL = 10, NPH = PPL * 2;

struct Args { const float* in[30]; float* out; unsigned char* ws; int ph_lo, ph_hi; };
typedef __attribute__((address_space(4))) const Args CArgs;

__device__ __forceinline__ float wave_sum(float v) {
#pragma unroll
    for (int o = 1; o < 64; o <<= 1) v += __shfl_xor(v, o);
    return v;
}
__device__ __forceinline__ unsigned f2bf(float f) { unsigned u = __builtin_bit_cast(unsigned, f); return (u + 0x7fffu + ((u >> 16) & 1u)) >> 16; }
__device__ __forceinline__ unsigned pk2(float lo, float hi) { return f2bf(lo) | (f2bf(hi) << 16); }

__device__ __forceinline__ void titem_load(const float* W, int N, int item, int lane, float (&wv)[32]) {
    const int nblk = N / 32, kb = item / nblk, nb = item % nblk;
    const float* wp = W + (size_t)(64 * kb + (lane >> 5)) * N + 32 * nb + (lane & 31);
#pragma unroll
    for (int i = 0; i < 32; ++i) wv[i] = __builtin_nontemporal_load(wp + (size_t)(2 * i) * N);
}
__device__ __forceinline__ void titem_finish(const float (&wv)[32], int K, int N, bf16_t* WT, LAS float* scr, int item, int lane, bool upperm, const float* gain) {
    const int nblk = N / 32, kb = item / nblk, nb = item % nblk, k0 = 64 * kb, n0 = 32 * nb;
    int nd0 = n0; if (upperm) { const int hi = n0 >= 5632, nn = n0 - hi * 5632; nd0 = 256 * (nn >> 7) + 128 * hi + (nn & 127); }
#pragma unroll
    for (int i = 0; i < 32; ++i) scr[(2 * i + (lane >> 5)) * 33 + (lane & 31)] = wv[i];
    asm volatile("s_waitcnt lgkmcnt(0)" ::: "memory");
    const int c = lane & 7;
    f32x4 g0 = (f32x4){1.f, 1.f, 1.f, 1.f}, g1 = g0;
    if (gain) { g0 = *(const f32x4*)(gain + k0 + 8 * c); g1 = *(const f32x4*)(gain + k0 + 8 * c + 4); }
#pragma unroll
    for (int j = 0; j < 4; ++j) { const int n = (lane >> 3) + 8 * j; const LAS float* s = scr + (8 * c) * 33 + n;
        u32x4 o; o.x = cvt_pk_bf16(s[0 * 33] * g0[0], s[1 * 33] * g0[1]); o.y = cvt_pk_bf16(s[2 * 33] * g0[2], s[3 * 33] * g0[3]); o.z = cvt_pk_bf16(s[4 * 33] * g1[0], s[5 * 33] * g1[1]); o.w = cvt_pk_bf16(s[6 * 33] * g1[2], s[7 * 33] * g1[3]);
        *(u32x4*)(WT + (size_t)(nd0 + n) * K + k0 + 8 * c) = o; }
    asm volatile("s_waitcnt lgkmcnt(0)" ::: "memory");
}
__device__ __forceinline__ void convert_phase(CArgs* ap, int l, LAS unsigned char* lds, int gw, int NGW, int wave, int lane) {
    LAS float* scr = (LAS float*)(lds + wave * 8448);
    {
        unsigned char* wb = ap->ws + WS_W;
#pragma unroll 1
        for (int mi = 0; mi < 8; ++mi) {
            const float* W; int K, N; size_t off;
            switch (mi) {
                case 0: W = ap->in[2] + (size_t)l * D * INW; K = D; N = INW; off = O_WIN; break;
                case 1: W = ap->in[21] + (size_t)l * 1024 * D; K = 1024; N = D; off = O_WA; break;
                case 2: W = ap->in[22] + (size_t)l * 512 * D; K = 512; N = D; off = O_WSG; break;
                case 3: W = ap->in[23] + (size_t)l * 512 * D; K = 512; N = D; off = O_WSSM; break;
                case 4: W = ap->in[24] + (size_t)l * D * D; K = D; N = D; off = O_WOUT; break;
                case 5: W = ap->in[26] + (size_t)l * D * NUP; K = D; N = NUP; off = O_WUP; break;
                case 6: W = ap->in[29] + (size_t)l * DFF * D; K = DFF; N = D; off = O_WDN; break;
                default: W = ap->in[19] + (size_t)l * 512 * 512; K = 512; N = 512; off = O_WGLU; break;
            }
            const int nitems = (K / 64) * (N / 32);
            const float* gain = mi == 0 ? ap->in[1] + l * D : (mi == 5 ? ap->in[25] + l * D : nullptr);
            float wc[32], wn[32];
            int it = gw;
            if (it < nitems) titem_load(W, N, it, lane, wc);
            while (it < nitems) {
                const int nx = it + NGW;
                if (nx < nitems) titem_load(W, N, nx, lane, wn);
                titem_finish(wc, K, N, (bf16_t*)(wb + off), scr, it, lane, mi == 5, gain);
#pragma unroll
                for (int i = 0; i < 32; ++i) wc[i] = wn[i];
                it = nx;
            }
        }
    }
}

__device__ __forceinline__ void xb_phase(const float* x, bf16_t* XB, float* SS, int gw, int NGW, int lane) {
    for (int m = gw; m < M; m += NGW) {
        const f32x4* xr = (const f32x4*)(x + (size_t)m * D) + lane;
        f32x4 v[8]; float s = 0.f;
#pragma unroll
        for (int j = 0; j < 8; ++j) { v[j] = xr[64 * j]; s += (v[j][0] * v[j][0] + v[j][1] * v[j][1]) + (v[j][2] * v[j][2] + v[j][3] * v[j][3]); }
        s = wave_sum(s);
        if (lane == 0) SS[m] = s;
        u32x2* o = (u32x2*)(XB + (size_t)m * D) + lane;
#pragma unroll
        for (int j = 0; j < 8; ++j) { u32x2 w; w.x = pk2(v[j][0], v[j][1]); w.y = pk2(v[j][2], v[j][3]); o[64 * j] = w; }
    }
}

__device__ __forceinline__ bf16x8 as_bf8(u32x4 w) { return __builtin_bit_cast(bf16x8, w); }

__device__ __forceinline__ void attn_unit(LAS unsigned char* lds, const bf16_t* PROJ, bf16_t* YCAT, const float* qg, const float* kg, const float* sinks, int unit, int tid, int wave, int lane) {
    const int kvh = unit & 1, blk = (unit >> 1) & 63, b = unit >> 7;
    const int t0 = b * SEQ + blk * 128;
    LAS bf16_t* Ks = (LAS bf16_t*)lds; LAS bf16_t* Vt = (LAS bf16_t*)(lds + 69632);
    {
        const int c16 = tid & 15;
        const f32x4 g0 = *(const f32x4*)(kg + 8 * c16), g1 = *(const f32x4*)(kg + 8 * c16 + 4);
#pragma unroll 2
        for (int pass = 0; pass < 8; ++pass) {
            const int kidx = (tid >> 4) + 32 * pass;
            u32x4 w = {0u, 0u, 0u, 0u};
            if (!(blk == 0 && pass < 4)) w = *(const u32x4*)(PROJ + (size_t)(t0 - 128 + kidx) * INW + 1024 + kvh * 128 + 8 * c16);
            f32x4 v0, v1; pg8::unpack8(w, v0, v1);
            float ss = (v0[0] * v0[0] + v0[1] * v0[1]) + (v0[2] * v0[2] + v0[3] * v0[3]) + (v1[0] * v1[0] + v1[1] * v1[1]) + (v1[2] * v1[2] + v1[3] * v1[3]);
            ss += __shfl_xor(ss, 1); ss += __shfl_xor(ss, 2); ss += __shfl_xor(ss, 4); ss += __shfl_xor(ss, 8);
            const float rs = rsqrtf(ss * (1.f / 128.f) + EPS);
            *(LAS u32x4*)(Ks + kidx * 136 + 8 * c16) = pg8::pack8(v0 * rs * g0, v1 * rs * g1);
        }
    }
    {
#pragma unroll 1
        for (int rg = 0; rg < 4; ++rg) {
            const int kidx = 64 * rg + lane, kk = kidx & 31, pos = (kidx & ~31) + 8 * ((kk >> 2) & 3) + 4 * (kk >> 4) + (kk & 3);
#pragma unroll
            for (int cc = 0; cc < 2; ++cc) {
                const int c16 = 2 * wave + cc;
                u32x4 w = {0u, 0u, 0u, 0u};
                if (!(blk == 0 && rg < 2)) w = *(const u32x4*)(PROJ + (size_t)(t0 - 128 + kidx) * INW + 1280 + kvh * 128 + 8 * c16);
                LAS bf16_t* d = Vt + (8 * c16) * 264 + pos;
                d[0 * 264] = (bf16_t)(w.x & 0xffffu); d[1 * 264] = (bf16_t)(w.x >> 16); d[2 * 264] = (bf16_t)(w.y & 0xffffu); d[3 * 264] = (bf16_t)(w.y >> 16);
                d[4 * 264] = (bf16_t)(w.z & 0xffffu); d[5 * 264] = (bf16_t)(w.z >> 16); d[6 * 264] = (bf16_t)(w.w & 0xffffu); d[7 * 264] = (bf16_t)(w.w >> 16);
            }
        }
    }
    __syncthreads();
    const int fr = lane & 15, fq = lane >> 4, qrow = 16 * wave + fr;
#pragma unroll 1
    for (int hq = 4 * kvh; hq < 4 * kvh + 4; ++hq) {
    bf16x8 qf[4];
    {
        const bf16_t* qp = PROJ + (size_t)(t0 + qrow) * INW + hq * 128 + 8 * fq;
        u32x4 w[4]; float ss = 0.f;
#pragma unroll
        for (int ks = 0; ks < 4; ++ks) { w[ks] = *(const u32x4*)(qp + 32 * ks); f32x4 v0, v1; pg8::unpack8(w[ks], v0, v1);
            ss += (v0[0] * v0[0] + v0[1] * v0[1]) + (v0[2] * v0[2] + v0[3] * v0[3]) + (v1[0] * v1[0] + v1[1] * v1[1]) + (v1[2] * v1[2] + v1[3] * v1[3]); }
        ss += __shfl_xor(ss, 16); ss += __shfl_xor(ss, 32);
        const float rs = rsqrtf(ss * (1.f / 128.f) + EPS) * 0.08838834764831845f;
#pragma unroll
        for (int ks = 0; ks < 4; ++ks) { f32x4 v0, v1; pg8::unpack8(w[ks], v0, v1);
            const f32x4 g0 = *(const f32x4*)(qg + 32 * ks + 8 * fq), g1 = *(const f32x4*)(qg + 32 * ks + 8 * fq + 4);
            qf[ks] = as_bf8(pg8::pack8(v0 * rs * g0, v1 * rs * g1)); }
    }
    const int wp = wave & ~1;
    f32x4 s[10];
#pragma unroll
    for (int rel = 0; rel < 10; ++rel) {
        s[rel] = (f32x4){0.f, 0.f, 0.f, 0.f};
#pragma unroll
        for (int ks = 0; ks < 4; ++ks) {
            const bf16x8 kf = *(const LAS bf16x8*)(Ks + (16 * (wp + rel) + fr) * 136 + 32 * ks + 8 * fq);
            s[rel] = __builtin_amdgcn_mfma_f32_16x16x32_bf16(kf, qf[ks], s[rel], 0, 0, 0);
        }
    }
    const float slope = exp2f(-(float)(hq + 1)), sink = sinks[hq];
    const int qidx = 128 + qrow;
    float mx = -INFINITY;
#pragma unroll
    for (int rel = 0; rel < 10; ++rel)
#pragma unroll
        for (int i = 0; i < 4; ++i) {
            const int kidx = 16 * (wp + rel) + 4 * fq + i, dist = qidx - kidx;
            const bool valid = (dist >= 0) && (dist < 128) && (blk > 0 || kidx >= 128);
            const float val = valid ? s[rel][i] - slope * (float)dist : -INFINITY;
            s[rel][i] = val; mx = fmaxf(mx, val);
        }
    mx = fmaxf(mx, __shfl_xor(mx, 16)); mx = fmaxf(mx, __shfl_xor(mx, 32));
    const float mm = fmaxf(mx, sink);
    float ls = 0.f;
#pragma unroll
    for (int rel = 0; rel < 10; ++rel)
#pragma unroll
        for (int i = 0; i < 4; ++i) { const float p = __expf(s[rel][i] - mm); s[rel][i] = p; ls += p; }
    ls += __shfl_xor(ls, 16); ls += __shfl_xor(ls, 32);
    const float inv = 1.f / (ls + __expf(sink - mm));
    bf16x8 pf[5];
#pragma unroll
    for (int g = 0; g < 5; ++g) pf[g] = as_bf8(pg8::pack8(s[2 * g], s[2 * g + 1]));
    bf16_t* op = YCAT + (size_t)(t0 + qrow) * D + hq * 128 + 4 * fq;
#pragma unroll
    for (int db = 0; db < 8; ++db) {
        f32x4 o = (f32x4){0.f, 0.f, 0.f, 0.f};
#pragma unroll
        for (int g = 0; g < 5; ++g) {
            const bf16x8 vf = *(const LAS bf16x8*)(Vt + (16 * db + fr) * 264 + 32 * ((wp >> 1) + g) + 8 * fq);
            o = __builtin_amdgcn_mfma_f32_16x16x32_bf16(vf, pf[g], o, 0, 0, 0);
        }
        u32x2 w; w.x = cvt_pk_bf16(o[0] * inv, o[1] * inv); w.y = cvt_pk_bf16(o[2] * inv, o[3] * inv);
        *(u32x2*)(op + 16 * db) = w;
    }
    }
    __syncthreads();
}

__device__ __forceinline__ void sg_unit(LAS unsigned char* lds, const bf16_t* PROJ, bf16_t* YCAT, const float* lng, const float* lnb, const float* sgw, const float* sgb, int unit, int tid, int wave, int lane) {
    const int g = unit & 3, ch = (unit >> 2) & 63, b = unit >> 8;
    const int t0 = b * SEQ + ch * 128;
    LAS bf16_t* Zt = (LAS bf16_t*)lds; LAS float* st = (LAS float*)(lds + 34816);
    const bf16_t* zv = PROJ + (size_t)t0 * INW + 2048 + g * 128;
    {
        const int c16 = tid & 15;
#pragma unroll
        for (int pass = 0; pass < 4; ++pass) {
            const int r = (tid >> 4) + 32 * pass;
            f32x4 v0, v1; pg8::unpack8(*(const u32x4*)(zv + (size_t)r * INW + 8 * c16), v0, v1);
            float sm = (v0[0] + v0[1]) + (v0[2] + v0[3]) + (v1[0] + v1[1]) + (v1[2] + v1[3]);
            sm += __shfl_xor(sm, 1); sm += __shfl_xor(sm, 2); sm += __shfl_xor(sm, 4); sm += __shfl_xor(sm, 8);
            const float mean = sm * (1.f / 128.f);
            v0 = v0 - mean; v1 = v1 - mean;
            float q = (v0[0] * v0[0] + v0[1] * v0[1]) + (v0[2] * v0[2] + v0[3] * v0[3]) + (v1[0] * v1[0] + v1[1] * v1[1]) + (v1[2] * v1[2] + v1[3] * v1[3]);
            q += __shfl_xor(q, 1); q += __shfl_xor(q, 2); q += __shfl_xor(q, 4); q += __shfl_xor(q, 8);
            if (c16 == 0) { st[2 * r] = mean; st[2 * r + 1] = rsqrtf(q * (1.f / 128.f) + EPS); }
        }
    }
    __syncthreads();
#pragma unroll 1
    for (int rg = 0; rg < 2; ++rg) {
        const int r = 64 * rg + lane; const float mean = st[2 * r], rstd = st[2 * r + 1];
#pragma unroll
        for (int cc = 0; cc < 2; ++cc) {
            const int c16 = 2 * wave + cc;
            f32x4 v0, v1; pg8::unpack8(*(const u32x4*)(zv + (size_t)r * INW + 8 * c16), v0, v1);
            const f32x4 a0 = *(const f32x4*)(lng + g * 128 + 8 * c16), a1 = *(const f32x4*)(lng + g * 128 + 8 * c16 + 4);
            const f32x4 b0 = *(const f32x4*)(lnb + g * 128 + 8 * c16), b1 = *(const f32x4*)(lnb + g * 128 + 8 * c16 + 4);
            v0 = (v0 - mean) * rstd * a0 + b0; v1 = (v1 - mean) * rstd * a1 + b1;
            LAS bf16_t* d = Zt + (8 * c16) * 136 + r;
            d[0 * 136] = (bf16_t)f2bf(v0[0]); d[1 * 136] = (bf16_t)f2bf(v0[1]); d[2 * 136] = (bf16_t)f2bf(v0[2]); d[3 * 136] = (bf16_t)f2bf(v0[3]);
            d[4 * 136] = (bf16_t)f2bf(v1[0]); d[5 * 136] = (bf16_t)f2bf(v1[1]); d[6 * 136] = (bf16_t)f2bf(v1[2]); d[7 * 136] = (bf16_t)f2bf(v1[3]);
        }
    }
    __syncthreads();
    const int fr = lane & 15, fq = lane >> 4, t = 16 * wave + fr, nks = (wave >> 1) + 1;
    bf16x8 wf[4];
#pragma unroll
    for (int ks = 0; ks < 4; ++ks) {
        u32x4 w = {0u, 0u, 0u, 0u};
        if (ks < nks) {
            const float* wp = sgw + ((size_t)(g * 128 + t)) * 128 + 32 * ks + 8 * fq;
            f32x4 a0 = *(const f32x4*)wp, a1 = *(const f32x4*)(wp + 4);
            const int s0 = 32 * ks + 8 * fq;
#pragma unroll
            for (int i = 0; i < 4; ++i) { if (s0 + i > t) a0[i] = 0.f; if (s0 + 4 + i > t) a1[i] = 0.f; }
            w = pg8::pack8(a0, a1);
        }
        wf[ks] = as_bf8(w);
    }
    const float bs = sgb[g * 128 + t];
    const bf16_t* zu = PROJ + (size_t)(t0 + t) * INW + 1536 + g * 128 + 4 * fq;
    bf16_t* op = YCAT + (size_t)(t0 + t) * D + 1024 + g * 128 + 4 * fq;
#pragma unroll
    for (int cb = 0; cb < 8; ++cb) {
        f32x4 acc = (f32x4){0.f, 0.f, 0.f, 0.f};
#pragma unroll
        for (int ks = 0; ks < 4; ++ks) if (ks < nks) {
            const bf16x8 zf = *(const LAS bf16x8*)(Zt + (16 * cb + fr) * 136 + 32 * ks + 8 * fq);
            acc = __builtin_amdgcn_mfma_f32_16x16x32_bf16(zf, wf[ks], acc, 0, 0, 0);
        }
        const u32x2 zw = *(const u32x2*)(zu + 16 * cb);
        u32x2 w; w.x = cvt_pk_bf16(bf_lo(zw.x) * (acc[0] + bs), bf_hi(zw.x) * (acc[1] + bs)); w.y = cvt_pk_bf16(bf_lo(zw.y) * (acc[2] + bs), bf_hi(zw.y) * (acc[3] + bs));
        *(u32x2*)(op + 16 * cb) = w;
    }
    __syncthreads();
}

template <bool P3> __device__ __forceinline__ void ssm_unit(CArgs* ap, int l, const bf16_t* PROJ, float* SST, bf16_t* YS, LAS unsigned char* wlds, int unit, int lane) {
    const int c = unit & 63, g = (unit >> 6) & 31, b = unit >> 11;
    const int fr = lane & 15, fq = lane >> 4;
    const float dt = expf(ap->in[13][l * 32 + g]);
    float pr[4][4], pi[4][4]; bf16x8 bfr[8];
#pragma unroll
    for (int cb = 0; cb < 4; ++cb) {
        const int gp = (l * 32 + g) * 64 + 16 * cb + fr;
        const float lr = ap->in[11][gp], li = ap->in[12][gp];
        const float x = lr * dt, y = li * dt;
        const float ex = expf(x), cs = cosf(y), sn = sinf(y), sh = sinf(0.5f * y);
        const float abr = ex * cs, abi = ex * sn;
        pr[cb][0] = abr; pi[cb][0] = abi;
#pragma unroll
        for (int i = 1; i < 4; ++i) { pr[cb][i] = pr[cb][i - 1] * abr - pi[cb][i - 1] * abi; pi[cb][i] = pr[cb][i - 1] * abi + pi[cb][i - 1] * abr; }
        const float nr = expm1f(x) * cs - 2.f * sh * sh, ni = abi;
        const float den = 1.f / (lr * lr + li * li);
        const float cr = (nr * lr + ni * li) * den, ci = (ni * lr - nr * li) * den;
        u32x4 wre = {0u, 0u, 0u, 0u}, wim = {0u, 0u, 0u, 0u};
        if (fq < 2) {
            const float* br = ap->in[14] + (size_t)gp * 16 + 8 * fq; const float* bi = ap->in[15] + (size_t)gp * 16 + 8 * fq;
            const f32x4 r0 = *(const f32x4*)br, r1 = *(const f32x4*)(br + 4), i0 = *(const f32x4*)bi, i1 = *(const f32x4*)(bi + 4);
            wre = pg8::pack8(cr * r0 - ci * i0, cr * r1 - ci * i1); wim = pg8::pack8(cr * i0 + ci * r0, cr * i1 + ci * r1);
        }
        bfr[cb] = as_bf8(wre); bfr[cb + 4] = as_bf8(wim);
    }
    bf16x8 cmf[4]; float dsk = 0.f;
    if (P3) {
#pragma unroll
        for (int ks = 0; ks < 4; ++ks) {
            const int k0 = 32 * ks + 8 * fq;
            const float* src = (ks < 2 ? ap->in[16] : ap->in[17]) + ((size_t)(l * 32 + g) * 16 + fr) * 64 + (ks < 2 ? k0 : k0 - 64);
            f32x4 c0 = *(const f32x4*)src, c1 = *(const f32x4*)(src + 4);
            if (ks >= 2) { c0 = -c0; c1 = -c1; }
            cmf[ks] = as_bf8(pg8::pack8(c0, c1));
        }
        dsk = ap->in[18][l * 512 + g * 16 + fr];
    }
    float hr[4], hi[4];
#pragma unroll
    for (int cb = 0; cb < 4; ++cb) { hr[cb] = 0.f; hi[cb] = 0.f; }
    if (P3) {
        float tr[4], ti[4];
#pragma unroll
        for (int cb = 0; cb < 4; ++cb) { tr[cb] = pr[cb][3]; ti[cb] = pi[cb][3];
#pragma unroll
            for (int k = 0; k < 5; ++k) { const float nr = tr[cb] * tr[cb] - ti[cb] * ti[cb], ni = 2.f * tr[cb] * ti[cb]; tr[cb] = nr; ti[cb] = ni; } }
        const float* sp = SST + ((size_t)(unit - c) * 64 + fr) * 2;
        for (int cc = 0; cc < c; ++cc) {
#pragma unroll
            for (int cb = 0; cb < 4; ++cb) { const float2 s = *(const float2*)(sp + (size_t)cc * 128 + 32 * cb);
                const float nr = tr[cb] * hr[cb] - ti[cb] * hi[cb] + s.x, ni = tr[cb] * hi[cb] + ti[cb] * hr[cb] + s.y; hr[cb] = nr; hi[cb] = ni; }
        }
    }
    const size_t row0 = (size_t)(b * SEQ + c * 128);
    LAS bf16_t* Hs = (LAS bf16_t*)wlds;
    u32x4 uwn = {0u, 0u, 0u, 0u};
    if (fq < 2) uwn = *(const u32x4*)(PROJ + (row0 + fr) * INW + 2560 + g * 16 + 8 * fq);
#pragma unroll 1
    for (int blk = 0; blk < 8; ++blk) {
        const u32x4 uw = uwn;
        if (fq < 2) uwn = *(const u32x4*)(PROJ + (row0 + 16 * (blk < 7 ? blk + 1 : blk) + fr) * INW + 2560 + g * 16 + 8 * fq);
        const bf16x8 uf = as_bf8(uw);
        f32x4 bu[8];
#pragma unroll
        for (int k = 0; k < 8; ++k) bu[k] = __builtin_amdgcn_mfma_f32_16x16x32_bf16(uf, bfr[k], (f32x4){0.f, 0.f, 0.f, 0.f}, 0, 0, 0);
#pragma unroll
        for (int cb = 0; cb < 4; ++cb) {
            const float ar = pr[cb][0], ai = pi[cb][0], a4r = pr[cb][3], a4i = pi[cb][3];
            float lr_[4], li_[4];
            lr_[0] = bu[cb][0]; li_[0] = bu[cb + 4][0];
#pragma unroll
            for (int i = 1; i < 4; ++i) { lr_[i] = ar * lr_[i - 1] - ai * li_[i - 1] + bu[cb][i]; li_[i] = ar * li_[i - 1] + ai * lr_[i - 1] + bu[cb + 4][i]; }
            float cr = hr[cb], ci = hi[cb];
#pragma unroll
            for (int j = 0; j < 3; ++j) {
                const float er = __shfl(lr_[3], fr + 16 * j), ei = __shfl(li_[3], fr + 16 * j);
                const float nr = a4r * cr - a4i * ci + er, ni = a4r * ci + a4i * cr + ei;
                if (j < fq) { cr = nr; ci = ni; }
            }
            float h_r[4], h_i[4];
#pragma unroll
            for (int i = 0; i < 4; ++i) { h_r[i] = lr_[i] + pr[cb][i] * cr - pi[cb][i] * ci; h_i[i] = li_[i] + pr[cb][i] * ci + pi[cb][i] * cr; }
            hr[cb] = __shfl(h_r[3], fr + 48); hi[cb] = __shfl(h_i[3], fr + 48);
            if (P3) {
#pragma unroll
                for (int i = 0; i < 4; ++i) { Hs[(4 * fq + i) * 136 + 16 * cb + fr] = (bf16_t)f2bf(h_r[i]); Hs[(4 * fq + i) * 136 + 64 + 16 * cb + fr] = (bf16_t)f2bf(h_i[i]); }
            }
        }
        if (P3) {
            f32x4 y = (f32x4){0.f, 0.f, 0.f, 0.f};
            asm volatile("s_waitcnt lgkmcnt(0)" ::: "memory");
            bf16x8 hf[4];
#pragma unroll
            for (int ks = 0; ks < 4; ++ks) hf[ks] = *(const LAS bf16x8*)(Hs + fr * 136 + 32 * ks + 8 * fq);
            asm volatile("s_waitcnt lgkmcnt(0)" ::: "memory");
#pragma unroll
            for (int ks = 0; ks < 4; ++ks) y = __builtin_amdgcn_mfma_f32_16x16x32_bf16(hf[ks], cmf[ks], y, 0, 0, 0);
#pragma unroll
            for (int i = 0; i < 4; ++i) {
                const size_t row = row0 + 16 * blk + 4 * fq + i;
                const float uu = __uint_as_float(((unsigned)PROJ[row * INW + 2560 + g * 16 + fr]) << 16);
                YS[row * 512 + g * 16 + fr] = (bf16_t)f2bf(gelu_t(y[i] + dsk * uu));
            }
        }
    }
    if (!P3) { if (fq == 0) {
#pragma unroll
        for (int cb = 0; cb < 4; ++cb) *(float2*)(SST + ((size_t)unit * 64 + 16 * cb + fr) * 2) = make_float2(hr[cb], hi[cb]); } }
}

__device__ __forceinline__ void ssm_setup(CArgs* ap, int l, int g, int p, float& abr, float& abi, float (&bbr)[16], float (&bbi)[16]) {
    const float dt = expf(ap->in[13][l * 32 + g]);
    const float lr = ap->in[11][(l * 32 + g) * 64 + p], li = ap->in[12][(l * 32 + g) * 64 + p];
    const float x = lr * dt, y = li * dt;
    const float ex = expf(x), cs = cosf(y), sn = sinf(y), sh = sinf(0.5f * y);
    abr = ex * cs; abi = ex * sn;
    const float nr = expm1f(x) * cs - 2.f * sh * sh, ni = abi;
    const float den = 1.f / (lr * lr + li * li);
    const float cr = (nr * lr + ni * li) * den, ci = (ni * lr - nr * li) * den;
    const float* br = ap->in[14] + ((size_t)(l * 32 + g) * 64 + p) * 16; const float* bi = ap->in[15] + ((size_t)(l * 32 + g) * 64 + p) * 16;
#pragma unroll
    for (int q = 0; q < 4; ++q) { const f32x4 r4 = *(const f32x4*)(br + 4 * q), i4 = *(const f32x4*)(bi + 4 * q);
#pragma unroll
        for (int i = 0; i < 4; ++i) { bbr[4 * q + i] = cr * r4[i] - ci * i4[i]; bbi[4 * q + i] = cr * i4[i] + ci * r4[i]; } }
}
__device__ __forceinline__ void load_u16(const bf16_t* p, float (&u)[16]) {
    const u32x4 w0 = ((const u32x4*)p)[0], w1 = ((const u32x4*)p)[1];
    u[0] = bf_lo(w0.x); u[1] = bf_hi(w0.x); u[2] = bf_lo(w0.y); u[3] = bf_hi(w0.y); u[4] = bf_lo(w0.z); u[5] = bf_hi(w0.z); u[6] = bf_lo(w0.w); u[7] = bf_hi(w0.w);
    u[8] = bf_lo(w1.x); u[9] = bf_hi(w1.x); u[10] = bf_lo(w1.y); u[11] = bf_hi(w1.y); u[12] = bf_lo(w1.z); u[13] = bf_hi(w1.z); u[14] = bf_lo(w1.w); u[15] = bf_hi(w1.w);
}
__device__ __forceinline__ void ssm_pass1(CArgs* ap, int l, const bf16_t* PROJ, float* SST, int unit, int lane) {
    const int c = unit & 63, g = (unit >> 6) & 31, b = unit >> 11;
    float abr, abi, bbr[16], bbi[16];
    ssm_setup(ap, l, g, lane, abr, abi, bbr, bbi);
    const bf16_t* up = PROJ + (size_t)(b * SEQ + c * 128) * INW + 2560 + g * 16;
    float hr = 0.f, hi = 0.f;
#pragma unroll 4
    for (int t = 0; t < 128; ++t) {
        float u[16]; load_u16(up + (size_t)t * INW, u);
        float br = 0.f, bi = 0.f;
#pragma unroll
        for (int k = 0; k < 16; ++k) { br += bbr[k] * u[k]; bi += bbi[k] * u[k]; }
        const float nr = abr * hr - abi * hi + br, ni = abr * hi + abi * hr + bi; hr = nr; hi = ni;
    }
    *(float2*)(SST + ((size_t)unit * 64 + lane) * 2) = make_float2(hr, hi);
}
template <int HALFN> __device__ __forceinline__ void rs_stage(float (&v)[64], int lane) {
    if constexpr (HALFN == 32 || HALFN == 16) {
#pragma unroll
        for (int i = 0; i < HALFN; ++i) {
            float a = v[i], b = v[i + HALFN];
            if constexpr (HALFN == 32) asm volatile("s_nop 1\n\tv_permlane32_swap_b32 %0, %1" : "+v"(a), "+v"(b));
            else asm volatile("s_nop 1\n\tv_permlane16_swap_b32 %0, %1" : "+v"(a), "+v"(b));
            v[i] = a + b;
        }
    } else {
        const bool bit = (lane & HALFN) != 0;
#pragma unroll
        for (int i = 0; i < HALFN; ++i) { const float keep = bit ? v[i + HALFN] : v[i], send = bit ? v[i] : v[i + HALFN]; v[i] = keep + __shfl_xor(send, HALFN); }
    }
}
__device__ __forceinline__ void ssm_pass3(CArgs* ap, int l, const bf16_t* PROJ, const float* SST, bf16_t* YS, int unit, int lane) {
    const int c = unit & 63, g = (unit >> 6) & 31, b = unit >> 11;
    float abr, abi, bbr[16], bbi[16];
    ssm_setup(ap, l, g, lane, abr, abi, bbr, bbi);
    typedef float f32x2v __attribute__((ext_vector_type(2)));
    f32x2v cre2[8], cim2[8], bb2[16];
#pragma unroll
    for (int k = 0; k < 8; ++k) { cre2[k] = (f32x2v){ap->in[16][((size_t)(l * 32 + g) * 16 + 2 * k) * 64 + lane], ap->in[16][((size_t)(l * 32 + g) * 16 + 2 * k + 1) * 64 + lane]};
        cim2[k] = (f32x2v){ap->in[17][((size_t)(l * 32 + g) * 16 + 2 * k) * 64 + lane], ap->in[17][((size_t)(l * 32 + g) * 16 + 2 * k + 1) * 64 + lane]}; }
#pragma unroll
    for (int k = 0; k < 16; ++k) bb2[k] = (f32x2v){bbr[k], bbi[k]};
    const float dsk = ap->in[18][l * 512 + g * 16 + (lane & 15)];
    float tr = abr, ti = abi;
#pragma unroll
    for (int k = 0; k < 7; ++k) { const float nr = tr * tr - ti * ti, ni = 2.f * tr * ti; tr = nr; ti = ni; }
    float hr = 0.f, hi = 0.f;
    const float* sp = SST + ((size_t)(unit - c) * 64 + lane) * 2;
    int cc = 0;
    for (; cc + 8 <= c; cc += 8) {
        float2 s8[8];
#pragma unroll
        for (int j = 0; j < 8; ++j) s8[j] = *(const float2*)(sp + (size_t)(cc + j) * 128);
#pragma unroll
        for (int j = 0; j < 8; ++j) { const float nr = tr * hr - ti * hi + s8[j].x, ni = tr * hi + ti * hr + s8[j].y; hr = nr; hi = ni; }
    }
    for (; cc < c; ++cc) { const float2 s = *(const float2*)(sp + (size_t)cc * 128); const float nr = tr * hr - ti * hi + s.x, ni = tr * hi + ti * hr + s.y; hr = nr; hi = ni; }
    const size_t row0 = (size_t)(b * SEQ + c * 128);
    const bf16_t* up = PROJ + row0 * INW + 2560 + g * 16;
    u32x4 wn[8];
#pragma unroll
    for (int tt = 0; tt < 4; ++tt) { wn[2 * tt] = ((const u32x4*)(up + (size_t)tt * INW))[0]; wn[2 * tt + 1] = ((const u32x4*)(up + (size_t)tt * INW))[1]; }
    const int ott = lane >> 4, ok = lane & 15;
    unsigned short uun = up[(size_t)ott * INW + ok];
#pragma unroll 1
    for (int t = 0; t < 128; t += 4) {
        float v[64];
        u32x4 wc[8];
#pragma unroll
        for (int j = 0; j < 8; ++j) wc[j] = wn[j];
        const unsigned short uuc = uun;
        const int tn = (t + 4 < 128) ? t + 4 : t;
#pragma unroll
        for (int tt = 0; tt < 4; ++tt) { wn[2 * tt] = ((const u32x4*)(up + (size_t)(tn + tt) * INW))[0]; wn[2 * tt + 1] = ((const u32x4*)(up + (size_t)(tn + tt) * INW))[1]; }
        uun = up[(size_t)(tn + ott) * INW + ok];
#pragma unroll
        for (int tt = 0; tt < 4; ++tt) {
            const u32x4 w0 = wc[2 * tt], w1 = wc[2 * tt + 1];
            float u[16];
            u[0] = bf_lo(w0.x); u[1] = bf_hi(w0.x); u[2] = bf_lo(w0.y); u[3] = bf_hi(w0.y); u[4] = bf_lo(w0.z); u[5] = bf_hi(w0.z); u[6] = bf_lo(w0.w); u[7] = bf_hi(w0.w);
            u[8] = bf_lo(w1.x); u[9] = bf_hi(w1.x); u[10] = bf_lo(w1.y); u[11] = bf_hi(w1.y); u[12] = bf_lo(w1.z); u[13] = bf_hi(w1.z); u[14] = bf_lo(w1.w); u[15] = bf_hi(w1.w);
            f32x2v b2 = (f32x2v){0.f, 0.f};
#pragma unroll
            for (int k = 0; k < 16; ++k) b2 += bb2[k] * u[k];
            const float nr = abr * hr - abi * hi + b2.x, ni = abr * hi + abi * hr + b2.y; hr = nr; hi = ni;
#pragma unroll
            for (int k = 0; k < 8; ++k) { const f32x2v p = cre2[k] * hr - cim2[k] * hi; v[tt * 16 + 2 * k] = p.x; v[tt * 16 + 2 * k + 1] = p.y; }
        }
        rs_stage<32>(v, lane); rs_stage<16>(v, lane); rs_stage<8>(v, lane); rs_stage<4>(v, lane); rs_stage<2>(v, lane); rs_stage<1>(v, lane);
        const float uu = __uint_as_float(((unsigned)uuc) << 16);
        const float y = gelu_t(v[0] + dsk * uu);
        YS[(row0 + t + ott) * 512 + g * 16 + ok] = (bf16_t)f2bf(y);
    }
}

__device__ __forceinline__ void fixup_phase(const float* RAW, bf16_t* ACT, const float* cw, const float* cb, int gtid, int nthr) {
    constexpr int NC4 = DFF / 4;
    for (int it = gtid; it < 256 * 2 * NC4; it += nthr) {
        const int c = (it % NC4) * 4, r = (it / NC4) & 1, sl = it / (2 * NC4);
        const int tc = (c >> 7) * 256 + (c & 127);
        const float* base = RAW + (size_t)sl * 4 * NUP + tc; const float* prev = base - (size_t)4 * NUP;
        const bool first = (sl & 127) == 0;
        const f32x4 z = (f32x4){0.f, 0.f, 0.f, 0.f};
        const f32x4 g0 = *(const f32x4*)(base + (size_t)r * NUP), v0 = *(const f32x4*)(base + (size_t)r * NUP + 128);
        const f32x4 g63 = first ? z : *(const f32x4*)(prev + (size_t)3 * NUP), v63 = first ? z : *(const f32x4*)(prev + (size_t)3 * NUP + 128);
        f32x4 g1, g2, v1, v2;
        if (r == 1) { g1 = *(const f32x4*)base; v1 = *(const f32x4*)(base + 128); g2 = g63; v2 = v63; }
        else { g1 = g63; v1 = v63; g2 = first ? z : *(const f32x4*)(prev + (size_t)2 * NUP); v2 = first ? z : *(const f32x4*)(prev + (size_t)2 * NUP + 128); }
        const f32x4 cgt = *(const f32x4*)(cb + c) + *(const f32x4*)(cw + c) * g0 + *(const f32x4*)(cw + NUP + c) * g1 + *(const f32x4*)(cw + 2 * NUP + c) * g2;
        const f32x4 cvl = *(const f32x4*)(cb + DFF + c) + *(const f32x4*)(cw + DFF + c) * v0 + *(const f32x4*)(cw + NUP + DFF + c) * v1 + *(const f32x4*)(cw + 2 * NUP + DFF + c) * v2;
        const f32x4 o = pg8::gelu4(cgt) * cvl;
        u32x2 w; w.x = cvt_pk_bf16(o[0], o[1]); w.y = cvt_pk_bf16(o[2], o[3]);
        *(u32x2*)(ACT + (size_t)(64 * sl + r) * DFF + c) = w;
    }
}

#define XB_TMO      128
#define XB_XCNT(j)  (256  + 64 * (j))
#define XB_XSUB(j)  (1280 + 64 * (j))
#define XB_XGEN(j)  (2304 + 64 * (j))
#define XB_TOP      3328
#define XB_TOPGEN   3392
#define XCD_BAR_WORDS 3456
#define XB_SPIN_CAP (1u << 18)

__device__ __forceinline__ unsigned xb_ld(unsigned* p)              { return __hip_atomic_load(p, __ATOMIC_RELAXED, __HIP_MEMORY_SCOPE_AGENT); }
__device__ __forceinline__ unsigned xb_add(unsigned* p, unsigned v) { return __hip_atomic_fetch_add(p, v, __ATOMIC_RELAXED, __HIP_MEMORY_SCOPE_AGENT); }
__device__ __forceinline__ unsigned xb_xcc_id() { return (unsigned)__builtin_amdgcn_s_getreg((3 << 11) | 20) & 0xFu; }
#define XB_SPIN(cond, bar) do { unsigned _sp = 0; while (cond) { __builtin_amdgcn_s_sleep(1); \
    if ((++_sp & 255u) == 0u) { if (xb_ld(&(bar)[XB_TMO])) break; if (_sp > XB_SPIN_CAP) { atomicAdd(&(bar)[XB_TMO], 1u); break; } } } } while (0)

struct XcdBarrier {
    unsigned* bar; unsigned x;
    volatile LAS unsigned* st;
};

__device__ __forceinline__ XcdBarrier xcd_barrier_post(unsigned* bar, volatile LAS unsigned* st) {
    XcdBarrier b; b.bar = bar; b.x = xb_xcc_id(); b.st = st;
    if (threadIdx.x == 0) (void)xb_add(&bar[XB_XCNT(b.x)], 1u);
    return b;
}
__device__ __forceinline__ void xcd_barrier_complete(unsigned* bar, unsigned x, unsigned& nloc, unsigned& nx) {
    const unsigned G = gridDim.x * gridDim.y * gridDim.z;
    unsigned sum, cnt, mine, sp = 0u;
    for (;;) {
        sum = 0u; cnt = 0u; mine = 0u;
#pragma unroll
        for (unsigned j = 0; j < 16; ++j) { const unsigned c = xb_ld(&bar[XB_XCNT(j)]); sum += c; cnt += (c > 0u) ? 1u : 0u; mine = (j == x) ? c : mine; }
        if (sum == G) break;
        __builtin_amdgcn_s_sleep(1);
        if ((++sp & 255u) == 0u) { if (xb_ld(&bar[XB_TMO])) break; if (sp > XB_SPIN_CAP) { atomicAdd(&bar[XB_TMO], 1u); break; } }
    }
    nloc = mine > 0u ? mine : 1u; nx = cnt > 0u ? cnt : 1u;
}

__device__ __forceinline__ void xcd_barrier(const XcdBarrier& b) {
    asm volatile("s_waitcnt vmcnt(0)" ::: "memory");
    __syncthreads();
    if (threadIdx.x == 0) {
        unsigned* bar = b.bar;
        __builtin_amdgcn_s_waitcnt(0);
        unsigned nloc = b.st[0], nx = b.st[1];
        if (nloc == 0u) { xcd_barrier_complete(bar, b.x, nloc, nx); b.st[0] = nloc; b.st[1] = nx; }
        const unsigned old = xb_add(&bar[XB_XSUB(b.x)], 1u);
        const unsigned gen = old / nloc;
        if (old + 1u == (gen + 1u) * nloc) {
            __builtin_amdgcn_fence(__ATOMIC_RELEASE, "agent");
            asm volatile("s_waitcnt vmcnt(0)" ::: "memory");
            const unsigned og = xb_add(&bar[XB_TOP], 1u);
            const unsigned tg = og / nx;
            if (og + 1u == (tg + 1u) * nx) xb_add(&bar[XB_TOPGEN], 1u);
            else XB_SPIN(xb_ld(&bar[XB_TOPGEN]) == tg, bar);
            __builtin_amdgcn_fence(__ATOMIC_ACQUIRE, "agent");
            xb_add(&bar[XB_XGEN(b.x)], 1u);
            asm volatile("s_waitcnt vmcnt(0)" ::: "memory");
        } else {
            XB_SPIN(xb_ld(&bar[XB_XGEN(b.x)]) == gen, bar);
            __builtin_amdgcn_fence(__ATOMIC_ACQUIRE, "agent");
            asm volatile("s_waitcnt vmcnt(0)" ::: "memory");
        }
    }
    __syncthreads();
}

#ifdef ONLY_MODE
#define ONLY_MODE_OK(m) ((m) == ONLY_MODE)
#else
#define ONLY_MODE_OK(m) true
#endif
#ifndef PG8_SP2
#define PG8_SP2 true
#endif
#ifndef PG8_ALIGN
#define PG8_ALIGN true
#endif
template <int MODE> __device__ __forceinline__ void run_gemm(LAS unsigned char* lds, const bf16_t* A, int lda, const bf16_t* Bt, int Mr, int N, int K, const pg8::Epi<MODE>& E, int wave_in) {
    pg8::Gemm g{A, Bt, Mr, N, K, lda}; pg8::StaticOrder S; S.init(Mr, N, (int)gridDim.x, (int)blockIdx.x);
#if !defined(NO_GEMM) && (!defined(ONLY_MODE) || 1)
    if (ONLY_MODE_OK(MODE)) pg8::gemm_phase<pg8::Epi<MODE>, pg8::StaticOrder, PG8_ALIGN, PG8_SP2>(lds, g, S, E, wave_in);
#endif
}

__global__ void __launch_bounds__(NTHR, 2) fwd(Args a) {
    extern __shared__ __attribute__((aligned(16))) unsigned char lds_raw[];
    LAS unsigned char* lds = (LAS unsigned char*)lds_raw;
    cg::grid_group grid = cg::this_grid();
    const int ph_lo = a.ph_lo, ph_hi = a.ph_hi;
    const int wave_s = __builtin_amdgcn_readfirstlane((int)threadIdx.x >> 6);
    constexpr int MISC_OFF = 139264;
    if (threadIdx.x < 16) ((LAS unsigned*)(lds + MISC_OFF))[threadIdx.x] = 0u;
    __syncthreads();
    (void)xcd_barrier_post((unsigned*)(a.ws + WS_BAR), (volatile LAS unsigned*)(lds + MISC_OFF) + 8);
    for (int ph = ph_lo; ph < ph_hi; ++ph) {
        CArgs* ap = (CArgs*)__builtin_amdgcn_kernarg_segment_ptr();
        asm volatile("" : "+s"(ap));
        int tid_ = wave_s * 64 + (int)__builtin_amdgcn_mbcnt_hi(~0u, __builtin_amdgcn_mbcnt_lo(~0u, 0u)); asm volatile("" : "+v"(tid_));
        const int tid = tid_, lane = tid & 63, wave = wave_s;
        const int G = gridDim.x, gw = blockIdx.x * NWAVES + wave, NGW = G * NWAVES;
        unsigned char* ws = ap->ws;
        bf16_t* XB = (bf16_t*)(ws + WS_XB); bf16_t* MRG = (bf16_t*)(ws + WS_MRG);
        bf16_t* PROJ = (bf16_t*)(ws + WS_PROJ); bf16_t* YCAT = (bf16_t*)(ws + WS_YCAT); bf16_t* YS = (bf16_t*)(ws + WS_YS); float* SST = (float*)(ws + WS_SST);
        bf16_t* ACT = (bf16_t*)(ws + WS_ACT); float* RAW = (float*)(ws + WS_RAW);
        {
            const int l = ph / PPL, sp = ph % PPL;
            const unsigned char* wl = ws + WS_W;
            float* SS = (float*)(ws + WS_SS);
            if (sp == 0) { convert_phase(ap, l, lds, gw, NGW, wave, lane); if (l == 0) xb_phase(ap->in[0], XB, SS, gw, NGW, lane); }
            else if (sp == 1) { pg8::Epi<pg8::EP_INPROJ> E{PROJ, INW, ap->in[3] + l * 6144, nullptr, 0, nullptr, nullptr, SS + (size_t)(2 * l) * M, nullptr, nullptr}; run_gemm<pg8::EP_INPROJ>(lds, XB, D, (const bf16_t*)(wl + O_WIN), M, INW, D, E, wave); }
            else if (sp == 2) {
                for (int u = blockIdx.x; u < 256; u += G) attn_unit(lds, PROJ, YCAT, ap->in[4] + l * 128, ap->in[5] + l * 128, ap->in[6] + l * 8, u, tid, wave, lane);
                for (int u = blockIdx.x; u < 512; u += G) sg_unit(lds, PROJ, YCAT, ap->in[7] + l * 512, ap->in[8] + l * 512, ap->in[9] + (size_t)l * 4 * 128 * 128, ap->in[10] + l * 512, u, tid, wave, lane);
                for (int u = gw; u < 4096; u += NGW) ssm_unit<false>(ap, l, PROJ, SST, YS, lds + wave * 4352, u, lane);
            }
            else if (sp == 3) { for (int u = gw; u < 4096; u += NGW) ssm_pass3(ap, l, PROJ, SST, YS, u, lane); }
            else if (sp == 4) { pg8::Epi<pg8::EP_GLU> E{YCAT + 1536, D, ap->in[20] + l * 512, YS, 512, nullptr}; run_gemm<pg8::EP_GLU>(lds, YS, 512, (const bf16_t*)(wl + O_WGLU), M, 512, 512, E, wave); }
            else if (sp == 5) {
                { pg8::Epi<pg8::EP_MERGE0> E{MRG, D, nullptr, PROJ + 3072, INW, nullptr}; run_gemm<pg8::EP_MERGE0>(lds, YCAT, D, (const bf16_t*)(wl + O_WA), M, D, 1024, E, wave); }
#pragma unroll 1
                for (int j = 1; j < 3; ++j) { pg8::Epi<pg8::EP_MERGE1> E{MRG, D, nullptr, PROJ + 3072 + j * D, INW, nullptr};
                    run_gemm<pg8::EP_MERGE1>(lds, YCAT + 512 + 512 * j, D, (const bf16_t*)(wl + (j == 1 ? O_WSG : O_WSSM)), M, D, 512, E, wave); }
            }
            else if (sp == 7) { pg8::Epi<pg8::EP_UPCONV> E{ACT, DFF, ap->in[27] + (size_t)l * 3 * NUP, nullptr, 0, ap->in[28] + (size_t)l * NUP, RAW, SS + (size_t)(2 * l + 1) * M, nullptr, nullptr};
                run_gemm<pg8::EP_UPCONV>(lds, XB, D, (const bf16_t*)(wl + O_WUP), M, NUP, D, E, wave); }
            else if (sp == 8) fixup_phase(RAW, ACT, ap->in[27] + (size_t)l * 3 * NUP, ap->in[28] + (size_t)l * NUP, blockIdx.x * NTHR + tid, G * NTHR);
            else {
                const bf16_t* A; const bf16_t* Bt; int K; float* sso;
                if (sp == 6) { A = MRG; Bt = (const bf16_t*)(wl + O_WOUT); K = D; sso = SS + (size_t)(2 * l + 1) * M; }
                else { A = ACT; Bt = (const bf16_t*)(wl + O_WDN); K = DFF; sso = (l == 0) ? SS + (size_t)2 * M : nullptr; }
                pg8::Epi<pg8::EP_RESID> E{sso ? nullptr : ap->out, D, nullptr, nullptr, 0, nullptr, nullptr, nullptr, XB, sso};
                run_gemm<pg8::EP_RESID>(lds, A, K, Bt, M, D, K, E, wave);
            }
        }
        if (ph + 1 < ph_hi) {
            if (ph == ph_lo) grid.sync();
            else { XcdBarrier bar; bar.bar = (unsigned*)(ws + WS_BAR); bar.x = xb_xcc_id(); bar.st = (volatile LAS unsigned*)(lds + MISC_OFF) + 8; xcd_barrier(bar); }
        }
    }
}
}

extern "C" void kernel_launch(void* const* d_in, const int* in_sizes, int n_in, void* d_out, int out_size, void* d_ws, size_t ws_size, hipStream_t stream) {
    using namespace mk;
    static int grid = 0;
    if (grid == 0) {
        if (n_in != 30 || out_size != M * D || ws_size < WS_END) { fprintf(stderr, "kernel_launch: unexpected problem (n_in %d out %d ws %zu need %zu)\n", n_in, out_size, ws_size, (size_t)WS_END); grid = -1; return; }
        int dev = 0, cus = 0, per_cu = 0;
        (void)hipGetDevice(&dev); (void)hipDeviceGetAttribute(&cus, hipDeviceAttributeMultiprocessorCount, dev);
        (void)hipFuncSetAttribute((const void*)fwd, hipFuncAttributeMaxDynamicSharedMemorySize, LDS_BYTES);
        if (hipOccupancyMaxActiveBlocksPerMultiprocessor(&per_cu, (const void*)fwd, NTHR, LDS_BYTES) != hipSuccess || per_cu < 1) { fprintf(stderr, "kernel_launch: occupancy query gave %d\n", per_cu); per_cu = 1; }
        (void)hipGetLastError();
        grid = cus * 1;
    }
    if (grid < 0) return;
    Args a{};
    for (int i = 0; i < 30; ++i) a.in[i] = (const float*)d_in[i];
    a.out = (float*)d_out; a.ws = (unsigned char*)d_ws;
    (void)hipMemsetAsync((unsigned char*)d_ws + WS_SS, 0, (size_t)1 * MiB, stream);
#if MK_MULTI
    for (int p = 0; p < NPH; ++p) { a.ph_lo = p; a.ph_hi = p + 1; hipLaunchKernelGGL(fwd, dim3(grid), dim3(NTHR), LDS_BYTES, stream, a); }
#else
    a.ph_lo = 0; a.ph_hi = NPH;
    void* args[] = {&a};
    hipError_t e = hipLaunchCooperativeKernel((const void*)fwd, dim3(grid), dim3(NTHR), args, LDS_BYTES, stream);
    if (e != hipSuccess) fprintf(stderr, "cooperative launch failed: %s (grid %d)\n", hipGetErrorString(e), grid);
#endif
}
```

```cpp
#include <hip/hip_runtime.h>
#include <hip/hip_cooperative_groups.h>
#include <cstdio>
#include <cstdint>
#include <cmath>
namespace cg = cooperative_groups;
#ifndef REP_CONVERT
#define REP_CONVERT 1
#endif
#ifndef REP_SSM
#define REP_SSM 1
#endif
#ifndef REP_ATT
#define REP_ATT 1
#endif
#ifndef MK_MULTI
#define MK_MULTI 0
#endif
namespace pg8 {
#define PG8_LAS __attribute__((address_space(3)))
typedef unsigned short bf16_t;
typedef short bf16x8 __attribute__((ext_vector_type(8)));
typedef float f32x4 __attribute__((ext_vector_type(4)));
typedef unsigned u32x4 __attribute__((ext_vector_type(4)));
constexpr int BM = 256, BK = 64, HALF = 128, HTB = HALF * BK * 2  , STAGE_BYTES = 8 * HTB, NXCD = 8, WGM = 8;

__host__ __device__ __forceinline__ int lds_byte(int r, int c) { const int st = (r >> 4) * 2 + (c >> 5), rr = r & 15, cc = c & 31, ob = rr * 64 + cc * 2; return st * 1024 + (ob ^ (((ob >> 9) & 1) << 5)); }
__host__ __device__ __forceinline__ void stage_rc(int b, int& R, int& C) { const int st = b / 1024, sb = b % 1024, swz = sb ^ (((sb >> 9) & 1) << 5); R = (st >> 1) * 16 + swz / 64; C = (st & 1) * 32 + (swz % 64) / 2; }
__host__ __device__ __forceinline__ int perm32(int rho) { const int n = rho >> 4, i = rho & 15; return 8 * (i >> 2) + 4 * n + (i & 3); }

struct Unit { int pm, pn; };
struct Gemm { const bf16_t* A; const bf16_t* Bt; int M, N, K, lda; };

struct StaticOrder {
    int nM, nN, nwg, G, c;
    __host__ __device__ void init(int M, int N, int G_, int c_) { nM = M / BM; nN = N / BM; nwg = nM * nN; G = G_; c = c_; }
    __host__ __device__ bool next(int i, Unit& u) const {
        const long L = (long)i * G + c; if (L >= nwg) return false;
        int wgid = (int)L; { const int q = nwg / NXCD, r = nwg % NXCD, xcd = wgid % NXCD, off = wgid / NXCD; wgid = (xcd < r ? xcd * (q + 1) : r * (q + 1) + (xcd - r) * q) + off; }
        const int nig = WGM * nN, gid = wgid / nig, fm = gid * WGM, gsz = (nM - fm) < WGM ? (nM - fm) : WGM;
        u.pm = fm + ((wgid % nig) % gsz); u.pn = (wgid % nig) / gsz; return true;
    }
    __device__ __forceinline__ void a_ready(const Unit&) const {}
    __device__ __forceinline__ void done(const Unit&) const {}
};

__device__ __forceinline__ unsigned cvt_pk_bf16(float lo, float hi) { unsigned r; asm volatile("v_cvt_pk_bf16_f32 %0, %1, %2" : "=v"(r) : "v"(lo), "v"(hi)); return r; }
__device__ __forceinline__ float bf_lo(unsigned w) { return __uint_as_float(w << 16); }
__device__ __forceinline__ float bf_hi(unsigned w) { return __uint_as_float(w & 0xffff0000u); }
__device__ __forceinline__ float sigm(float x) { return __builtin_amdgcn_rcpf(1.f + __expf(-x)); }
__device__ __forceinline__ float gelu_t(float x) { const float p = __builtin_fmaf(x * x, -0.10294324f, -2.30220819f); return x * __builtin_amdgcn_rcpf(1.f + __builtin_amdgcn_exp2f(x * p)); }
__device__ __forceinline__ f32x4 sigm4(f32x4 v) { return (f32x4){sigm(v[0]), sigm(v[1]), sigm(v[2]), sigm(v[3])}; }
__device__ __forceinline__ f32x4 gelu4(f32x4 v) { return (f32x4){gelu_t(v[0]), gelu_t(v[1]), gelu_t(v[2]), gelu_t(v[3])}; }
__device__ __forceinline__ u32x4 pack8(f32x4 a, f32x4 b) { u32x4 w; w.x = cvt_pk_bf16(a[0], a[1]); w.y = cvt_pk_bf16(a[2], a[3]); w.z = cvt_pk_bf16(b[0], b[1]); w.w = cvt_pk_bf16(b[2], b[3]); return w; }
__device__ __forceinline__ void unpack8(u32x4 w, f32x4& a, f32x4& b) { a = (f32x4){bf_lo(w.x), bf_hi(w.x), bf_lo(w.y), bf_hi(w.y)}; b = (f32x4){bf_lo(w.z), bf_hi(w.z), bf_lo(w.w), bf_hi(w.w)}; }
enum { EP_INPROJ = 0, EP_GLU = 1, EP_MERGE0 = 2, EP_MERGE1 = 3, EP_RESID = 4, EP_RAW = 5, EP_UPCONV = 6 };
template <int CTRL> __device__ __forceinline__ float dpp_f(float x) { return __builtin_bit_cast(float, __builtin_amdgcn_update_dpp(0, __builtin_bit_cast(int, x), CTRL, 0xf, 0xf, false)); }
template <int CTRL> __device__ __forceinline__ f32x4 dpp4(f32x4 v) { return (f32x4){dpp_f<CTRL>(v[0]), dpp_f<CTRL>(v[1]), dpp_f<CTRL>(v[2]), dpp_f<CTRL>(v[3])}; }
template <int MODE> struct Epi {
    static constexpr bool PERM = true, AFTER_DRAIN = false;
    void* O; int ldc; const float* bias; const bf16_t* aux; int ldaux; const float* xin; float* raw; const float* ss; bf16_t* xb; float* ssout;
    __device__ __forceinline__ void operator()(const f32x4 (&acc)[2][2][4][2], const Unit& u, int wr, int wc, int fr, int fq) const {
        const int row0 = u.pm * BM + wr * 64 + fr, col0 = u.pn * BM + wc * 32 + 8 * fq;
        if constexpr (MODE == EP_UPCONV) {
            constexpr int NUPc = 11264, DFFc = 5632;
            const int cgl = u.pn * 128 + wc * 32 + 8 * fq, tcol = u.pn * 256 + wc * 32 + 8 * fq;
            float rs[2][4];
#pragma unroll
            for (int ai = 0; ai < 2; ++ai)
#pragma unroll
                for (int m = 0; m < 4; ++m) rs[ai][m] = rsqrtf(ss[row0 + ai * HALF + m * 16] * (1.f / 2048.f) + 1e-6f);
#pragma unroll
            for (int ai = 0; ai < 2; ++ai) {
                const int slab = u.pm * 4 + ai * 2 + wr;
                if (fr < 2) {
#pragma unroll
                    for (int bj = 0; bj < 2; ++bj)
#pragma unroll
                        for (int n = 0; n < 2; ++n) *(f32x4*)(raw + (size_t)(slab * 4 + fr) * NUPc + tcol + bj * 128 + 4 * n) = acc[ai][bj][0][n] * rs[ai][0];
                }
                if (fr >= 14) {
#pragma unroll
                    for (int bj = 0; bj < 2; ++bj)
#pragma unroll
                        for (int n = 0; n < 2; ++n) *(f32x4*)(raw + (size_t)(slab * 4 + fr - 12) * NUPc + tcol + bj * 128 + 4 * n) = acc[ai][bj][3][n] * rs[ai][3];
                }
            }
#pragma unroll
            for (int n = 0; n < 2; ++n) {
                const int c = cgl + 4 * n;
                const f32x4 wg0 = *(const f32x4*)(bias + c), wg1 = *(const f32x4*)(bias + NUPc + c), wg2 = *(const f32x4*)(bias + 2 * NUPc + c), bg = *(const f32x4*)(xin + c);
                const f32x4 wv0 = *(const f32x4*)(bias + DFFc + c), wv1 = *(const f32x4*)(bias + NUPc + DFFc + c), wv2 = *(const f32x4*)(bias + 2 * NUPc + DFFc + c), bv = *(const f32x4*)(xin + DFFc + c);
#pragma unroll
                for (int ai = 0; ai < 2; ++ai) {
                    f32x4 pg1 = (f32x4){0.f, 0.f, 0.f, 0.f}, pg2 = pg1, pv1 = pg1, pv2 = pg1;
#pragma unroll
                    for (int m = 0; m < 4; ++m) {
                        const f32x4 g = acc[ai][0][m][n] * rs[ai][m], v = acc[ai][1][m][n] * rs[ai][m];
                        const f32x4 g1 = dpp4<0x121>(g), g2 = dpp4<0x122>(g), v1 = dpp4<0x121>(v), v2 = dpp4<0x122>(v);
                        const f32x4 gp1 = (fr >= 1) ? g1 : pg1, gp2 = (fr >= 2) ? g2 : pg2, vp1 = (fr >= 1) ? v1 : pv1, vp2 = (fr >= 2) ? v2 : pv2;
                        const f32x4 cgt = bg + wg0 * g + wg1 * gp1 + wg2 * gp2, cvl = bv + wv0 * v + wv1 * vp1 + wv2 * vp2;
                        const f32x4 o = gelu4(cgt) * cvl;
                        typedef unsigned u32x2e __attribute__((ext_vector_type(2)));
                        u32x2e w; w.x = cvt_pk_bf16(o[0], o[1]); w.y = cvt_pk_bf16(o[2], o[3]);
                        if (!(m == 0 && fr < 2)) *(u32x2e*)((bf16_t*)O + (size_t)(row0 + ai * HALF + m * 16) * DFFc + c) = w;
                        pg1 = g1; pg2 = g2; pv1 = v1; pv2 = v2;
                    }
                }
            }
            return;
        }
        int kind = 0;
        if (MODE == EP_INPROJ) kind = (u.pn >= 12) ? 2 : ((u.pn >= 6 && u.pn < 10) ? 1 : 0);
        float rsr[2][4]; f32x4 cb0[2], cb1[2];
#pragma unroll
        for (int bj = 0; bj < 2; ++bj) { cb0[bj] = (f32x4){0.f, 0.f, 0.f, 0.f}; cb1[bj] = cb0[bj]; }
        if (MODE == EP_INPROJ) {
#pragma unroll
            for (int ai = 0; ai < 2; ++ai)
#pragma unroll
                for (int m = 0; m < 4; ++m) rsr[ai][m] = rsqrtf(ss[row0 + ai * HALF + m * 16] * (1.f / 2048.f) + 1e-6f);
            if (kind == 2) {
#pragma unroll
                for (int bj = 0; bj < 2; ++bj) { cb0[bj] = *(const f32x4*)(bias + (col0 + bj * HALF - 3072)); cb1[bj] = *(const f32x4*)(bias + (col0 + bj * HALF - 3072) + 4); }
            }
        }
        if (MODE == EP_GLU) {
#pragma unroll
            for (int bj = 0; bj < 2; ++bj) { cb0[bj] = *(const f32x4*)(bias + col0 + bj * HALF); cb1[bj] = *(const f32x4*)(bias + col0 + bj * HALF + 4); }
        }
#pragma unroll
        for (int ai = 0; ai < 2; ++ai)
#pragma unroll
            for (int m = 0; m < 4; ++m) {
                const size_t row = (size_t)(row0 + ai * HALF + m * 16);
                float ssq = 0.f;
#pragma unroll
                for (int bj = 0; bj < 2; ++bj) {
                    const int col = col0 + bj * HALF;
                    f32x4 v0 = acc[ai][bj][m][0], v1 = acc[ai][bj][m][1];
                    if (MODE == EP_INPROJ) {
                        const float rs = rsr[ai][m];
                        v0 = v0 * rs; v1 = v1 * rs;
                        if (kind == 1) { v0 = gelu4(v0); v1 = gelu4(v1); }
                        else if (kind == 2) { v0 = sigm4(v0 + cb0[bj]); v1 = sigm4(v1 + cb1[bj]); }
                        *(u32x4*)((bf16_t*)O + row * ldc + col) = pack8(v0, v1);
                    } else if (MODE == EP_GLU) {
                        f32x4 y0, y1; unpack8(*(const u32x4*)(aux + row * ldaux + col), y0, y1);
                        v0 = y0 * sigm4(v0 + cb0[bj]); v1 = y1 * sigm4(v1 + cb1[bj]);
                        *(u32x4*)((bf16_t*)O + row * ldc + col) = pack8(v0, v1);
                    } else if (MODE == EP_MERGE0 || MODE == EP_MERGE1) {
                        f32x4 g0, g1; unpack8(*(const u32x4*)(aux + row * ldaux + col), g0, g1);
                        v0 = g0 * v0; v1 = g1 * v1;
                        if (MODE == EP_MERGE1) { f32x4 o0, o1; unpack8(*(const u32x4*)((const bf16_t*)O + row * ldc + col), o0, o1); v0 = v0 + o0; v1 = v1 + o1; }
                        *(u32x4*)((bf16_t*)O + row * ldc + col) = pack8(v0, v1);
                    } else if (MODE == EP_RESID) {
                        f32x4 x0, x1; unpack8(*(const u32x4*)(xb + row * ldc + col), x0, x1); x0 = x0 + v0; x1 = x1 + v1;
                        if (O) { *(f32x4*)((float*)O + row * ldc + col) = x0; *(f32x4*)((float*)O + row * ldc + col + 4) = x1; }
                        if (ssout) {
                            *(u32x4*)(xb + row * ldc + col) = pack8(x0, x1);
                            const float q = (x0[0] * x0[0] + x0[1] * x0[1]) + (x0[2] * x0[2] + x0[3] * x0[3]) + (x1[0] * x1[0] + x1[1] * x1[1]) + (x1[2] * x1[2] + x1[3] * x1[3]);
                            if (bj == 0) ssq = q; else ssq += q;
                        }
                    } else {
                        *(u32x4*)((bf16_t*)O + row * ldc + col) = pack8(v0, v1);
                    }
                }
                if (MODE == EP_RESID) { if (ssout) { ssq += __shfl_xor(ssq, 16); ssq += __shfl_xor(ssq, 32); if (fq == 0) unsafeAtomicAdd(ssout + row, ssq); } }
                if (m == 3) asm volatile("" ::: "memory");
            }
    }
};
template <class Epi, class Sched, bool ALIGN_EPI = false, bool SP2 = false>
__device__ __forceinline__ void gemm_phase(PG8_LAS unsigned char* lds, const Gemm g, const Sched& S, const Epi& E, int wave_in) {
    int tid_ = wave_in * 64 + (int)__builtin_amdgcn_mbcnt_hi(~0u, __builtin_amdgcn_mbcnt_lo(~0u, 0u)); asm volatile("" : "+v"(tid_));
    const int tid = tid_, wid = __builtin_amdgcn_readfirstlane(tid >> 6), lane = tid & 63, wr = wid >> 2, wc = wid & 3, fr = lane & 15, fq = lane >> 4;
    const int K = g.K, nt = K / BK;
    unsigned voffA[2], voffB[2];
#pragma unroll
    for (int i = 0; i < 2; ++i) { int R, C; stage_rc(tid * 16 + i * 8192, R, C); const int Rb = Epi::PERM ? ((R & ~31) + perm32(R & 31)) : R;
        voffA[i] = (unsigned)(R * g.lda + C) * 2u; voffB[i] = (unsigned)(Rb * K + C) * 2u; }
    const size_t kstep = (size_t)(BK * 2);
    const size_t hstep = (size_t)HALF * K * 2;
    const size_t tstep = 2 * hstep; const size_t hstepA = (size_t)HALF * g.lda * 2, tstepA = 2 * hstepA;
    const unsigned ldsw = (unsigned)wid * 1024u;
    const int aoff = lds_byte(wr * 64 + fr, fq * 8), boff = lds_byte(wc * 32 + fr, fq * 8);
#define PG8_SA(b, h) (((b) * 2 + (h)) * HTB)
#define PG8_SB(b, h) ((4 + (b) * 2 + (h)) * HTB)
#define PG8_STAGE(bufoff, gbase, voff) do { _Pragma("unroll") for (int _i = 0; _i < 2; ++_i) \
        __builtin_amdgcn_global_load_lds((const unsigned*)((const char*)(gbase) + (voff)[_i]), (PG8_LAS unsigned*)(lds + (bufoff) + ldsw + _i * 8192), 16, 0, 0); } while (0)
#define PG8_LDA(dst, b, h) do { _Pragma("unroll") for (int m = 0; m < 4; ++m) _Pragma("unroll") for (int k = 0; k < 2; ++k) dst[m][k] = *(const PG8_LAS bf16x8*)(lds + PG8_SA(b, h) + aoff + m * 2048 + k * 1024); } while (0)
#define PG8_LDB(dst, b, h) do { _Pragma("unroll") for (int n = 0; n < 2; ++n) _Pragma("unroll") for (int k = 0; k < 2; ++k) dst[n][k] = *(const PG8_LAS bf16x8*)(lds + PG8_SB(b, h) + boff + n * 2048 + k * 1024); } while (0)
#define PG8_MMA(ai, bj, At, Bt) do { __builtin_amdgcn_s_setprio(1); _Pragma("unroll") for (int m = 0; m < 4; ++m) _Pragma("unroll") for (int n = 0; n < 2; ++n) _Pragma("unroll") for (int k = 0; k < 2; ++k) \
        acc[ai][bj][m][n] = __builtin_amdgcn_mfma_f32_16x16x32_bf16(Bt[n][k], At[m][k], acc[ai][bj][m][n], 0, 0, 0); __builtin_amdgcn_s_setprio(0); } while (0)
#define PG8_WAIT_V(n) asm volatile("s_waitcnt vmcnt(" #n ")" ::: "memory")
#define PG8_WAIT_L(n) asm volatile("s_waitcnt lgkmcnt(" #n ")" ::: "memory")
#define PG8_BAR __builtin_amdgcn_s_barrier()
#define PG8_SCHED __builtin_amdgcn_sched_barrier(0)
    Unit cur, nxt; int ui = 0;
    if (!S.next(0, cur)) return;
    f32x4 acc[2][2][4][2];
#pragma unroll
    for (int a = 0; a < 2; ++a)
#pragma unroll
        for (int b = 0; b < 2; ++b)
#pragma unroll
            for (int m = 0; m < 4; ++m)
#pragma unroll
                for (int n = 0; n < 2; ++n) acc[a][b][m][n] = (f32x4){0.f, 0.f, 0.f, 0.f};
    bf16x8 At[4][2], B0[2][2], B1[2][2];
    const char* cA = (const char*)g.A + (size_t)cur.pm * tstepA; const char* cB = (const char*)g.Bt + (size_t)cur.pn * tstep;
    S.a_ready(cur);
    if constexpr (SP2) {
        PG8_STAGE(PG8_SB(0, 0), cB, voffB); PG8_STAGE(PG8_SB(0, 1), cB + hstep, voffB); PG8_STAGE(PG8_SA(0, 0), cA, voffA); PG8_STAGE(PG8_SA(0, 1), cA + hstepA, voffA);
        if (wr == 1) PG8_BAR;
        PG8_WAIT_V(2); PG8_BAR;
        PG8_STAGE(PG8_SB(1, 0), cB + kstep, voffB); PG8_STAGE(PG8_SA(1, 0), cA + kstep, voffA); PG8_STAGE(PG8_SB(1, 1), cB + hstep + kstep, voffB);
        PG8_WAIT_V(6); PG8_BAR;
    } else {
        PG8_STAGE(PG8_SB(0, 0), cB, voffB); PG8_STAGE(PG8_SA(0, 0), cA, voffA); PG8_STAGE(PG8_SB(0, 1), cB + hstep, voffB); PG8_STAGE(PG8_SA(0, 1), cA + hstepA, voffA);
        if (wr == 1) PG8_BAR;
        PG8_WAIT_V(4); PG8_BAR;
        PG8_STAGE(PG8_SB(1, 0), cB + kstep, voffB); PG8_STAGE(PG8_SA(1, 0), cA + kstep, voffA); PG8_STAGE(PG8_SB(1, 1), cB + hstep + kstep, voffB);
        PG8_WAIT_V(6); PG8_BAR;
    }
    for (;;) {
        const bool has_next = S.next(ui + 1, nxt);
        const char* nA = has_next ? (const char*)g.A + (size_t)nxt.pm * tstepA : cA; const char* nB = has_next ? (const char*)g.Bt + (size_t)nxt.pn * tstep : cB;
        for (int t = 0; t < nt; t += 2) {
            const bool last = (t == nt - 2);
            const char* a1 = cA + (size_t)(t + 1) * kstep;
            const char* a2 = last ? nA : cA + (size_t)(t + 2) * kstep; const char* b2 = last ? nB : cB + (size_t)(t + 2) * kstep;
            const char* a3 = a2 + kstep; const char* b3 = b2 + kstep;
            if (last && has_next) S.a_ready(nxt);
            if constexpr (SP2) {
            PG8_LDB(B0, 0, 0); PG8_LDB(B1, 0, 1); PG8_SCHED; PG8_LDA(At, 0, 0); PG8_STAGE(PG8_SA(1, 1), a1 + hstepA, voffA);
            PG8_WAIT_V(8); PG8_WAIT_L(0); PG8_BAR; PG8_MMA(0, 0, At, B0); PG8_MMA(0, 1, At, B1); PG8_BAR; PG8_SCHED;
            PG8_LDA(At, 0, 1); PG8_STAGE(PG8_SB(0, 0), b2, voffB); PG8_STAGE(PG8_SB(0, 1), b2 + hstep, voffB); PG8_STAGE(PG8_SA(0, 0), a2, voffA);
            PG8_WAIT_V(8); PG8_WAIT_L(0); PG8_BAR; PG8_MMA(1, 0, At, B0); PG8_MMA(1, 1, At, B1); PG8_BAR; PG8_SCHED;
            PG8_LDB(B0, 1, 0); PG8_LDB(B1, 1, 1); PG8_SCHED; PG8_LDA(At, 1, 0); PG8_STAGE(PG8_SA(0, 1), a2 + hstepA, voffA);
            PG8_WAIT_V(8); PG8_WAIT_L(0); PG8_BAR; PG8_MMA(0, 0, At, B0); PG8_MMA(0, 1, At, B1); PG8_BAR; PG8_SCHED;
            PG8_LDA(At, 1, 1); PG8_STAGE(PG8_SB(1, 0), b3, voffB); PG8_STAGE(PG8_SB(1, 1), b3 + hstep, voffB); PG8_STAGE(PG8_SA(1, 0), a3, voffA);
            PG8_WAIT_V(8); PG8_WAIT_L(0); PG8_BAR; PG8_MMA(1, 0, At, B0); PG8_MMA(1, 1, At, B1); PG8_BAR; PG8_SCHED;
            } else {
            PG8_LDB(B0, 0, 0); PG8_SCHED; PG8_LDA(At, 0, 0); PG8_STAGE(PG8_SA(1, 1), a1 + hstepA, voffA);
            PG8_WAIT_L(8); PG8_BAR; PG8_WAIT_L(0); PG8_MMA(0, 0, At, B0); PG8_BAR; PG8_SCHED;
            PG8_LDB(B1, 0, 1); PG8_STAGE(PG8_SB(0, 0), b2, voffB);
            PG8_BAR; PG8_WAIT_L(0); PG8_MMA(0, 1, At, B1); PG8_BAR;
            PG8_LDA(At, 0, 1); PG8_STAGE(PG8_SA(0, 0), a2, voffA);
            PG8_BAR; PG8_WAIT_L(0); PG8_MMA(1, 0, At, B0); PG8_BAR; PG8_SCHED;
            PG8_STAGE(PG8_SB(0, 1), b2 + hstep, voffB);
            PG8_WAIT_V(6); PG8_BAR; PG8_MMA(1, 1, At, B1); PG8_BAR;
            PG8_LDB(B0, 1, 0); PG8_SCHED; PG8_LDA(At, 1, 0); PG8_STAGE(PG8_SA(0, 1), a2 + hstepA, voffA);
            PG8_WAIT_L(8); PG8_BAR; PG8_WAIT_L(0); PG8_MMA(0, 0, At, B0); PG8_BAR; PG8_SCHED;
            PG8_LDB(B1, 1, 1); PG8_STAGE(PG8_SB(1, 0), b3, voffB);
            PG8_BAR; PG8_WAIT_L(0); PG8_MMA(0, 1, At, B1); PG8_BAR;
            PG8_LDA(At, 1, 1); PG8_STAGE(PG8_SA(1, 0), a3, voffA);
            PG8_BAR; PG8_WAIT_L(0); PG8_MMA(1, 0, At, B0); PG8_BAR; PG8_SCHED;
            PG8_STAGE(PG8_SB(1, 1), b3 + hstep, voffB);
            PG8_WAIT_V(6); PG8_BAR; PG8_MMA(1, 1, At, B1); PG8_BAR;
            }
        }
        if constexpr (ALIGN_EPI) { if (wr == 0) PG8_BAR; }
        if constexpr (!Epi::AFTER_DRAIN) { E(acc, cur, wr, wc, fr, fq); S.done(cur); }
        if (!has_next) break;
#pragma unroll
        for (int a = 0; a < 2; ++a)
#pragma unroll
            for (int b = 0; b < 2; ++b)
#pragma unroll
                for (int m = 0; m < 4; ++m)
#pragma unroll
                    for (int n = 0; n < 2; ++n) acc[a][b][m][n] = (f32x4){0.f, 0.f, 0.f, 0.f};
        cur = nxt; cA = nA; cB = nB; ++ui;
        if constexpr (ALIGN_EPI) { if (wr == 1) PG8_BAR; }
    }
    PG8_WAIT_V(0);
    if constexpr (!ALIGN_EPI) { if (wr == 0) PG8_BAR; }
    PG8_BAR;
    if constexpr (Epi::AFTER_DRAIN) { E.fused(acc, cur, wr, wc, fr, fq, lds, wid, lane); S.done(cur); }
#undef PG8_SA
#undef PG8_SB
#undef PG8_STAGE
#undef PG8_LDA
#undef PG8_LDB
#undef PG8_MMA
#undef PG8_WAIT_V
#undef PG8_WAIT_L
#undef PG8_BAR
#undef PG8_SCHED
}
}

namespace mk {
using pg8::bf16_t; using pg8::bf16x8; using pg8::f32x4; using pg8::u32x4; using pg8::bf_lo; using pg8::bf_hi; using pg8::cvt_pk_bf16; using pg8::gelu_t;
#define LAS __attribute__((address_space(3)))
typedef unsigned u32x2 __attribute__((ext_vector_type(2)));
constexpr int M = 16384, D = 2048, SEQ = 8192, INW = 9216, DFF = 5632, NUP = 11264, MH = 8192;
constexpr int NWAVES = 8, NTHR = 512;
constexpr int LDS_BYTES = 143360;
constexpr float EPS = 1e-6f;
constexpr size_t O_WIN = 0, O_WA = O_WIN + (size_t)INW * D * 2, O_WSG = O_WA + (size_t)D * 1024 * 2, O_WSSM = O_WSG + (size_t)D * 512 * 2, O_WOUT = O_WSSM + (size_t)D * 512 * 2,
                 O_WUP = O_WOUT + (size_t)D * D * 2, O_WDN = O_WUP + (size_t)NUP * D * 2, O_WGLU = O_WDN + (size_t)D * DFF * 2, WLAYER = O_WGLU + (size_t)512 * 512 * 2;
constexpr size_t MiB = 1u << 20;
constexpr size_t WS_W = 0, WS_XB = 119 * MiB, WS_MRG = WS_XB + 64 * MiB, WS_PROJ = WS_MRG + 64 * MiB, WS_YCAT = WS_PROJ + 288 * MiB, WS_YS = WS_YCAT + 64 * MiB, WS_SST = WS_YS + 16 * MiB, WS_SS = WS_SST + 2 * MiB, WS_BAR = WS_SS + 512 * 1024, WS_COEF = WS_SS + 768 * 1024, WS_END = WS_SS + 1 * MiB;
static_assert(WLAYER <= 119 * MiB, "one layer of bf16 weights");
constexpr size_t WS_ACT = WS_PROJ, WS_RAW = WS_PROJ + 176 * MiB;
static_assert(WLAYER % 256 == 0 && (size_t)M * INW * 2 == 288 * MiB && (size_t)M * DFF * 2 == 176 * MiB && (size_t)256 * 4 * NUP * 4 <= 112 * MiB, "ws map");
constexpr int PPL = 10, NPH = PPL * 2;

struct Args { const float* in[30]; float* out; unsigned char* ws; int ph_lo, ph_hi; };
typedef __attribute__((address_space(4))) const Args CArgs;

__device__ __forceinline__ float wave_sum(float v) {
#pragma unroll
    for (int o = 1; o < 64; o <<= 1) v += __shfl_xor(v, o);
    return v;
}
__device__ __forceinline__ unsigned f2bf(float f) { unsigned u = __builtin_bit_cast(unsigned, f); return (u + 0x7fffu + ((u >> 16) & 1u)) >> 16; }
__device__ __forceinline__ unsigned pk2(float lo, float hi) { return f2bf(lo) | (f2bf(hi) << 16); }

__device__ __forceinline__ void titem_load(const float* W, int N, int item, int lane, float (&wv)[32]) {
    const int nblk = N / 32, kb = item / nblk, nb = item % nblk;
    const float* wp = W + (size_t)(64 * kb + (lane >> 5)) * N + 32 * nb + (lane & 31);
#pragma unroll
    for (int i = 0; i < 32; ++i) wv[i] = __builtin_nontemporal_load(wp + (size_t)(2 * i) * N);
}
__device__ __forceinline__ void titem_finish(const float (&wv)[32], int K, int N, bf16_t* WT, LAS float* scr, int item, int lane, bool upperm, const float* gain) {
    const int nblk = N / 32, kb = item / nblk, nb = item % nblk, k0 = 64 * kb, n0 = 32 * nb;
    int nd0 = n0; if (upperm) { const int hi = n0 >= 5632, nn = n0 - hi * 5632; nd0 = 256 * (nn >> 7) + 128 * hi + (nn & 127); }
#pragma unroll
    for (int i = 0; i < 32; ++i) scr[(2 * i + (lane >> 5)) * 33 + (lane & 31)] = wv[i];
    asm volatile("s_waitcnt lgkmcnt(0)" ::: "memory");
    const int c = lane & 7;
    f32x4 g0 = (f32x4){1.f, 1.f, 1.f, 1.f}, g1 = g0;
    if (gain) { g0 = *(const f32x4*)(gain + k0 + 8 * c); g1 = *(const f32x4*)(gain + k0 + 8 * c + 4); }
#pragma unroll
    for (int j = 0; j < 4; ++j) { const int n = (lane >> 3) + 8 * j; const LAS float* s = scr + (8 * c) * 33 + n;
        u32x4 o; o.x = cvt_pk_bf16(s[0 * 33] * g0[0], s[1 * 33] * g0[1]); o.y = cvt_pk_bf16(s[2 * 33] * g0[2], s[3 * 33] * g0[3]); o.z = cvt_pk_bf16(s[4 * 33] * g1[0], s[5 * 33] * g1[1]); o.w = cvt_pk_bf16(s[6 * 33] * g1[2], s[7 * 33] * g1[3]);
        *(u32x4*)(WT + (size_t)(nd0 + n) * K + k0 + 8 * c) = o; }
    asm volatile("s_waitcnt lgkmcnt(0)" ::: "memory");
}
__device__ __forceinline__ void convert_phase(CArgs* ap, int l, LAS unsigned char* lds, int gw, int NGW, int wave, int lane) {
    LAS float* scr = (LAS float*)(lds + wave * 8448);
    {
        unsigned char* wb = ap->ws + WS_W;
#pragma unroll 1
        for (int mi = 0; mi < 8; ++mi) {
            const float* W; int K, N; size_t off;
            switch (mi) {
                case 0: W = ap->in[2] + (size_t)l * D * INW; K = D; N = INW; off = O_WIN; break;
                case 1: W = ap->in[21] + (size_t)l * 1024 * D; K = 1024; N = D; off = O_WA; break;
                case 2: W = ap->in[22] + (size_t)l * 512 * D; K = 512; N = D; off = O_WSG; break;
                case 3: W = ap->in[23] + (size_t)l * 512 * D; K = 512; N = D; off = O_WSSM; break;
                case 4: W = ap->in[24] + (size_t)l * D * D; K = D; N = D; off = O_WOUT; break;
                case 5: W = ap->in[26] + (size_t)l * D * NUP; K = D; N = NUP; off = O_WUP; break;
                case 6: W = ap->in[29] + (size_t)l * DFF * D; K = DFF; N = D; off = O_WDN; break;
                default: W = ap->in[19] + (size_t)l * 512 * 512; K = 512; N = 512; off = O_WGLU; break;
            }
            const int nitems = (K / 64) * (N / 32);
            const float* gain = mi == 0 ? ap->in[1] + l * D : (mi == 5 ? ap->in[25] + l * D : nullptr);
            float wc[32], wn[32];
            int it = gw;
            if (it < nitems) titem_load(W, N, it, lane, wc);
            while (it < nitems) {
                const int nx = it + NGW;
                if (nx < nitems) titem_load(W, N, nx, lane, wn);
                titem_finish(wc, K, N, (bf16_t*)(wb + off), scr, it, lane, mi == 5, gain);
#pragma unroll
                for (int i = 0; i < 32; ++i) wc[i] = wn[i];
                it = nx;
            }
        }
    }
}

__device__ __forceinline__ void xb_phase(const float* x, bf16_t* XB, float* SS, int gw, int NGW, int lane) {
    for (int m = gw; m < M; m += NGW) {
        const f32x4* xr = (const f32x4*)(x + (size_t)m * D) + lane;
        f32x4 v[8]; float s = 0.f;
#pragma unroll
        for (int j = 0; j < 8; ++j) { v[j] = xr[64 * j]; s += (v[j][0] * v[j][0] + v[j][1] * v[j][1]) + (v[j][2] * v[j][2] + v[j][3] * v[j][3]); }
        s = wave_sum(s);
        if (lane == 0) SS[m] = s;
        u32x2* o = (u32x2*)(XB + (size_t)m * D) + lane;
#pragma unroll
        for (int j = 0; j < 8; ++j) { u32x2 w; w.x = pk2(v[j][0], v[j][1]); w.y = pk2(v[j][2], v[j][3]); o[64 * j] = w; }
    }
}

__device__ __forceinline__ bf16x8 as_bf8(u32x4 w) { return __builtin_bit_cast(bf16x8, w); }

__device__ __forceinline__ void attn_unit(LAS unsigned char* lds, const bf16_t* PROJ, bf16_t* YCAT, const float* qg, const float* kg, const float* sinks, int unit, int tid, int wave, int lane) {
    const int kvh = unit & 1, blk = (unit >> 1) & 63, b = unit >> 7;
    const int t0 = b * SEQ + blk * 128;
    LAS bf16_t* Ks = (LAS bf16_t*)lds; LAS bf16_t* Vt = (LAS bf16_t*)(lds + 69632);
    {
        const int c16 = tid & 15;
        const f32x4 g0 = *(const f32x4*)(kg + 8 * c16), g1 = *(const f32x4*)(kg + 8 * c16 + 4);
#pragma unroll 2
        for (int pass = 0; pass < 8; ++pass) {
            const int kidx = (tid >> 4) + 32 * pass;
            u32x4 w = {0u, 0u, 0u, 0u};
            if (!(blk == 0 && pass < 4)) w = *(const u32x4*)(PROJ + (size_t)(t0 - 128 + kidx) * INW + 1024 + kvh * 128 + 8 * c16);
            f32x4 v0, v1; pg8::unpack8(w, v0, v1);
            float ss = (v0[0] * v0[0] + v0[1] * v0[1]) + (v0[2] * v0[2] + v0[3] * v0[3]) + (v1[0] * v1[0] + v1[1] * v1[1]) + (v1[2] * v1[2] + v1[3] * v1[3]);
            ss += __shfl_xor(ss, 1); ss += __shfl_xor(ss, 2); ss += __shfl_xor(ss, 4); ss += __shfl_xor(ss, 8);
            const float rs = rsqrtf(ss * (1.f / 128.f) + EPS);
            *(LAS u32x4*)(Ks + kidx * 136 + 8 * c16) = pg8::pack8(v0 * rs * g0, v1 * rs * g1);
        }
    }
    {
#pragma unroll 1
        for (int rg = 0; rg < 4; ++rg) {
            const int kidx = 64 * rg + lane, kk = kidx & 31, pos = (kidx & ~31) + 8 * ((kk >> 2) & 3) + 4 * (kk >> 4) + (kk & 3);
#pragma unroll
            for (int cc = 0; cc < 2; ++cc) {
                const int c16 = 2 * wave + cc;
                u32x4 w = {0u, 0u, 0u, 0u};
                if (!(blk == 0 && rg < 2)) w = *(const u32x4*)(PROJ + (size_t)(t0 - 128 + kidx) * INW + 1280 + kvh * 128 + 8 * c16);
                LAS bf16_t* d = Vt + (8 * c16) * 264 + pos;
                d[0 * 264] = (bf16_t)(w.x & 0xffffu); d[1 * 264] = (bf16_t)(w.x >> 16); d[2 * 264] = (bf16_t)(w.y & 0xffffu); d[3 * 264] = (bf16_t)(w.y >> 16);
                d[4 * 264] = (bf16_t)(w.z & 0xffffu); d[5 * 264] = (bf16_t)(w.z >> 16); d[6 * 264] = (bf16_t)(w.w & 0xffffu); d[7 * 264] = (bf16_t)(w.w >> 16);
            }
        }
    }
    __syncthreads();
    const int fr = lane & 15, fq = lane >> 4, qrow = 16 * wave + fr;
#pragma unroll 1
    for (int hq = 4 * kvh; hq < 4 * kvh + 4; ++hq) {
    bf16x8 qf[4];
    {
        const bf16_t* qp = PROJ + (size_t)(t0 + qrow) * INW + hq * 128 + 8 * fq;
        u32x4 w[4]; float ss = 0.f;
#pragma unroll
        for (int ks = 0; ks < 4; ++ks) { w[ks] = *(const u32x4*)(qp + 32 * ks); f32x4 v0, v1; pg8::unpack8(w[ks], v0, v1);
            ss += (v0[0] * v0[0] + v0[1] * v0[1]) + (v0[2] * v0[2] + v0[3] * v0[3]) + (v1[0] * v1[0] + v1[1] * v1[1]) + (v1[2] * v1[2] + v1[3] * v1[3]); }
        ss += __shfl_xor(ss, 16); ss += __shfl_xor(ss, 32);
        const float rs = rsqrtf(ss * (1.f / 128.f) + EPS) * 0.08838834764831845f;
#pragma unroll
        for (int ks = 0; ks < 4; ++ks) { f32x4 v0, v1; pg8::unpack8(w[ks], v0, v1);
            const f32x4 g0 = *(const f32x4*)(qg + 32 * ks + 8 * fq), g1 = *(const f32x4*)(qg + 32 * ks + 8 * fq + 4);
            qf[ks] = as_bf8(pg8::pack8(v0 * rs * g0, v1 * rs * g1)); }
    }
    const int wp = wave & ~1;
    f32x4 s[10];
#pragma unroll
    for (int rel = 0; rel < 10; ++rel) {
        s[rel] = (f32x4){0.f, 0.f, 0.f, 0.f};
#pragma unroll
        for (int ks = 0; ks < 4; ++ks) {
            const bf16x8 kf = *(const LAS bf16x8*)(Ks + (16 * (wp + rel) + fr) * 136 + 32 * ks + 8 * fq);
            s[rel] = __builtin_amdgcn_mfma_f32_16x16x32_bf16(kf, qf[ks], s[rel], 0, 0, 0);
        }
    }
    const float slope = exp2f(-(float)(hq + 1)), sink = sinks[hq];
    const int qidx = 128 + qrow;
    float mx = -INFINITY;
#pragma unroll
    for (int rel = 0; rel < 10; ++rel)
#pragma unroll
        for (int i = 0; i < 4; ++i) {
            const int kidx = 16 * (wp + rel) + 4 * fq + i, dist = qidx - kidx;
            const bool valid = (dist >= 0) && (dist < 128) && (blk > 0 || kidx >= 128);
            const float val = valid ? s[rel][i] - slope * (float)dist : -INFINITY;
            s[rel][i] = val; mx = fmaxf(mx, val);
        }
    mx = fmaxf(mx, __shfl_xor(mx, 16)); mx = fmaxf(mx, __shfl_xor(mx, 32));
    const float mm = fmaxf(mx, sink);
    float ls = 0.f;
#pragma unroll
    for (int rel = 0; rel < 10; ++rel)
#pragma unroll
        for (int i = 0; i < 4; ++i) { const float p = __expf(s[rel][i] - mm); s[rel][i] = p; ls += p; }
    ls += __shfl_xor(ls, 16); ls += __shfl_xor(ls, 32);
    const float inv = 1.f / (ls + __expf(sink - mm));
    bf16x8 pf[5];
#pragma unroll
    for (int g = 0; g < 5; ++g) pf[g] = as_bf8(pg8::pack8(s[2 * g], s[2 * g + 1]));
    bf16_t* op = YCAT + (size_t)(t0 + qrow) * D + hq * 128 + 4 * fq;
#pragma unroll
    for (int db = 0; db < 8; ++db) {
        f32x4 o = (f32x4){0.f, 0.f, 0.f, 0.f};
#pragma unroll
        for (int g = 0; g < 5; ++g) {
            const bf16x8 vf = *(const LAS bf16x8*)(Vt + (16 * db + fr) * 264 + 32 * ((wp >> 1) + g) + 8 * fq);
            o = __builtin_amdgcn_mfma_f32_16x16x32_bf16(vf, pf[g], o, 0, 0, 0);
        }
        u32x2 w; w.x = cvt_pk_bf16(o[0] * inv, o[1] * inv); w.y = cvt_pk_bf16(o[2] * inv, o[3] * inv);
        *(u32x2*)(op + 16 * db) = w;
    }
    }
    __syncthreads();
}

__device__ __forceinline__ void sg_unit(LAS unsigned char* lds, const bf16_t* PROJ, bf16_t* YCAT, const float* lng, const float* lnb, const float* sgw, const float* sgb, int unit, int tid, int wave, int lane) {
    const int g = unit & 3, ch = (unit >> 2) & 63, b = unit >> 8;
    const int t0 = b * SEQ + ch * 128;
    LAS bf16_t* Zt = (LAS bf16_t*)lds; LAS float* st = (LAS float*)(lds + 34816);
    const bf16_t* zv = PROJ + (size_t)t0 * INW + 2048 + g * 128;
    {
        const int c16 = tid & 15;
#pragma unroll
        for (int pass = 0; pass < 4; ++pass) {
            const int r = (tid >> 4) + 32 * pass;
            f32x4 v0, v1; pg8::unpack8(*(const u32x4*)(zv + (size_t)r * INW + 8 * c16), v0, v1);
            float sm = (v0[0] + v0[1]) + (v0[2] + v0[3]) + (v1[0] + v1[1]) + (v1[2] + v1[3]);
            sm += __shfl_xor(sm, 1); sm += __shfl_xor(sm, 2); sm += __shfl_xor(sm, 4); sm += __shfl_xor(sm, 8);
            const float mean = sm * (1.f / 128.f);
            v0 = v0 - mean; v1 = v1 - mean;
            float q = (v0[0] * v0[0] + v0[1] * v0[1]) + (v0[2] * v0[2] + v0[3] * v0[3]) + (v1[0] * v1[0] + v1[1] * v1[1]) + (v1[2] * v1[2] + v1[3] * v1[3]);
            q += __shfl_xor(q, 1); q += __shfl_xor(q, 2); q += __shfl_xor(q, 4); q += __shfl_xor(q, 8);
            if (c16 == 0) { st[2 * r] = mean; st[2 * r + 1] = rsqrtf(q * (1.f / 128.f) + EPS); }
        }
    }
    __syncthreads();
#pragma unroll 1
    for (int rg = 0; rg < 2; ++rg) {
        const int r = 64 * rg + lane; const float mean = st[2 * r], rstd = st[2 * r + 1];
#pragma unroll
        for (int cc = 0; cc < 2; ++cc) {
            const int c16 = 2 * wave + cc;
            f32x4 v0, v1; pg8::unpack8(*(const u32x4*)(zv + (size_t)r * INW + 8 * c16), v0, v1);
            const f32x4 a0 = *(const f32x4*)(lng + g * 128 + 8 * c16), a1 = *(const f32x4*)(lng + g * 128 + 8 * c16 + 4);
            const f32x4 b0 = *(const f32x4*)(lnb + g * 128 + 8 * c16), b1 = *(const f32x4*)(lnb + g * 128 + 8 * c16 + 4);
            v0 = (v0 - mean) * rstd * a0 + b0; v1 = (v1 - mean) * rstd * a1 + b1;
            LAS bf16_t* d = Zt + (8 * c16) * 136 + r;
            d[0 * 136] = (bf16_t)f2bf(v0[0]); d[1 * 136] = (bf16_t)f2bf(v0[1]); d[2 * 136] = (bf16_t)f2bf(v0[2]); d[3 * 136] = (bf16_t)f2bf(v0[3]);
            d[4 * 136] = (bf16_t)f2bf(v1[0]); d[5 * 136] = (bf16_t)f2bf(v1[1]); d[6 * 136] = (bf16_t)f2bf(v1[2]); d[7 * 136] = (bf16_t)f2bf(v1[3]);
        }
    }
    __syncthreads();
    const int fr = lane & 15, fq = lane >> 4, t = 16 * wave + fr, nks = (wave >> 1) + 1;
    bf16x8 wf[4];
#pragma unroll
    for (int ks = 0; ks < 4; ++ks) {
        u32x4 w = {0u, 0u, 0u, 0u};
        if (ks < nks) {
            const float* wp = sgw + ((size_t)(g * 128 + t)) * 128 + 32 * ks + 8 * fq;
            f32x4 a0 = *(const f32x4*)wp, a1 = *(const f32x4*)(wp + 4);
            const int s0 = 32 * ks + 8 * fq;
#pragma unroll
            for (int i = 0; i < 4; ++i) { if (s0 + i > t) a0[i] = 0.f; if (s0 + 4 + i > t) a1[i] = 0.f; }
            w = pg8::pack8(a0, a1);
        }
        wf[ks] = as_bf8(w);
    }
    const float bs = sgb[g * 128 + t];
    const bf16_t* zu = PROJ + (size_t)(t0 + t) * INW + 1536 + g * 128 + 4 * fq;
    bf16_t* op = YCAT + (size_t)(t0 + t) * D + 1024 + g * 128 + 4 * fq;
#pragma unroll
    for (int cb = 0; cb < 8; ++cb) {
        f32x4 acc = (f32x4){0.f, 0.f, 0.f, 0.f};
#pragma unroll
        for (int ks = 0; ks < 4; ++ks) if (ks < nks) {
            const bf16x8 zf = *(const LAS bf16x8*)(Zt + (16 * cb + fr) * 136 + 32 * ks + 8 * fq);
            acc = __builtin_amdgcn_mfma_f32_16x16x32_bf16(zf, wf[ks], acc, 0, 0, 0);
        }
        const u32x2 zw = *(const u32x2*)(zu + 16 * cb);
        u32x2 w; w.x = cvt_pk_bf16(bf_lo(zw.x) * (acc[0] + bs), bf_hi(zw.x) * (acc[1] + bs)); w.y = cvt_pk_bf16(bf_lo(zw.y) * (acc[2] + bs), bf_hi(zw.y) * (acc[3] + bs));
        *(u32x2*)(op + 16 * cb) = w;
    }
    __syncthreads();
}

template <bool P3> __device__ __forceinline__ void ssm_unit(CArgs* ap, const float* COEF, int l, const bf16_t* PROJ, float* SST, bf16_t* YS, LAS unsigned char* wlds, int unit, int lane) {
    const int c = unit & 63, g = (unit >> 6) & 31, b = unit >> 11;
    const int fr = lane & 15, fq = lane >> 4;
    float pr[4][4], pi[4][4]; bf16x8 bfr[8];
#pragma unroll
    for (int cb = 0; cb < 4; ++cb) {
        const int gp = (l * 32 + g) * 64 + 16 * cb + fr;
        const f32x4 cf = *(const f32x4*)(COEF + (size_t)(g * 64 + 16 * cb + fr) * 4);
        const float abr = cf[0], abi = cf[1];
        pr[cb][0] = abr; pi[cb][0] = abi;
#pragma unroll
        for (int i = 1; i < 4; ++i) { pr[cb][i] = pr[cb][i - 1] * abr - pi[cb][i - 1] * abi; pi[cb][i] = pr[cb][i - 1] * abi + pi[cb][i - 1] * abr; }
        const float cr = cf[2], ci = cf[3];
        u32x4 wre = {0u, 0u, 0u, 0u}, wim = {0u, 0u, 0u, 0u};
        if (fq < 2) {
            const float* br = ap->in[14] + (size_t)gp * 16 + 8 * fq; const float* bi = ap->in[15] + (size_t)gp * 16 + 8 * fq;
            const f32x4 r0 = *(const f32x4*)br, r1 = *(const f32x4*)(br + 4), i0 = *(const f32x4*)bi, i1 = *(const f32x4*)(bi + 4);
            wre = pg8::pack8(cr * r0 - ci * i0, cr * r1 - ci * i1); wim = pg8::pack8(cr * i0 + ci * r0, cr * i1 + ci * r1);
        }
        bfr[cb] = as_bf8(wre); bfr[cb + 4] = as_bf8(wim);
    }
    bf16x8 cmf[4]; float dsk = 0.f;
    if (P3) {
#pragma unroll
        for (int ks = 0; ks < 4; ++ks) {
            const int k0 = 32 * ks + 8 * fq;
            const float* src = (ks < 2 ? ap->in[16] : ap->in[17]) + ((size_t)(l * 32 + g) * 16 + fr) * 64 + (ks < 2 ? k0 : k0 - 64);
            f32x4 c0 = *(const f32x4*)src, c1 = *(const f32x4*)(src + 4);
            if (ks >= 2) { c0 = -c0; c1 = -c1; }
            cmf[ks] = as_bf8(pg8::pack8(c0, c1));
        }
        dsk = ap->in[18][l * 512 + g * 16 + fr];
    }
    float hr[4], hi[4];
#pragma unroll
    for (int cb = 0; cb < 4; ++cb) { hr[cb] = 0.f; hi[cb] = 0.f; }
    if (P3) {
        float tr[4], ti[4];
#pragma unroll
        for (int cb = 0; cb < 4; ++cb) { tr[cb] = pr[cb][3]; ti[cb] = pi[cb][3];
#pragma unroll
            for (int k = 0; k < 5; ++k) { const float nr = tr[cb] * tr[cb] - ti[cb] * ti[cb], ni = 2.f * tr[cb] * ti[cb]; tr[cb] = nr; ti[cb] = ni; } }
        const float* sp = SST + ((size_t)(unit - c) * 64 + fr) * 2;
        for (int cc = 0; cc < c; ++cc) {
#pragma unroll
            for (int cb = 0; cb < 4; ++cb) { const float2 s = *(const float2*)(sp + (size_t)cc * 128 + 32 * cb);
                const float nr = tr[cb] * hr[cb] - ti[cb] * hi[cb] + s.x, ni = tr[cb] * hi[cb] + ti[cb] * hr[cb] + s.y; hr[cb] = nr; hi[cb] = ni; }
        }
    }
    const size_t row0 = (size_t)(b * SEQ + c * 128);
    LAS bf16_t* Hs = (LAS bf16_t*)wlds;
    u32x4 uwn = {0u, 0u, 0u, 0u};
    if (fq < 2) uwn = *(const u32x4*)(PROJ + (row0 + fr) * INW + 2560 + g * 16 + 8 * fq);
#pragma unroll 1
    for (int blk = 0; blk < 8; ++blk) {
        const u32x4 uw = uwn;
        if (fq < 2) uwn = *(const u32x4*)(PROJ + (row0 + 16 * (blk < 7 ? blk + 1 : blk) + fr) * INW + 2560 + g * 16 + 8 * fq);
        const bf16x8 uf = as_bf8(uw);
        f32x4 bu[8];
#pragma unroll
        for (int k = 0; k < 8; ++k) bu[k] = __builtin_amdgcn_mfma_f32_16x16x32_bf16(uf, bfr[k], (f32x4){0.f, 0.f, 0.f, 0.f}, 0, 0, 0);
#pragma unroll
        for (int cb = 0; cb < 4; ++cb) {
            const float ar = pr[cb][0], ai = pi[cb][0], a4r = pr[cb][3], a4i = pi[cb][3];
            float lr_[4], li_[4];
            lr_[0] = bu[cb][0]; li_[0] = bu[cb + 4][0];
#pragma unroll
            for (int i = 1; i < 4; ++i) { lr_[i] = ar * lr_[i - 1] - ai * li_[i - 1] + bu[cb][i]; li_[i] = ar * li_[i - 1] + ai * lr_[i - 1] + bu[cb + 4][i]; }
            float cr = hr[cb], ci = hi[cb];
#pragma unroll
            for (int j = 0; j < 3; ++j) {
                const float er = __shfl(lr_[3], fr + 16 * j), ei = __shfl(li_[3], fr + 16 * j);
                const float nr = a4r * cr - a4i * ci + er, ni = a4r * ci + a4i * cr + ei;
                if (j < fq) { cr = nr; ci = ni; }
            }
            float h_r[4], h_i[4];
#pragma unroll
            for (int i = 0; i < 4; ++i) { h_r[i] = lr_[i] + pr[cb][i] * cr - pi[cb][i] * ci; h_i[i] = li_[i] + pr[cb][i] * ci + pi[cb][i] * cr; }
            hr[cb] = __shfl(h_r[3], fr + 48); hi[cb] = __shfl(h_i[3], fr + 48);
            if (P3) {
#pragma unroll
                for (int i = 0; i < 4; ++i) { Hs[(4 * fq + i) * 136 + 16 * cb + fr] = (bf16_t)f2bf(h_r[i]); Hs[(4 * fq + i) * 136 + 64 + 16 * cb + fr] = (bf16_t)f2bf(h_i[i]); }
            }
        }
        if (P3) {
            f32x4 y = (f32x4){0.f, 0.f, 0.f, 0.f};
            asm volatile("s_waitcnt lgkmcnt(0)" ::: "memory");
            bf16x8 hf[4];
#pragma unroll
            for (int ks = 0; ks < 4; ++ks) hf[ks] = *(const LAS bf16x8*)(Hs + fr * 136 + 32 * ks + 8 * fq);
            asm volatile("s_waitcnt lgkmcnt(0)" ::: "memory");
#pragma unroll
            for (int ks = 0; ks < 4; ++ks) y = __builtin_amdgcn_mfma_f32_16x16x32_bf16(hf[ks], cmf[ks], y, 0, 0, 0);
#pragma unroll
            for (int i = 0; i < 4; ++i) {
                const size_t row = row0 + 16 * blk + 4 * fq + i;
                const float uu = __uint_as_float(((unsigned)PROJ[row * INW + 2560 + g * 16 + fr]) << 16);
                YS[row * 512 + g * 16 + fr] = (bf16_t)f2bf(gelu_t(y[i] + dsk * uu));
            }
        }
    }
    if (!P3) { if (fq == 0) {
#pragma unroll
        for (int cb = 0; cb < 4; ++cb) *(float2*)(SST + ((size_t)unit * 64 + 16 * cb + fr) * 2) = make_float2(hr[cb], hi[cb]); } }
}

__device__ __forceinline__ void ssm_coef_phase(CArgs* ap, int l, float* COEF, int gw, int lane) {
    if (gw < 32) {
        const int g = gw, p = lane;
        const float dt = expf(ap->in[13][l * 32 + g]);
        const float lr = ap->in[11][(l * 32 + g) * 64 + p], li = ap->in[12][(l * 32 + g) * 64 + p];
        const float x = lr * dt, y = li * dt;
        const float ex = expf(x), cs = cosf(y), sn = sinf(y), sh = sinf(0.5f * y);
        const float abr = ex * cs, abi = ex * sn;
        const float nr = expm1f(x) * cs - 2.f * sh * sh, ni = abi;
        const float den = 1.f / (lr * lr + li * li);
        *(f32x4*)(COEF + (size_t)(g * 64 + p) * 4) = (f32x4){abr, abi, (nr * lr + ni * li) * den, (ni * lr - nr * li) * den};
    }
}
__device__ __forceinline__ void ssm_setup(CArgs* ap, const float* COEF, int l, int g, int p, float& abr, float& abi, float (&bbr)[16], float (&bbi)[16]) {
    const f32x4 cf = *(const f32x4*)(COEF + (size_t)(g * 64 + p) * 4);
    abr = cf[0]; abi = cf[1];
    const float cr = cf[2], ci = cf[3];
    const float* br = ap->in[14] + ((size_t)(l * 32 + g) * 64 + p) * 16; const float* bi = ap->in[15] + ((size_t)(l * 32 + g) * 64 + p) * 16;
#pragma unroll
    for (int q = 0; q < 4; ++q) { const f32x4 r4 = *(const f32x4*)(br + 4 * q), i4 = *(const f32x4*)(bi + 4 * q);
#pragma unroll
        for (int i = 0; i < 4; ++i) { bbr[4 * q + i] = cr * r4[i] - ci * i4[i]; bbi[4 * q + i] = cr * i4[i] + ci * r4[i]; } }
}
__device__ __forceinline__ void load_u16(const bf16_t* p, float (&u)[16]) {
    const u32x4 w0 = ((const u32x4*)p)[0], w1 = ((const u32x4*)p)[1];
    u[0] = bf_lo(w0.x); u[1] = bf_hi(w0.x); u[2] = bf_lo(w0.y); u[3] = bf_hi(w0.y); u[4] = bf_lo(w0.z); u[5] = bf_hi(w0.z); u[6] = bf_lo(w0.w); u[7] = bf_hi(w0.w);
    u[8] = bf_lo(w1.x); u[9] = bf_hi(w1.x); u[10] = bf_lo(w1.y); u[11] = bf_hi(w1.y); u[12] = bf_lo(w1.z); u[13] = bf_hi(w1.z); u[14] = bf_lo(w1.w); u[15] = bf_hi(w1.w);
}
__device__ __forceinline__ void ssm_pass1(CArgs* ap, const float* COEF, int l, const bf16_t* PROJ, float* SST, int unit, int lane) {
    const int c = unit & 63, g = (unit >> 6) & 31, b = unit >> 11;
    float abr, abi, bbr[16], bbi[16];
    ssm_setup(ap, COEF, l, g, lane, abr, abi, bbr, bbi);
    const bf16_t* up = PROJ + (size_t)(b * SEQ + c * 128) * INW + 2560 + g * 16;
    float hr = 0.f, hi = 0.f;
#pragma unroll 4
    for (int t = 0; t < 128; ++t) {
        float u[16]; load_u16(up + (size_t)t * INW, u);
        float br = 0.f, bi = 0.f;
#pragma unroll
        for (int k = 0; k < 16; ++k) { br += bbr[k] * u[k]; bi += bbi[k] * u[k]; }
        const float nr = abr * hr - abi * hi + br, ni = abr * hi + abi * hr + bi; hr = nr; hi = ni;
    }
    *(float2*)(SST + ((size_t)unit * 64 + lane) * 2) = make_float2(hr, hi);
}
template <int HALFN> __device__ __forceinline__ void rs_stage(float (&v)[64], int lane) {
    if constexpr (HALFN == 32 || HALFN == 16) {
#pragma unroll
        for (int i = 0; i < HALFN; ++i) {
            float a = v[i], b = v[i + HALFN];
            if constexpr (HALFN == 32) asm volatile("s_nop 1\n\tv_permlane32_swap_b32 %0, %1" : "+v"(a), "+v"(b));
            else asm volatile("s_nop 1\n\tv_permlane16_swap_b32 %0, %1" : "+v"(a), "+v"(b));
            v[i] = a + b;
        }
    } else {
        const bool bit = (lane & HALFN) != 0;
#pragma unroll
        for (int i = 0; i < HALFN; ++i) { const float keep = bit ? v[i + HALFN] : v[i], send = bit ? v[i] : v[i + HALFN]; v[i] = keep + __shfl_xor(send, HALFN); }
    }
}
__device__ __forceinline__ void ssm_pass3(CArgs* ap, const float* COEF, int l, const bf16_t* PROJ, const float* SST, bf16_t* YS, int unit, int lane) {
    const int c = unit & 63, g = (unit >> 6) & 31, b = unit >> 11;
    float abr, abi, bbr[16], bbi[16];
    ssm_setup(ap, COEF, l, g, lane, abr, abi, bbr, bbi);
    typedef float f32x2v __attribute__((ext_vector_type(2)));
    f32x2v cre2[8], cim2[8], bb2[16];
#pragma unroll
    for (int k = 0; k < 8; ++k) { cre2[k] = (f32x2v){ap->in[16][((size_t)(l * 32 + g) * 16 + 2 * k) * 64 + lane], ap->in[16][((size_t)(l * 32 + g) * 16 + 2 * k + 1) * 64 + lane]};
        cim2[k] = (f32x2v){ap->in[17][((size_t)(l * 32 + g) * 16 + 2 * k) * 64 + lane], ap->in[17][((size_t)(l * 32 + g) * 16 + 2 * k + 1) * 64 + lane]}; }
#pragma unroll
    for (int k = 0; k < 16; ++k) bb2[k] = (f32x2v){bbr[k], bbi[k]};
    const float dsk = ap->in[18][l * 512 + g * 16 + (lane & 15)];
    float tr = abr, ti = abi;
#pragma unroll
    for (int k = 0; k < 7; ++k) { const float nr = tr * tr - ti * ti, ni = 2.f * tr * ti; tr = nr; ti = ni; }
    float hr = 0.f, hi = 0.f;
    const float* sp = SST + ((size_t)(unit - c) * 64 + lane) * 2;
    int cc = 0;
    for (; cc + 8 <= c; cc += 8) {
        float2 s8[8];
#pragma unroll
        for (int j = 0; j < 8; ++j) s8[j] = *(const float2*)(sp + (size_t)(cc + j) * 128);
#pragma unroll
        for (int j = 0; j < 8; ++j) { const float nr = tr * hr - ti * hi + s8[j].x, ni = tr * hi + ti * hr + s8[j].y; hr = nr; hi = ni; }
    }
    for (; cc < c; ++cc) { const float2 s = *(const float2*)(sp + (size_t)cc * 128); const float nr = tr * hr - ti * hi + s.x, ni = tr * hi + ti * hr + s.y; hr = nr; hi = ni; }
    const size_t row0 = (size_t)(b * SEQ + c * 128);
    const bf16_t* up = PROJ + row0 * INW + 2560 + g * 16;
    u32x4 wn[8];
#pragma unroll
    for (int tt = 0; tt < 4; ++tt) { wn[2 * tt] = ((const u32x4*)(up + (size_t)tt * INW))[0]; wn[2 * tt + 1] = ((const u32x4*)(up + (size_t)tt * INW))[1]; }
    const int ott = lane >> 4, ok = lane & 15;
    unsigned short uun = up[(size_t)ott * INW + ok];
#pragma unroll 1
    for (int t = 0; t < 128; t += 4) {
        float v[64];
        u32x4 wc[8];
#pragma unroll
        for (int j = 0; j < 8; ++j) wc[j] = wn[j];
        const unsigned short uuc = uun;
        const int tn = (t + 4 < 128) ? t + 4 : t;
#pragma unroll
        for (int tt = 0; tt < 4; ++tt) { wn[2 * tt] = ((const u32x4*)(up + (size_t)(tn + tt) * INW))[0]; wn[2 * tt + 1] = ((const u32x4*)(up + (size_t)(tn + tt) * INW))[1]; }
        uun = up[(size_t)(tn + ott) * INW + ok];
#pragma unroll
        for (int tt = 0; tt < 4; ++tt) {
            const u32x4 w0 = wc[2 * tt], w1 = wc[2 * tt + 1];
            float u[16];
            u[0] = bf_lo(w0.x); u[1] = bf_hi(w0.x); u[2] = bf_lo(w0.y); u[3] = bf_hi(w0.y); u[4] = bf_lo(w0.z); u[5] = bf_hi(w0.z); u[6] = bf_lo(w0.w); u[7] = bf_hi(w0.w);
            u[8] = bf_lo(w1.x); u[9] = bf_hi(w1.x); u[10] = bf_lo(w1.y); u[11] = bf_hi(w1.y); u[12] = bf_lo(w1.z); u[13] = bf_hi(w1.z); u[14] = bf_lo(w1.w); u[15] = bf_hi(w1.w);
            f32x2v b2 = (f32x2v){0.f, 0.f};
#pragma unroll
            for (int k = 0; k < 16; ++k) b2 += bb2[k] * u[k];
            const float nr = abr * hr - abi * hi + b2.x, ni = abr * hi + abi * hr + b2.y; hr = nr; hi = ni;
#pragma unroll
            for (int k = 0; k < 8; ++k) { const f32x2v p = cre2[k] * hr - cim2[k] * hi; v[tt * 16 + 2 * k] = p.x; v[tt * 16 + 2 * k + 1] = p.y; }
        }
        rs_stage<32>(v, lane); rs_stage<16>(v, lane); rs_stage<8>(v, lane); rs_stage<4>(v, lane); rs_stage<2>(v, lane); rs_stage<1>(v, lane);
        const float uu = __uint_as_float(((unsigned)uuc) << 16);
        const float y = gelu_t(v[0] + dsk * uu);
        YS[(row0 + t + ott) * 512 + g * 16 + ok] = (bf16_t)f2bf(y);
    }
}

__device__ __forceinline__ void fixup_phase(const float* RAW, bf16_t* ACT, const float* cw, const float* cb, int gtid, int nthr) {
    constexpr int NC4 = DFF / 4;
    for (int it = gtid; it < 256 * 2 * NC4; it += nthr) {
        const int c = (it % NC4) * 4, r = (it / NC4) & 1, sl = it / (2 * NC4);
        const int tc = (c >> 7) * 256 + (c & 127);
        const float* base = RAW + (size_t)sl * 4 * NUP + tc; const float* prev = base - (size_t)4 * NUP;
        const bool first = (sl & 127) == 0;
        const f32x4 z = (f32x4){0.f, 0.f, 0.f, 0.f};
        const f32x4 g0 = *(const f32x4*)(base + (size_t)r * NUP), v0 = *(const f32x4*)(base + (size_t)r * NUP + 128);
        const f32x4 g63 = first ? z : *(const f32x4*)(prev + (size_t)3 * NUP), v63 = first ? z : *(const f32x4*)(prev + (size_t)3 * NUP + 128);
        f32x4 g1, g2, v1, v2;
        if (r == 1) { g1 = *(const f32x4*)base; v1 = *(const f32x4*)(base + 128); g2 = g63; v2 = v63; }
        else { g1 = g63; v1 = v63; g2 = first ? z : *(const f32x4*)(prev + (size_t)2 * NUP); v2 = first ? z : *(const f32x4*)(prev + (size_t)2 * NUP + 128); }
        const f32x4 cgt = *(const f32x4*)(cb + c) + *(const f32x4*)(cw + c) * g0 + *(const f32x4*)(cw + NUP + c) * g1 + *(const f32x4*)(cw + 2 * NUP + c) * g2;
        const f32x4 cvl = *(const f32x4*)(cb + DFF + c) + *(const f32x4*)(cw + DFF + c) * v0 + *(const f32x4*)(cw + NUP + DFF + c) * v1 + *(const f32x4*)(cw + 2 * NUP + DFF + c) * v2;
        const f32x4 o = pg8::gelu4(cgt) * cvl;
        u32x2 w; w.x = cvt_pk_bf16(o[0], o[1]); w.y = cvt_pk_bf16(o[2], o[3]);
        *(u32x2*)(ACT + (size_t)(64 * sl + r) * DFF + c) = w;
    }
}

#define XB_TMO      128
#define XB_XCNT(j)  (256  + 64 * (j))
#define XB_XSUB(j)  (1280 + 64 * (j))
#define XB_XGEN(j)  (2304 + 64 * (j))
#define XB_TOP      3328
#define XB_TOPGEN   3392
#define XCD_BAR_WORDS 3456
#define XB_SPIN_CAP (1u << 18)

__device__ __forceinline__ unsigned xb_ld(unsigned* p)              { return __hip_atomic_load(p, __ATOMIC_RELAXED, __HIP_MEMORY_SCOPE_AGENT); }
__device__ __forceinline__ unsigned xb_add(unsigned* p, unsigned v) { return __hip_atomic_fetch_add(p, v, __ATOMIC_RELAXED, __HIP_MEMORY_SCOPE_AGENT); }
__device__ __forceinline__ unsigned xb_xcc_id() { return (unsigned)__builtin_amdgcn_s_getreg((3 << 11) | 20) & 0xFu; }
#define XB_SPIN(cond, bar) do { unsigned _sp = 0; while (cond) { __builtin_amdgcn_s_sleep(1); \
    if ((++_sp & 255u) == 0u) { if (xb_ld(&(bar)[XB_TMO])) break; if (_sp > XB_SPIN_CAP) { atomicAdd(&(bar)[XB_TMO], 1u); break; } } } } while (0)

struct XcdBarrier {
    unsigned* bar; unsigned x;
    volatile LAS unsigned* st;
};

__device__ __forceinline__ XcdBarrier xcd_barrier_post(unsigned* bar, volatile LAS unsigned* st) {
    XcdBarrier b; b.bar = bar; b.x = xb_xcc_id(); b.st = st;
    if (threadIdx.x == 0) (void)xb_add(&bar[XB_XCNT(b.x)], 1u);
    return b;
}
__device__ __forceinline__ void xcd_barrier_complete(unsigned* bar, unsigned x, unsigned& nloc, unsigned& nx) {
    const unsigned G = gridDim.x * gridDim.y * gridDim.z;
    unsigned sum, cnt, mine, sp = 0u;
    for (;;) {
        sum = 0u; cnt = 0u; mine = 0u;
#pragma unroll
        for (unsigned j = 0; j < 16; ++j) { const unsigned c = xb_ld(&bar[XB_XCNT(j)]); sum += c; cnt += (c > 0u) ? 1u : 0u; mine = (j == x) ? c : mine; }
        if (sum == G) break;
        __builtin_amdgcn_s_sleep(1);
        if ((++sp & 255u) == 0u) { if (xb_ld(&bar[XB_TMO])) break; if (sp > XB_SPIN_CAP) { atomicAdd(&bar[XB_TMO], 1u); break; } }
    }
    nloc = mine > 0u ? mine : 1u; nx = cnt > 0u ? cnt : 1u;
}

__device__ __forceinline__ void xcd_barrier(const XcdBarrier& b) {
    asm volatile("s_waitcnt vmcnt(0)" ::: "memory");
    __syncthreads();
    if (threadIdx.x == 0) {
        unsigned* bar = b.bar;
        __builtin_amdgcn_s_waitcnt(0);
        unsigned nloc = b.st[0], nx = b.st[1];
        if (nloc == 0u) { xcd_barrier_complete(bar, b.x, nloc, nx); b.st[0] = nloc; b.st[1] = nx; }
        const unsigned old = xb_add(&bar[XB_XSUB(b.x)], 1u);
        const unsigned gen = old / nloc;
        if (old + 1u == (gen + 1u) * nloc) {
            __builtin_amdgcn_fence(__ATOMIC_RELEASE, "agent");
            asm volatile("s_waitcnt vmcnt(0)" ::: "memory");
            const unsigned og = xb_add(&bar[XB_TOP], 1u);
            const unsigned tg = og / nx;
            if (og + 1u == (tg + 1u) * nx) xb_add(&bar[XB_TOPGEN], 1u);
            else XB_SPIN(xb_ld(&bar[XB_TOPGEN]) == tg, bar);
            __builtin_amdgcn_fence(__ATOMIC_ACQUIRE, "agent");
            xb_add(&bar[XB_XGEN(b.x)], 1u);
            asm volatile("s_waitcnt vmcnt(0)" ::: "memory");
        } else {
            XB_SPIN(xb_ld(&bar[XB_XGEN(b.x)]) == gen, bar);
            __builtin_amdgcn_fence(__ATOMIC_ACQUIRE, "agent");
            asm volatile("s_waitcnt vmcnt(0)" ::: "memory");
        }
    }
    __syncthreads();
}

#ifdef ONLY_MODE
#define ONLY_MODE_OK(m) ((m) == ONLY_MODE)
#else
#define ONLY_MODE_OK(m) true
#endif
#ifndef PG8_SP2
#define PG8_SP2 true
#endif
#ifndef PG8_ALIGN
#define PG8_ALIGN true
#endif
template <int MODE> __device__ __forceinline__ void run_gemm(LAS unsigned char* lds, const bf16_t* A, int lda, const bf16_t* Bt, int Mr, int N, int K, const pg8::Epi<MODE>& E, int wave_in) {
    pg8::Gemm g{A, Bt, Mr, N, K, lda}; pg8::StaticOrder S; S.init(Mr, N, (int)gridDim.x, (int)blockIdx.x);
#if !defined(NO_GEMM) && (!defined(ONLY_MODE) || 1)
    if (ONLY_MODE_OK(MODE)) pg8::gemm_phase<pg8::Epi<MODE>, pg8::StaticOrder, PG8_ALIGN, PG8_SP2>(lds, g, S, E, wave_in);
#endif
}

__global__ void __launch_bounds__(NTHR, 2) fwd(Args a) {
    extern __shared__ __attribute__((aligned(16))) unsigned char lds_raw[];
    LAS unsigned char* lds = (LAS unsigned char*)lds_raw;
    cg::grid_group grid = cg::this_grid();
    const int ph_lo = a.ph_lo, ph_hi = a.ph_hi;
    const int wave_s = __builtin_amdgcn_readfirstlane((int)threadIdx.x >> 6);
    constexpr int MISC_OFF = 139264;
    if (threadIdx.x < 16) ((LAS unsigned*)(lds + MISC_OFF))[threadIdx.x] = 0u;
    __syncthreads();
    (void)xcd_barrier_post((unsigned*)(a.ws + WS_BAR), (volatile LAS unsigned*)(lds + MISC_OFF) + 8);
    for (int ph = ph_lo; ph < ph_hi; ++ph) {
        CArgs* ap = (CArgs*)__builtin_amdgcn_kernarg_segment_ptr();
        asm volatile("" : "+s"(ap));
        int tid_ = wave_s * 64 + (int)__builtin_amdgcn_mbcnt_hi(~0u, __builtin_amdgcn_mbcnt_lo(~0u, 0u)); asm volatile("" : "+v"(tid_));
        const int tid = tid_, lane = tid & 63, wave = wave_s;
        const int G = gridDim.x, gw = blockIdx.x * NWAVES + wave, NGW = G * NWAVES;
        unsigned char* ws = ap->ws;
        bf16_t* XB = (bf16_t*)(ws + WS_XB); bf16_t* MRG = (bf16_t*)(ws + WS_MRG);
        bf16_t* PROJ = (bf16_t*)(ws + WS_PROJ); bf16_t* YCAT = (bf16_t*)(ws + WS_YCAT); bf16_t* YS = (bf16_t*)(ws + WS_YS); float* SST = (float*)(ws + WS_SST);
        bf16_t* ACT = (bf16_t*)(ws + WS_ACT); float* RAW = (float*)(ws + WS_RAW);
        {
            const int l = ph / PPL, sp = ph % PPL;
            const unsigned char* wl = ws + WS_W;
            float* SS = (float*)(ws + WS_SS);
            float* COEF = (float*)(ws + WS_COEF);
            if (sp == 0) { ssm_coef_phase(ap, l, COEF, gw, lane); convert_phase(ap, l, lds, gw, NGW, wave, lane); if (l == 0) xb_phase(ap->in[0], XB, SS, gw, NGW, lane); }
            else if (sp == 1) { pg8::Epi<pg8::EP_INPROJ> E{PROJ, INW, ap->in[3] + l * 6144, nullptr, 0, nullptr, nullptr, SS + (size_t)(2 * l) * M, nullptr, nullptr}; run_gemm<pg8::EP_INPROJ>(lds, XB, D, (const bf16_t*)(wl + O_WIN), M, INW, D, E, wave); }
            else if (sp == 2) {
                for (int u = blockIdx.x; u < 256; u += G) attn_unit(lds, PROJ, YCAT, ap->in[4] + l * 128, ap->in[5] + l * 128, ap->in[6] + l * 8, u, tid, wave, lane);
                for (int u = blockIdx.x; u < 512; u += G) sg_unit(lds, PROJ, YCAT, ap->in[7] + l * 512, ap->in[8] + l * 512, ap->in[9] + (size_t)l * 4 * 128 * 128, ap->in[10] + l * 512, u, tid, wave, lane);
                for (int u = gw; u < 4096; u += NGW) ssm_unit<false>(ap, COEF, l, PROJ, SST, YS, lds + wave * 4352, u, lane);
            }
            else if (sp == 3) { for (int u = gw; u < 4096; u += NGW) ssm_pass3(ap, COEF, l, PROJ, SST, YS, u, lane); }
            else if (sp == 4) { pg8::Epi<pg8::EP_GLU> E{YCAT + 1536, D, ap->in[20] + l * 512, YS, 512, nullptr}; run_gemm<pg8::EP_GLU>(lds, YS, 512, (const bf16_t*)(wl + O_WGLU), M, 512, 512, E, wave); }
            else if (sp == 5) {
                { pg8::Epi<pg8::EP_MERGE0> E{MRG, D, nullptr, PROJ + 3072, INW, nullptr}; run_gemm<pg8::EP_MERGE0>(lds, YCAT, D, (const bf16_t*)(wl + O_WA), M, D, 1024, E, wave); }
#pragma unroll 1
                for (int j = 1; j < 3; ++j) { pg8::Epi<pg8::EP_MERGE1> E{MRG, D, nullptr, PROJ + 3072 + j * D, INW, nullptr};
                    run_gemm<pg8::EP_MERGE1>(lds, YCAT + 512 + 512 * j, D, (const bf16_t*)(wl + (j == 1 ? O_WSG : O_WSSM)), M, D, 512, E, wave); }
            }
            else if (sp == 7) { pg8::Epi<pg8::EP_UPCONV> E{ACT, DFF, ap->in[27] + (size_t)l * 3 * NUP, nullptr, 0, ap->in[28] + (size_t)l * NUP, RAW, SS + (size_t)(2 * l + 1) * M, nullptr, nullptr};
                run_gemm<pg8::EP_UPCONV>(lds, XB, D, (const bf16_t*)(wl + O_WUP), M, NUP, D, E, wave); }
            else if (sp == 8) fixup_phase(RAW, ACT, ap->in[27] + (size_t)l * 3 * NUP, ap->in[28] + (size_t)l * NUP, blockIdx.x * NTHR + tid, G * NTHR);
            else {
                const bf16_t* A; const bf16_t* Bt; int K; float* sso;
                if (sp == 6) { A = MRG; Bt = (const bf16_t*)(wl + O_WOUT); K = D; sso = SS + (size_t)(2 * l + 1) * M; }
                else { A = ACT; Bt = (const bf16_t*)(wl + O_WDN); K = DFF; sso = (l == 0) ? SS + (size_t)2 * M : nullptr; }
                pg8::Epi<pg8::EP_RESID> E{sso ? nullptr : ap->out, D, nullptr, nullptr, 0, nullptr, nullptr, nullptr, XB, sso};
                run_gemm<pg8::EP_RESID>(lds, A, K, Bt, M, D, K, E, wave);
            }
        }
        if (ph + 1 < ph_hi) {
            if (ph == ph_lo) grid.sync();
            else { XcdBarrier bar; bar.bar = (unsigned*)(ws + WS_BAR); bar.x = xb_xcc_id(); bar.st = (volatile LAS unsigned*)(lds + MISC_OFF) + 8; xcd_barrier(bar); }
        }
    }
}
}

extern "C" void kernel_launch(void* const* d_in, const int* in_sizes, int n_in, void* d_out, int out_size, void* d_ws, size_t ws_size, hipStream_t stream) {
    using namespace mk;
    static int grid = 0;
    if (grid == 0) {
        if (n_in != 30 || out_size != M * D || ws_size < WS_END) { fprintf(stderr, "kernel_launch: unexpected problem (n_in %d out %d ws %zu need %zu)\n", n_in, out_size, ws_size, (size_t)WS_END); grid = -1; return; }
        int dev = 0, cus = 0, per_cu = 0;
        (void)hipGetDevice(&dev); (void)hipDeviceGetAttribute(&cus, hipDeviceAttributeMultiprocessorCount, dev);
        (void)hipFuncSetAttribute((const void*)fwd, hipFuncAttributeMaxDynamicSharedMemorySize, LDS_BYTES);
        if (hipOccupancyMaxActiveBlocksPerMultiprocessor(&per_cu, (const void*)fwd, NTHR, LDS_BYTES) != hipSuccess || per_cu < 1) { fprintf(stderr, "kernel_launch: occupancy query gave %d\n", per_cu); per_cu = 1; }
        (void)hipGetLastError();
        grid = cus * 1;
    }
    if (grid < 0) return;
    Args a{};
    for (int i = 0; i < 30; ++i) a.in[i] = (const float*)d_in[i];
    a.out = (float*)d_out; a.ws = (unsigned char*)d_ws;
    (void)hipMemsetAsync((unsigned char*)d_ws + WS_SS, 0, (size_t)1 * MiB, stream);
#if MK_MULTI
    for (int p = 0; p < NPH; ++p) { a.ph_lo = p; a.ph_hi = p + 1; hipLaunchKernelGGL(fwd, dim3(grid), dim3(NTHR), LDS_BYTES, stream, a); }
#else
    a.ph_lo = 0; a.ph_hi = NPH;
    void* args[] = {&a};
    hipError_t e = hipLaunchCooperativeKernel((const void*)fwd, dim3(grid), dim3(NTHR), args, LDS_BYTES, stream);
    if (e != hipSuccess) fprintf(stderr, "cooperative launch failed: %s (grid %d)\n", hipGetErrorString(e), grid);
#endif
}
```

```cpp
#include <hip/hip_runtime.h>
#include <hip/hip_cooperative_groups.h>
#include <cstdio>
#include <cstdint>
#include <cmath>
namespace cg = cooperative_groups;
#ifndef REP_CONVERT
#define REP_CONVERT 1
#endif
#ifndef REP_SSM
#define REP_SSM 1
#endif
#ifndef REP_ATT
#define REP_ATT 1
#endif
#ifndef MK_MULTI
#define MK_MULTI 0
#endif
namespace pg8 {
#define PG8_LAS __attribute__((address_space(3)))
typedef unsigned short bf16_t;
typedef short bf16x8 __attribute__((ext_vector_type(8)));
typedef float f32x4 __attribute__((ext_vector_type(4)));
typedef unsigned u32x4 __attribute__((ext_vector_type(4)));
constexpr int BM = 256, BK = 64, HALF = 128, HTB = HALF * BK * 2  , STAGE_BYTES = 8 * HTB, NXCD = 8, WGM = 8;

__host__ __device__ __forceinline__ int lds_byte(int r, int c) { const int st = (r >> 4) * 2 + (c >> 5), rr = r & 15, cc = c & 31, ob = rr * 64 + cc * 2; return st * 1024 + (ob ^ (((ob >> 9) & 1) << 5)); }
__host__ __device__ __forceinline__ void stage_rc(int b, int& R, int& C) { const int st = b / 1024, sb = b % 1024, swz = sb ^ (((sb >> 9) & 1) << 5); R = (st >> 1) * 16 + swz / 64; C = (st & 1) * 32 + (swz % 64) / 2; }
__host__ __device__ __forceinline__ int perm32(int rho) { const int n = rho >> 4, i = rho & 15; return 8 * (i >> 2) + 4 * n + (i & 3); }

struct Unit { int pm, pn; };
struct Gemm { const bf16_t* A; const bf16_t* Bt; int M, N, K, lda; };

struct StaticOrder {
    int nM, nN, nwg, G, c;
    __host__ __device__ void init(int M, int N, int G_, int c_) { nM = M / BM; nN = N / BM; nwg = nM * nN; G = G_; c = c_; }
    __host__ __device__ bool next(int i, Unit& u) const {
        const long L = (long)i * G + c; if (L >= nwg) return false;
        int wgid = (int)L; { const int q = nwg / NXCD, r = nwg % NXCD, xcd = wgid % NXCD, off = wgid / NXCD; wgid = (xcd < r ? xcd * (q + 1) : r * (q + 1) + (xcd - r) * q) + off; }
        const int nig = WGM * nN, gid = wgid / nig, fm = gid * WGM, gsz = (nM - fm) < WGM ? (nM - fm) : WGM;
        u.pm = fm + ((wgid % nig) % gsz); u.pn = (wgid % nig) / gsz; return true;
    }
    __device__ __forceinline__ void a_ready(const Unit&) const {}
    __device__ __forceinline__ void done(const Unit&) const {}
};

__device__ __forceinline__ unsigned cvt_pk_bf16(float lo, float hi) { unsigned r; asm volatile("v_cvt_pk_bf16_f32 %0, %1, %2" : "=v"(r) : "v"(lo), "v"(hi)); return r; }
__device__ __forceinline__ float bf_lo(unsigned w) { return __uint_as_float(w << 16); }
__device__ __forceinline__ float bf_hi(unsigned w) { return __uint_as_float(w & 0xffff0000u); }
__device__ __forceinline__ float sigm(float x) { return __builtin_amdgcn_rcpf(1.f + __expf(-x)); }
__device__ __forceinline__ float gelu_t(float x) { const float p = __builtin_fmaf(x * x, -0.10294324f, -2.30220819f); return x * __builtin_amdgcn_rcpf(1.f + __builtin_amdgcn_exp2f(x * p)); }
__device__ __forceinline__ f32x4 sigm4(f32x4 v) { return (f32x4){sigm(v[0]), sigm(v[1]), sigm(v[2]), sigm(v[3])}; }
__device__ __forceinline__ f32x4 gelu4(f32x4 v) { return (f32x4){gelu_t(v[0]), gelu_t(v[1]), gelu_t(v[2]), gelu_t(v[3])}; }
__device__ __forceinline__ u32x4 pack8(f32x4 a, f32x4 b) { u32x4 w; w.x = cvt_pk_bf16(a[0], a[1]); w.y = cvt_pk_bf16(a[2], a[3]); w.z = cvt_pk_bf16(b[0], b[1]); w.w = cvt_pk_bf16(b[2], b[3]); return w; }
__device__ __forceinline__ void unpack8(u32x4 w, f32x4& a, f32x4& b) { a = (f32x4){bf_lo(w.x), bf_hi(w.x), bf_lo(w.y), bf_hi(w.y)}; b = (f32x4){bf_lo(w.z), bf_hi(w.z), bf_lo(w.w), bf_hi(w.w)}; }
enum { EP_INPROJ = 0, EP_GLU = 1, EP_MERGE0 = 2, EP_MERGE1 = 3, EP_RESID = 4, EP_RAW = 5, EP_UPCONV = 6 };
template <int CTRL> __device__ __forceinline__ float dpp_f(float x) { return __builtin_bit_cast(float, __builtin_amdgcn_update_dpp(0, __builtin_bit_cast(int, x), CTRL, 0xf, 0xf, false)); }
template <int CTRL> __device__ __forceinline__ f32x4 dpp4(f32x4 v) { return (f32x4){dpp_f<CTRL>(v[0]), dpp_f<CTRL>(v[1]), dpp_f<CTRL>(v[2]), dpp_f<CTRL>(v[3])}; }
template <int MODE> struct Epi {
    static constexpr bool PERM = true, AFTER_DRAIN = false;
    void* O; int ldc; const float* bias; const bf16_t* aux; int ldaux; const float* xin; float* raw; const float* ss; bf16_t* xb; float* ssout;
    __device__ __forceinline__ void operator()(const f32x4 (&acc)[2][2][4][2], const Unit& u, int wr, int wc, int fr, int fq) const {
        const int row0 = u.pm * BM + wr * 64 + fr, col0 = u.pn * BM + wc * 32 + 8 * fq;
        if constexpr (MODE == EP_UPCONV) {
            constexpr int NUPc = 11264, DFFc = 5632;
            const int cgl = u.pn * 128 + wc * 32 + 8 * fq, tcol = u.pn * 256 + wc * 32 + 8 * fq;
            float rs[2][4];
#pragma unroll
            for (int ai = 0; ai < 2; ++ai)
#pragma unroll
                for (int m = 0; m < 4; ++m) rs[ai][m] = rsqrtf(ss[row0 + ai * HALF + m * 16] * (1.f / 2048.f) + 1e-6f);
#pragma unroll
            for (int ai = 0; ai < 2; ++ai) {
                const int slab = u.pm * 4 + ai * 2 + wr;
                if (fr < 2) {
#pragma unroll
                    for (int bj = 0; bj < 2; ++bj)
#pragma unroll
                        for (int n = 0; n < 2; ++n) *(f32x4*)(raw + (size_t)(slab * 4 + fr) * NUPc + tcol + bj * 128 + 4 * n) = acc[ai][bj][0][n] * rs[ai][0];
                }
                if (fr >= 14) {
#pragma unroll
                    for (int bj = 0; bj < 2; ++bj)
#pragma unroll
                        for (int n = 0; n < 2; ++n) *(f32x4*)(raw + (size_t)(slab * 4 + fr - 12) * NUPc + tcol + bj * 128 + 4 * n) = acc[ai][bj][3][n] * rs[ai][3];
                }
            }
#pragma unroll
            for (int n = 0; n < 2; ++n) {
                const int c = cgl + 4 * n;
                const f32x4 wg0 = *(const f32x4*)(bias + c), wg1 = *(const f32x4*)(bias + NUPc + c), wg2 = *(const f32x4*)(bias + 2 * NUPc + c), bg = *(const f32x4*)(xin + c);
                const f32x4 wv0 = *(const f32x4*)(bias + DFFc + c), wv1 = *(const f32x4*)(bias + NUPc + DFFc + c), wv2 = *(const f32x4*)(bias + 2 * NUPc + DFFc + c), bv = *(const f32x4*)(xin + DFFc + c);
#pragma unroll
                for (int ai = 0; ai < 2; ++ai) {
                    f32x4 pg1 = (f32x4){0.f, 0.f, 0.f, 0.f}, pg2 = pg1, pv1 = pg1, pv2 = pg1;
#pragma unroll
                    for (int m = 0; m < 4; ++m) {
                        const f32x4 g = acc[ai][0][m][n] * rs[ai][m], v = acc[ai][1][m][n] * rs[ai][m];
                        const f32x4 g1 = dpp4<0x121>(g), g2 = dpp4<0x122>(g), v1 = dpp4<0x121>(v), v2 = dpp4<0x122>(v);
                        const f32x4 gp1 = (fr >= 1) ? g1 : pg1, gp2 = (fr >= 2) ? g2 : pg2, vp1 = (fr >= 1) ? v1 : pv1, vp2 = (fr >= 2) ? v2 : pv2;
                        const f32x4 cgt = bg + wg0 * g + wg1 * gp1 + wg2 * gp2, cvl = bv + wv0 * v + wv1 * vp1 + wv2 * vp2;
                        const f32x4 o = gelu4(cgt) * cvl;
                        typedef unsigned u32x2e __attribute__((ext_vector_type(2)));
                        u32x2e w; w.x = cvt_pk_bf16(o[0], o[1]); w.y = cvt_pk_bf16(o[2], o[3]);
                        if (!(m == 0 && fr < 2)) *(u32x2e*)((bf16_t*)O + (size_t)(row0 + ai * HALF + m * 16) * DFFc + c) = w;
                        pg1 = g1; pg2 = g2; pv1 = v1; pv2 = v2;
                    }
                }
            }
            return;
        }
        int kind = 0;
        if (MODE == EP_INPROJ) kind = (u.pn >= 12) ? 2 : ((u.pn >= 6 && u.pn < 10) ? 1 : 0);
        float rsr[2][4]; f32x4 cb0[2], cb1[2];
#pragma unroll
        for (int bj = 0; bj < 2; ++bj) { cb0[bj] = (f32x4){0.f, 0.f, 0.f, 0.f}; cb1[bj] = cb0[bj]; }
        if (MODE == EP_INPROJ) {
#pragma unroll
            for (int ai = 0; ai < 2; ++ai)
#pragma unroll
                for (int m = 0; m < 4; ++m) rsr[ai][m] = rsqrtf(ss[row0 + ai * HALF + m * 16] * (1.f / 2048.f) + 1e-6f);
            if (kind == 2) {
#pragma unroll
                for (int bj = 0; bj < 2; ++bj) { cb0[bj] = *(const f32x4*)(bias + (col0 + bj * HALF - 3072)); cb1[bj] = *(const f32x4*)(bias + (col0 + bj * HALF - 3072) + 4); }
            }
        }
        if (MODE == EP_GLU) {
#pragma unroll
            for (int bj = 0; bj < 2; ++bj) { cb0[bj] = *(const f32x4*)(bias + col0 + bj * HALF); cb1[bj] = *(const f32x4*)(bias + col0 + bj * HALF + 4); }
        }
#pragma unroll
        for (int ai = 0; ai < 2; ++ai)
#pragma unroll
            for (int m = 0; m < 4; ++m) {
                const size_t row = (size_t)(row0 + ai * HALF + m * 16);
                float ssq = 0.f;
#pragma unroll
                for (int bj = 0; bj < 2; ++bj) {
                    const int col = col0 + bj * HALF;
                    f32x4 v0 = acc[ai][bj][m][0], v1 = acc[ai][bj][m][1];
                    if (MODE == EP_INPROJ) {
                        const float rs = rsr[ai][m];
                        v0 = v0 * rs; v1 = v1 * rs;
                        if (kind == 1) { v0 = gelu4(v0); v1 = gelu4(v1); }
                        else if (kind == 2) { v0 = sigm4(v0 + cb0[bj]); v1 = sigm4(v1 + cb1[bj]); }
                        *(u32x4*)((bf16_t*)O + row * ldc + col) = pack8(v0, v1);
                    } else if (MODE == EP_GLU) {
                        f32x4 y0, y1; unpack8(*(const u32x4*)(aux + row * ldaux + col), y0, y1);
                        v0 = y0 * sigm4(v0 + cb0[bj]); v1 = y1 * sigm4(v1 + cb1[bj]);
                        *(u32x4*)((bf16_t*)O + row * ldc + col) = pack8(v0, v1);
                    } else if (MODE == EP_MERGE0 || MODE == EP_MERGE1) {
                        f32x4 g0, g1; unpack8(*(const u32x4*)(aux + row * ldaux + col), g0, g1);
                        v0 = g0 * v0; v1 = g1 * v1;
                        if (MODE == EP_MERGE1) { f32x4 o0, o1; unpack8(*(const u32x4*)((const bf16_t*)O + row * ldc + col), o0, o1); v0 = v0 + o0; v1 = v1 + o1; }
                        *(u32x4*)((bf16_t*)O + row * ldc + col) = pack8(v0, v1);
                    } else if (MODE == EP_RESID) {
                        f32x4 x0, x1; unpack8(*(const u32x4*)(xb + row * ldc + col), x0, x1); x0 = x0 + v0; x1 = x1 + v1;
                        if (O) { *(f32x4*)((float*)O + row * ldc + col) = x0; *(f32x4*)((float*)O + row * ldc + col + 4) = x1; }
                        if (ssout) {
                            *(u32x4*)(xb + row * ldc + col) = pack8(x0, x1);
                            const float q = (x0[0] * x0[0] + x0[1] * x0[1]) + (x0[2] * x0[2] + x0[3] * x0[3]) + (x1[0] * x1[0] + x1[1] * x1[1]) + (x1[2] * x1[2] + x1[3] * x1[3]);
                            if (bj == 0) ssq = q; else ssq += q;
                        }
                    } else {
                        *(u32x4*)((bf16_t*)O + row * ldc + col) = pack8(v0, v1);
                    }
                }
                if (MODE == EP_RESID) { if (ssout) { ssq += __shfl_xor(ssq, 16); ssq += __shfl_xor(ssq, 32); if (fq == 0) unsafeAtomicAdd(ssout + row, ssq); } }
                if (m == 3) asm volatile("" ::: "memory");
            }
    }
};
template <class Epi, class Sched, bool ALIGN_EPI = false, bool SP2 = false>
__device__ __forceinline__ void gemm_phase(PG8_LAS unsigned char* lds, const Gemm g, const Sched& S, const Epi& E, int wave_in) {
    int tid_ = wave_in * 64 + (int)__builtin_amdgcn_mbcnt_hi(~0u, __builtin_amdgcn_mbcnt_lo(~0u, 0u)); asm volatile("" : "+v"(tid_));
    const int tid = tid_, wid = __builtin_amdgcn_readfirstlane(tid >> 6), lane = tid & 63, wr = wid >> 2, wc = wid & 3, fr = lane & 15, fq = lane >> 4;
    const int K = g.K, nt = K / BK;
    unsigned voffA[2], voffB[2];
#pragma unroll
    for (int i = 0; i < 2; ++i) { int R, C; stage_rc(tid * 16 + i * 8192, R, C); const int Rb = Epi::PERM ? ((R & ~31) + perm32(R & 31)) : R;
        voffA[i] = (unsigned)(R * g.lda + C) * 2u; voffB[i] = (unsigned)(Rb * K + C) * 2u; }
    const size_t kstep = (size_t)(BK * 2);
    const size_t hstep = (size_t)HALF * K * 2;
    const size_t tstep = 2 * hstep; const size_t hstepA = (size_t)HALF * g.lda * 2, tstepA = 2 * hstepA;
    const unsigned ldsw = (unsigned)wid * 1024u;
    const int aoff = lds_byte(wr * 64 + fr, fq * 8), boff = lds_byte(wc * 32 + fr, fq * 8);
#define PG8_SA(b, h) (((b) * 2 + (h)) * HTB)
#define PG8_SB(b, h) ((4 + (b) * 2 + (h)) * HTB)
#define PG8_STAGE(bufoff, gbase, voff) do { _Pragma("unroll") for (int _i = 0; _i < 2; ++_i) \
        __builtin_amdgcn_global_load_lds((const unsigned*)((const char*)(gbase) + (voff)[_i]), (PG8_LAS unsigned*)(lds + (bufoff) + ldsw + _i * 8192), 16, 0, 0); } while (0)
#define PG8_LDA(dst, b, h) do { _Pragma("unroll") for (int m = 0; m < 4; ++m) _Pragma("unroll") for (int k = 0; k < 2; ++k) dst[m][k] = *(const PG8_LAS bf16x8*)(lds + PG8_SA(b, h) + aoff + m * 2048 + k * 1024); } while (0)
#define PG8_LDB(dst, b, h) do { _Pragma("unroll") for (int n = 0; n < 2; ++n) _Pragma("unroll") for (int k = 0; k < 2; ++k) dst[n][k] = *(const PG8_LAS bf16x8*)(lds + PG8_SB(b, h) + boff + n * 2048 + k * 1024); } while (0)
#define PG8_MMA(ai, bj, At, Bt) do { __builtin_amdgcn_s_setprio(1); _Pragma("unroll") for (int m = 0; m < 4; ++m) _Pragma("unroll") for (int n = 0; n < 2; ++n) _Pragma("unroll") for (int k = 0; k < 2; ++k) \
        acc[ai][bj][m][n] = __builtin_amdgcn_mfma_f32_16x16x32_bf16(Bt[n][k], At[m][k], acc[ai][bj][m][n], 0, 0, 0); __builtin_amdgcn_s_setprio(0); } while (0)
#define PG8_WAIT_V(n) asm volatile("s_waitcnt vmcnt(" #n ")" ::: "memory")
#define PG8_WAIT_L(n) asm volatile("s_waitcnt lgkmcnt(" #n ")" ::: "memory")
#define PG8_BAR __builtin_amdgcn_s_barrier()
#define PG8_SCHED __builtin_amdgcn_sched_barrier(0)
    Unit cur, nxt; int ui = 0;
    if (!S.next(0, cur)) return;
    f32x4 acc[2][2][4][2];
#pragma unroll
    for (int a = 0; a < 2; ++a)
#pragma unroll
        for (int b = 0; b < 2; ++b)
#pragma unroll
            for (int m = 0; m < 4; ++m)
#pragma unroll
                for (int n = 0; n < 2; ++n) acc[a][b][m][n] = (f32x4){0.f, 0.f, 0.f, 0.f};
    bf16x8 At[4][2], B0[2][2], B1[2][2];
    const char* cA = (const char*)g.A + (size_t)cur.pm * tstepA; const char* cB = (const char*)g.Bt + (size_t)cur.pn * tstep;
    S.a_ready(cur);
    if constexpr (SP2) {
        PG8_STAGE(PG8_SB(0, 0), cB, voffB); PG8_STAGE(PG8_SB(0, 1), cB + hstep, voffB); PG8_STAGE(PG8_SA(0, 0), cA, voffA); PG8_STAGE(PG8_SA(0, 1), cA + hstepA, voffA);
        if (wr == 1) PG8_BAR;
        PG8_WAIT_V(2); PG8_BAR;
        PG8_STAGE(PG8_SB(1, 0), cB + kstep, voffB); PG8_STAGE(PG8_SA(1, 0), cA + kstep, voffA); PG8_STAGE(PG8_SB(1, 1), cB + hstep + kstep, voffB);
        PG8_WAIT_V(6); PG8_BAR;
    } else {
        PG8_STAGE(PG8_SB(0, 0), cB, voffB); PG8_STAGE(PG8_SA(0, 0), cA, voffA); PG8_STAGE(PG8_SB(0, 1), cB + hstep, voffB); PG8_STAGE(PG8_SA(0, 1), cA + hstepA, voffA);
        if (wr == 1) PG8_BAR;
        PG8_WAIT_V(4); PG8_BAR;
        PG8_STAGE(PG8_SB(1, 0), cB + kstep, voffB); PG8_STAGE(PG8_SA(1, 0), cA + kstep, voffA); PG8_STAGE(PG8_SB(1, 1), cB + hstep + kstep, voffB);
        PG8_WAIT_V(6); PG8_BAR;
    }
    for (;;) {
        const bool has_next = S.next(ui + 1, nxt);
        const char* nA = has_next ? (const char*)g.A + (size_t)nxt.pm * tstepA : cA; const char* nB = has_next ? (const char*)g.Bt + (size_t)nxt.pn * tstep : cB;
        for (int t = 0; t < nt; t += 2) {
            const bool last = (t == nt - 2);
            const char* a1 = cA + (size_t)(t + 1) * kstep;
            const char* a2 = last ? nA : cA + (size_t)(t + 2) * kstep; const char* b2 = last ? nB : cB + (size_t)(t + 2) * kstep;
            const char* a3 = a2 + kstep; const char* b3 = b2 + kstep;
            if (last && has_next) S.a_ready(nxt);
            if constexpr (SP2) {
            PG8_LDB(B0, 0, 0); PG8_LDB(B1, 0, 1); PG8_SCHED; PG8_LDA(At, 0, 0); PG8_STAGE(PG8_SA(1, 1), a1 + hstepA, voffA);
            PG8_WAIT_V(8); PG8_WAIT_L(0); PG8_BAR; PG8_MMA(0, 0, At, B0); PG8_MMA(0, 1, At, B1); PG8_BAR; PG8_SCHED;
            PG8_LDA(At, 0, 1); PG8_STAGE(PG8_SB(0, 0), b2, voffB); PG8_STAGE(PG8_SB(0, 1), b2 + hstep, voffB); PG8_STAGE(PG8_SA(0, 0), a2, voffA);
            PG8_WAIT_V(8); PG8_WAIT_L(0); PG8_BAR; PG8_MMA(1, 0, At, B0); PG8_MMA(1, 1, At, B1); PG8_BAR; PG8_SCHED;
            PG8_LDB(B0, 1, 0); PG8_LDB(B1, 1, 1); PG8_SCHED; PG8_LDA(At, 1, 0); PG8_STAGE(PG8_SA(0, 1), a2 + hstepA, voffA);
            PG8_WAIT_V(8); PG8_WAIT_L(0); PG8_BAR; PG8_MMA(0, 0, At, B0); PG8_MMA(0, 1, At, B1); PG8_BAR; PG8_SCHED;
            PG8_LDA(At, 1, 1); PG8_STAGE(PG8_SB(1, 0), b3, voffB); PG8_STAGE(PG8_SB(1, 1), b3 + hstep, voffB); PG8_STAGE(PG8_SA(1, 0), a3, voffA);
            PG8_WAIT_V(8); PG8_WAIT_L(0); PG8_BAR; PG8_MMA(1, 0, At, B0); PG8_MMA(1, 1, At, B1); PG8_BAR; PG8_SCHED;
            } else {
            PG8_LDB(B0, 0, 0); PG8_SCHED; PG8_LDA(At, 0, 0); PG8_STAGE(PG8_SA(1, 1), a1 + hstepA, voffA);
            PG8_WAIT_L(8); PG8_BAR; PG8_WAIT_L(0); PG8_MMA(0, 0, At, B0); PG8_BAR; PG8_SCHED;
            PG8_LDB(B1, 0, 1); PG8_STAGE(PG8_SB(0, 0), b2, voffB);
            PG8_BAR; PG8_WAIT_L(0); PG8_MMA(0, 1, At, B1); PG8_BAR;
            PG8_LDA(At, 0, 1); PG8_STAGE(PG8_SA(0, 0), a2, voffA);
            PG8_BAR; PG8_WAIT_L(0); PG8_MMA(1, 0, At, B0); PG8_BAR; PG8_SCHED;
            PG8_STAGE(PG8_SB(0, 1), b2 + hstep, voffB);
            PG8_WAIT_V(6); PG8_BAR; PG8_MMA(1, 1, At, B1); PG8_BAR;
            PG8_LDB(B0, 1, 0); PG8_SCHED; PG8_LDA(At, 1, 0); PG8_STAGE(PG8_SA(0, 1), a2 + hstepA, voffA);
            PG8_WAIT_L(8); PG8_BAR; PG8_WAIT_L(0); PG8_MMA(0, 0, At, B0); PG8_BAR; PG8_SCHED;
            PG8_LDB(B1, 1, 1); PG8_STAGE(PG8_SB(1, 0), b3, voffB);
            PG8_BAR; PG8_WAIT_L(0); PG8_MMA(0, 1, At, B1); PG8_BAR;
            PG8_LDA(At, 1, 1); PG8_STAGE(PG8_SA(1, 0), a3, voffA);
            PG8_BAR; PG8_WAIT_L(0); PG8_MMA(1, 0, At, B0); PG8_BAR; PG8_SCHED;
            PG8_STAGE(PG8_SB(1, 1), b3 + hstep, voffB);
            PG8_WAIT_V(6); PG8_BAR; PG8_MMA(1, 1, At, B1); PG8_BAR;
            }
        }
        if constexpr (ALIGN_EPI) { if (wr == 0) PG8_BAR; }
        if constexpr (!Epi::AFTER_DRAIN) { E(acc, cur, wr, wc, fr, fq); S.done(cur); }
        if (!has_next) break;
#pragma unroll
        for (int a = 0; a < 2; ++a)
#pragma unroll
            for (int b = 0; b < 2; ++b)
#pragma unroll
                for (int m = 0; m < 4; ++m)
#pragma unroll
                    for (int n = 0; n < 2; ++n) acc[a][b][m][n] = (f32x4){0.f, 0.f, 0.f, 0.f};
        cur = nxt; cA = nA; cB = nB; ++ui;
        if constexpr (ALIGN_EPI) { if (wr == 1) PG8_BAR; }
    }
    PG8_WAIT_V(0);
    if constexpr (!ALIGN_EPI) { if (wr == 0) PG8_BAR; }
    PG8_BAR;
    if constexpr (Epi::AFTER_DRAIN) { E.fused(acc, cur, wr, wc, fr, fq, lds, wid, lane); S.done(cur); }
#undef PG8_SA
#undef PG8_SB
#undef PG8_STAGE
#undef PG8_LDA
#undef PG8_LDB
#undef PG8_MMA
#undef PG8_WAIT_V
#undef PG8_WAIT_L
#undef PG8_BAR
#undef PG8_SCHED
}
}

namespace mk {
using pg8::bf16_t; using pg8::bf16x8; using pg8::f32x4; using pg8::u32x4; using pg8::bf_lo; using pg8::bf_hi; using pg8::cvt_pk_bf16; using pg8::gelu_t;
#define LAS __attribute__((address_space(3)))
typedef unsigned u32x2 __attribute__((ext_vector_type(2)));
constexpr int M = 16384, D = 2048, SEQ = 8192, INW = 9216, DFF = 5632, NUP = 11264, MH = 8192;
constexpr int NWAVES = 8, NTHR = 512;
constexpr int LDS_BYTES = 143360;
constexpr float EPS = 1e-6f;
constexpr size_t O_WIN = 0, O_WA = O_WIN + (size_t)INW * D * 2, O_WSG = O_WA + (size_t)D * 1024 * 2, O_WSSM = O_WSG + (size_t)D * 512 * 2, O_WOUT = O_WSSM + (size_t)D * 512 * 2,
                 O_WUP = O_WOUT + (size_t)D * D * 2, O_WDN = O_WUP + (size_t)NUP * D * 2, O_WGLU = O_WDN + (size_t)D * DFF * 2, WLAYER = O_WGLU + (size_t)512 * 512 * 2;
constexpr size_t MiB = 1u << 20;
constexpr size_t WS_W = 0, WS_XB = 119 * MiB, WS_MRG = WS_XB + 64 * MiB, WS_PROJ = WS_MRG + 64 * MiB, WS_YCAT = WS_PROJ + 288 * MiB, WS_YS = WS_YCAT + 64 * MiB, WS_SST = WS_YS + 16 * MiB, WS_SS = WS_SST + 2 * MiB, WS_BAR = WS_SS + 512 * 1024, WS_COEF = WS_SS + 768 * 1024, WS_END = WS_SS + 1 * MiB;
static_assert(WLAYER <= 119 * MiB, "one layer of bf16 weights");
constexpr size_t WS_ACT = WS_PROJ, WS_RAW = WS_PROJ + 176 * MiB;
static_assert(WLAYER % 256 == 0 && (size_t)M * INW * 2 == 288 * MiB && (size_t)M * DFF * 2 == 176 * MiB && (size_t)256 * 4 * NUP * 4 <= 112 * MiB, "ws map");
constexpr int PPL = 10, NPH = PPL * 2;

struct Args { const float* in[30]; float* out; unsigned char* ws; int ph_lo, ph_hi; };
typedef __attribute__((address_space(4))) const Args CArgs;

__device__ __forceinline__ float wave_sum(float v) {
#pragma unroll
    for (int o = 1; o < 64; o <<= 1) v += __shfl_xor(v, o);
    return v;
}
__device__ __forceinline__ unsigned f2bf(float f) { unsigned u = __builtin_bit_cast(unsigned, f); return (u + 0x7fffu + ((u >> 16) & 1u)) >> 16; }
__device__ __forceinline__ unsigned pk2(float lo, float hi) { return f2bf(lo) | (f2bf(hi) << 16); }

__device__ __forceinline__ void titem_load(const float* W, int N, int item, int lane, float (&wv)[32]) {
    const int nblk = N / 32, kb = item / nblk, nb = item % nblk;
    const float* wp = W + (size_t)(64 * kb + (lane >> 5)) * N + 32 * nb + (lane & 31);
#pragma unroll
    for (int i = 0; i < 32; ++i) wv[i] = __builtin_nontemporal_load(wp + (size_t)(2 * i) * N);
}
__device__ __forceinline__ void titem_finish(const float (&wv)[32], int K, int N, bf16_t* WT, LAS float* scr, int item, int lane, bool upperm, const float* gain) {
    const int nblk = N / 32, kb = item / nblk, nb = item % nblk, k0 = 64 * kb, n0 = 32 * nb;
    int nd0 = n0; if (upperm) { const int hi = n0 >= 5632, nn = n0 - hi * 5632; nd0 = 256 * (nn >> 7) + 128 * hi + (nn & 127); }
#pragma unroll
    for (int i = 0; i < 32; ++i) scr[(2 * i + (lane >> 5)) * 33 + (lane & 31)] = wv[i];
    asm volatile("s_waitcnt lgkmcnt(0)" ::: "memory");
    const int c = lane & 7;
    f32x4 g0 = (f32x4){1.f, 1.f, 1.f, 1.f}, g1 = g0;
    if (gain) { g0 = *(const f32x4*)(gain + k0 + 8 * c); g1 = *(const f32x4*)(gain + k0 + 8 * c + 4); }
#pragma unroll
    for (int j = 0; j < 4; ++j) { const int n = (lane >> 3) + 8 * j; const LAS float* s = scr + (8 * c) * 33 + n;
        u32x4 o; o.x = cvt_pk_bf16(s[0 * 33] * g0[0], s[1 * 33] * g0[1]); o.y = cvt_pk_bf16(s[2 * 33] * g0[2], s[3 * 33] * g0[3]); o.z = cvt_pk_bf16(s[4 * 33] * g1[0], s[5 * 33] * g1[1]); o.w = cvt_pk_bf16(s[6 * 33] * g1[2], s[7 * 33] * g1[3]);
        *(u32x4*)(WT + (size_t)(nd0 + n) * K + k0 + 8 * c) = o; }
    asm volatile("s_waitcnt lgkmcnt(0)" ::: "memory");
}
__device__ __forceinline__ void convert_phase(CArgs* ap, int l, LAS unsigned char* lds, int gw, int NGW, int wave, int lane) {
    LAS float* scr = (LAS float*)(lds + wave * 8448);
    {
        unsigned char* wb = ap->ws + WS_W;
#pragma unroll 1
        for (int mi = 0; mi < 8; ++mi) {
            const float* W; int K, N; size_t off;
            switch (mi) {
                case 0: W = ap->in[2] + (size_t)l * D * INW; K = D; N = INW; off = O_WIN; break;
                case 1: W = ap->in[21] + (size_t)l * 1024 * D; K = 1024; N = D; off = O_WA; break;
                case 2: W = ap->in[22] + (size_t)l * 512 * D; K = 512; N = D; off = O_WSG; break;
                case 3: W = ap->in[23] + (size_t)l * 512 * D; K = 512; N = D; off = O_WSSM; break;
                case 4: W = ap->in[24] + (size_t)l * D * D; K = D; N = D; off = O_WOUT; break;
                case 5: W = ap->in[26] + (size_t)l * D * NUP; K = D; N = NUP; off = O_WUP; break;
                case 6: W = ap->in[29] + (size_t)l * DFF * D; K = DFF; N = D; off = O_WDN; break;
                default: W = ap->in[19] + (size_t)l * 512 * 512; K = 512; N = 512; off = O_WGLU; break;
            }
            const int nitems = (K / 64) * (N / 32);
            const float* gain = mi == 0 ? ap->in[1] + l * D : (mi == 5 ? ap->in[25] + l * D : nullptr);
            float wc[32], wn[32];
            int it = gw;
            if (it < nitems) titem_load(W, N, it, lane, wc);
            while (it < nitems) {
                const int nx = it + NGW;
                if (nx < nitems) titem_load(W, N, nx, lane, wn);
                titem_finish(wc, K, N, (bf16_t*)(wb + off), scr, it, lane, mi == 5, gain);
#pragma unroll
                for (int i = 0; i < 32; ++i) wc[i] = wn[i];
                it = nx;
            }
        }
    }
}

__device__ __forceinline__ void xb_phase(const float* x, bf16_t* XB, float* SS, int gw, int NGW, int lane) {
    for (int m = gw; m < M; m += NGW) {
        const f32x4* xr = (const f32x4*)(x + (size_t)m * D) + lane;
        f32x4 v[8]; float s = 0.f;
#pragma unroll
        for (int j = 0; j < 8; ++j) { v[j] = xr[64 * j]; s += (v[j][0] * v[j][0] + v[j][1] * v[j][1]) + (v[j][2] * v[j][2] + v[j][3] * v[j][3]); }
        s = wave_sum(s);
        if (lane == 0) SS[m] = s;
        u32x2* o = (u32x2*)(XB + (size_t)m * D) + lane;
#pragma unroll
        for (int j = 0; j < 8; ++j) { u32x2 w; w.x = pk2(v[j][0], v[j][1]); w.y = pk2(v[j][2], v[j][3]); o[64 * j] = w; }
    }
}

__device__ __forceinline__ bf16x8 as_bf8(u32x4 w) { return __builtin_bit_cast(bf16x8, w); }

__device__ __forceinline__ void attn_unit(LAS unsigned char* lds, const bf16_t* PROJ, bf16_t* YCAT, const float* qg, const float* kg, const float* sinks, int unit, int tid, int wave, int lane) {
    const int kvh = unit & 1, blk = (unit >> 1) & 63, b = unit >> 7;
    const int t0 = b * SEQ + blk * 128;
    LAS bf16_t* Ks = (LAS bf16_t*)lds; LAS bf16_t* Vt = (LAS bf16_t*)(lds + 69632);
    {
        const int c16 = tid & 15;
        const f32x4 g0 = *(const f32x4*)(kg + 8 * c16), g1 = *(const f32x4*)(kg + 8 * c16 + 4);
#pragma unroll 2
        for (int pass = 0; pass < 8; ++pass) {
            const int kidx = (tid >> 4) + 32 * pass;
            u32x4 w = {0u, 0u, 0u, 0u};
            if (!(blk == 0 && pass < 4)) w = *(const u32x4*)(PROJ + (size_t)(t0 - 128 + kidx) * INW + 1024 + kvh * 128 + 8 * c16);
            f32x4 v0, v1; pg8::unpack8(w, v0, v1);
            float ss = (v0[0] * v0[0] + v0[1] * v0[1]) + (v0[2] * v0[2] + v0[3] * v0[3]) + (v1[0] * v1[0] + v1[1] * v1[1]) + (v1[2] * v1[2] + v1[3] * v1[3]);
            ss += __shfl_xor(ss, 1); ss += __shfl_xor(ss, 2); ss += __shfl_xor(ss, 4); ss += __shfl_xor(ss, 8);
            const float rs = rsqrtf(ss * (1.f / 128.f) + EPS);
            *(LAS u32x4*)(Ks + kidx * 136 + 8 * c16) = pg8::pack8(v0 * rs * g0, v1 * rs * g1);
        }
    }
    {
#pragma unroll 1
        for (int rg = 0; rg < 4; ++rg) {
            const int kidx = 64 * rg + lane, kk = kidx & 31, pos = (kidx & ~31) + 8 * ((kk >> 2) & 3) + 4 * (kk >> 4) + (kk & 3);
#pragma unroll
            for (int cc = 0; cc < 2; ++cc) {
                const int c16 = 2 * wave + cc;
                u32x4 w = {0u, 0u, 0u, 0u};
                if (!(blk == 0 && rg < 2)) w = *(const u32x4*)(PROJ + (size_t)(t0 - 128 + kidx) * INW + 1280 + kvh * 128 + 8 * c16);
                LAS bf16_t* d = Vt + (8 * c16) * 264 + pos;
                d[0 * 264] = (bf16_t)(w.x & 0xffffu); d[1 * 264] = (bf16_t)(w.x >> 16); d[2 * 264] = (bf16_t)(w.y & 0xffffu); d[3 * 264] = (bf16_t)(w.y >> 16);
                d[4 * 264] = (bf16_t)(w.z & 0xffffu); d[5 * 264] = (bf16_t)(w.z >> 16); d[6 * 264] = (bf16_t)(w.w & 0xffffu); d[7 * 264] = (bf16_t)(w.w >> 16);
            }
        }
    }
    __syncthreads();
    const int fr = lane & 15, fq = lane >> 4, qrow = 16 * wave + fr;
#pragma unroll 1
    for (int hq = 4 * kvh; hq < 4 * kvh + 4; ++hq) {
    bf16x8 qf[4];
    {
        const bf16_t* qp = PROJ + (size_t)(t0 + qrow) * INW + hq * 128 + 8 * fq;
        u32x4 w[4]; float ss = 0.f;
#pragma unroll
        for (int ks = 0; ks < 4; ++ks) { w[ks] = *(const u32x4*)(qp + 32 * ks); f32x4 v0, v1; pg8::unpack8(w[ks], v0, v1);
            ss += (v0[0] * v0[0] + v0[1] * v0[1]) + (v0[2] * v0[2] + v0[3] * v0[3]) + (v1[0] * v1[0] + v1[1] * v1[1]) + (v1[2] * v1[2] + v1[3] * v1[3]); }
        ss += __shfl_xor(ss, 16); ss += __shfl_xor(ss, 32);
        const float rs = rsqrtf(ss * (1.f / 128.f) + EPS) * 0.08838834764831845f;
#pragma unroll
        for (int ks = 0; ks < 4; ++ks) { f32x4 v0, v1; pg8::unpack8(w[ks], v0, v1);
            const f32x4 g0 = *(const f32x4*)(qg + 32 * ks + 8 * fq), g1 = *(const f32x4*)(qg + 32 * ks + 8 * fq + 4);
            qf[ks] = as_bf8(pg8::pack8(v0 * rs * g0, v1 * rs * g1)); }
    }
    const int wp = wave & ~1;
    f32x4 s[10];
#pragma unroll
    for (int rel = 0; rel < 10; ++rel) {
        s[rel] = (f32x4){0.f, 0.f, 0.f, 0.f};
#pragma unroll
        for (int ks = 0; ks < 4; ++ks) {
            const bf16x8 kf = *(const LAS bf16x8*)(Ks + (16 * (wp + rel) + fr) * 136 + 32 * ks + 8 * fq);
            s[rel] = __builtin_amdgcn_mfma_f32_16x16x32_bf16(kf, qf[ks], s[rel], 0, 0, 0);
        }
    }
    const float slope = exp2f(-(float)(hq + 1)), sink = sinks[hq];
    const int qidx = 128 + qrow;
    float mx = -INFINITY;
#pragma unroll
    for (int rel = 0; rel < 10; ++rel)
#pragma unroll
        for (int i = 0; i < 4; ++i) {
            const int kidx = 16 * (wp + rel) + 4 * fq + i, dist = qidx - kidx;
            const bool valid = (dist >= 0) && (dist < 128) && (blk > 0 || kidx >= 128);
            const float val = valid ? s[rel][i] - slope * (float)dist : -INFINITY;
            s[rel][i] = val; mx = fmaxf(mx, val);
        }
    mx = fmaxf(mx, __shfl_xor(mx, 16)); mx = fmaxf(mx, __shfl_xor(mx, 32));
    const float mm = fmaxf(mx, sink);
    float ls = 0.f;
#pragma unroll
    for (int rel = 0; rel < 10; ++rel)
#pragma unroll
        for (int i = 0; i < 4; ++i) { const float p = __expf(s[rel][i] - mm); s[rel][i] = p; ls += p; }
    ls += __shfl_xor(ls, 16); ls += __shfl_xor(ls, 32);
    const float inv = 1.f / (ls + __expf(sink - mm));
    bf16x8 pf[5];
#pragma unroll
    for (int g = 0; g < 5; ++g) pf[g] = as_bf8(pg8::pack8(s[2 * g], s[2 * g + 1]));
    bf16_t* op = YCAT + (size_t)(t0 + qrow) * D + hq * 128 + 4 * fq;
#pragma unroll
    for (int db = 0; db < 8; ++db) {
        f32x4 o = (f32x4){0.f, 0.f, 0.f, 0.f};
#pragma unroll
        for (int g = 0; g < 5; ++g) {
            const bf16x8 vf = *(const LAS bf16x8*)(Vt + (16 * db + fr) * 264 + 32 * ((wp >> 1) + g) + 8 * fq);
            o = __builtin_amdgcn_mfma_f32_16x16x32_bf16(vf, pf[g], o, 0, 0, 0);
        }
        u32x2 w; w.x = cvt_pk_bf16(o[0] * inv, o[1] * inv); w.y = cvt_pk_bf16(o[2] * inv, o[3] * inv);
        *(u32x2*)(op + 16 * db) = w;
    }
    }
    __syncthreads();
}

__device__ __forceinline__ void sg_unit(LAS unsigned char* lds, const bf16_t* PROJ, bf16_t* YCAT, const float* lng, const float* lnb, const float* sgw, const float* sgb, int unit, int tid, int wave, int lane) {
    const int g = unit & 3, ch = (unit >> 2) & 63, b = unit >> 8;
    const int t0 = b * SEQ + ch * 128;
    LAS bf16_t* Zt = (LAS bf16_t*)lds; LAS float* st = (LAS float*)(lds + 34816);
    const bf16_t* zv = PROJ + (size_t)t0 * INW + 2048 + g * 128;
    {
        const int c16 = tid & 15;
#pragma unroll
        for (int pass = 0; pass < 4; ++pass) {
            const int r = (tid >> 4) + 32 * pass;
            f32x4 v0, v1; pg8::unpack8(*(const u32x4*)(zv + (size_t)r * INW + 8 * c16), v0, v1);
            float sm = (v0[0] + v0[1]) + (v0[2] + v0[3]) + (v1[0] + v1[1]) + (v1[2] + v1[3]);
            sm += __shfl_xor(sm, 1); sm += __shfl_xor(sm, 2); sm += __shfl_xor(sm, 4); sm += __shfl_xor(sm, 8);
            const float mean = sm * (1.f / 128.f);
            v0 = v0 - mean; v1 = v1 - mean;
            float q = (v0[0] * v0[0] + v0[1] * v0[1]) + (v0[2] * v0[2] + v0[3] * v0[3]) + (v1[0] * v1[0] + v1[1] * v1[1]) + (v1[2] * v1[2] + v1[3] * v1[3]);
            q += __shfl_xor(q, 1); q += __shfl_xor(q, 2); q += __shfl_xor(q, 4); q += __shfl_xor(q, 8);
            if (c16 == 0) { st[2 * r] = mean; st[2 * r + 1] = rsqrtf(q * (1.f / 128.f) + EPS); }
        }
    }
    __syncthreads();
#pragma unroll 1
    for (int rg = 0; rg < 2; ++rg) {
        const int r = 64 * rg + lane; const float mean = st[2 * r], rstd = st[2 * r + 1];
#pragma unroll
        for (int cc = 0; cc < 2; ++cc) {
            const int c16 = 2 * wave + cc;
            f32x4 v0, v1; pg8::unpack8(*(const u32x4*)(zv + (size_t)r * INW + 8 * c16), v0, v1);
            const f32x4 a0 = *(const f32x4*)(lng + g * 128 + 8 * c16), a1 = *(const f32x4*)(lng + g * 128 + 8 * c16 + 4);
            const f32x4 b0 = *(const f32x4*)(lnb + g * 128 + 8 * c16), b1 = *(const f32x4*)(lnb + g * 128 + 8 * c16 + 4);
            v0 = (v0 - mean) * rstd * a0 + b0; v1 = (v1 - mean) * rstd * a1 + b1;
            LAS bf16_t* d = Zt + (8 * c16) * 136 + r;
            d[0 * 136] = (bf16_t)f2bf(v0[0]); d[1 * 136] = (bf16_t)f2bf(v0[1]); d[2 * 136] = (bf16_t)f2bf(v0[2]); d[3 * 136] = (bf16_t)f2bf(v0[3]);
            d[4 * 136] = (bf16_t)f2bf(v1[0]); d[5 * 136] = (bf16_t)f2bf(v1[1]); d[6 * 136] = (bf16_t)f2bf(v1[2]); d[7 * 136] = (bf16_t)f2bf(v1[3]);
        }
    }
    __syncthreads();
    const int fr = lane & 15, fq = lane >> 4, t = 16 * wave + fr, nks = (wave >> 1) + 1;
    bf16x8 wf[4];
#pragma unroll
    for (int ks = 0; ks < 4; ++ks) {
        u32x4 w = {0u, 0u, 0u, 0u};
        if (ks < nks) {
            const float* wp = sgw + ((size_t)(g * 128 + t)) * 128 + 32 * ks + 8 * fq;
            f32x4 a0 = *(const f32x4*)wp, a1 = *(const f32x4*)(wp + 4);
            const int s0 = 32 * ks + 8 * fq;
#pragma unroll
            for (int i = 0; i < 4; ++i) { if (s0 + i > t) a0[i] = 0.f; if (s0 + 4 + i > t) a1[i] = 0.f; }
            w = pg8::pack8(a0, a1);
        }
        wf[ks] = as_bf8(w);
    }
    const float bs = sgb[g * 128 + t];
    const bf16_t* zu = PROJ + (size_t)(t0 + t) * INW + 1536 + g * 128 + 4 * fq;
    bf16_t* op = YCAT + (size_t)(t0 + t) * D + 1024 + g * 128 + 4 * fq;
#pragma unroll
    for (int cb = 0; cb < 8; ++cb) {
        f32x4 acc = (f32x4){0.f, 0.f, 0.f, 0.f};
#pragma unroll
        for (int ks = 0; ks < 4; ++ks) if (ks < nks) {
            const bf16x8 zf = *(const LAS bf16x8*)(Zt + (16 * cb + fr) * 136 + 32 * ks + 8 * fq);
            acc = __builtin_amdgcn_mfma_f32_16x16x32_bf16(zf, wf[ks], acc, 0, 0, 0);
        }
        const u32x2 zw = *(const u32x2*)(zu + 16 * cb);
        u32x2 w; w.x = cvt_pk_bf16(bf_lo(zw.x) * (acc[0] + bs), bf_hi(zw.x) * (acc[1] + bs)); w.y = cvt_pk_bf16(bf_lo(zw.y) * (acc[2] + bs), bf_hi(zw.y) * (acc[3] + bs));
        *(u32x2*)(op + 16 * cb) = w;
    }
    __syncthreads();
}

template <bool P3> __device__ __forceinline__ void ssm_unit(CArgs* ap, const float* COEF, int l, const bf16_t* PROJ, float* SST, bf16_t* YS, LAS unsigned char* wlds, int unit, int lane) {
    const int c = unit & 63, g = (unit >> 6) & 31, b = unit >> 11;
    const int fr = lane & 15, fq = lane >> 4;
    float pr[4][4], pi[4][4]; bf16x8 bfr[8];
#pragma unroll
    for (int cb = 0; cb < 4; ++cb) {
        const int gp = (l * 32 + g) * 64 + 16 * cb + fr;
        const f32x4 cf = *(const f32x4*)(COEF + (size_t)(g * 64 + 16 * cb + fr) * 4);
        const float abr = cf[0], abi = cf[1];
        pr[cb][0] = abr; pi[cb][0] = abi;
#pragma unroll
        for (int i = 1; i < 4; ++i) { pr[cb][i] = pr[cb][i - 1] * abr - pi[cb][i - 1] * abi; pi[cb][i] = pr[cb][i - 1] * abi + pi[cb][i - 1] * abr; }
        const float cr = cf[2], ci = cf[3];
        u32x4 wre = {0u, 0u, 0u, 0u}, wim = {0u, 0u, 0u, 0u};
        if (fq < 2) {
            const float* br = ap->in[14] + (size_t)gp * 16 + 8 * fq; const float* bi = ap->in[15] + (size_t)gp * 16 + 8 * fq;
            const f32x4 r0 = *(const f32x4*)br, r1 = *(const f32x4*)(br + 4), i0 = *(const f32x4*)bi, i1 = *(const f32x4*)(bi + 4);
            wre = pg8::pack8(cr * r0 - ci * i0, cr * r1 - ci * i1); wim = pg8::pack8(cr * i0 + ci * r0, cr * i1 + ci * r1);
        }
        bfr[cb] = as_bf8(wre); bfr[cb + 4] = as_bf8(wim);
    }
    bf16x8 cmf[4]; float dsk = 0.f;
    if (P3) {
#pragma unroll
        for (int ks = 0; ks < 4; ++ks) {
            const int k0 = 32 * ks + 8 * fq;
            const float* src = (ks < 2 ? ap->in[16] : ap->in[17]) + ((size_t)(l * 32 + g) * 16 + fr) * 64 + (ks < 2 ? k0 : k0 - 64);
            f32x4 c0 = *(const f32x4*)src, c1 = *(const f32x4*)(src + 4);
            if (ks >= 2) { c0 = -c0; c1 = -c1; }
            cmf[ks] = as_bf8(pg8::pack8(c0, c1));
        }
        dsk = ap->in[18][l * 512 + g * 16 + fr];
    }
    float hr[4], hi[4];
#pragma unroll
    for (int cb = 0; cb < 4; ++cb) { hr[cb] = 0.f; hi[cb] = 0.f; }
    if (P3) {
        float tr[4], ti[4];
#pragma unroll
        for (int cb = 0; cb < 4; ++cb) { tr[cb] = pr[cb][3]; ti[cb] = pi[cb][3];
#pragma unroll
            for (int k = 0; k < 5; ++k) { const float nr = tr[cb] * tr[cb] - ti[cb] * ti[cb], ni = 2.f * tr[cb] * ti[cb]; tr[cb] = nr; ti[cb] = ni; } }
        const float* sp = SST + ((size_t)(unit - c) * 64 + fr) * 2;
        for (int cc = 0; cc < c; ++cc) {
#pragma unroll
            for (int cb = 0; cb < 4; ++cb) { const float2 s = *(const float2*)(sp + (size_t)cc * 128 + 32 * cb);
                const float nr = tr[cb] * hr[cb] - ti[cb] * hi[cb] + s.x, ni = tr[cb] * hi[cb] + ti[cb] * hr[cb] + s.y; hr[cb] = nr; hi[cb] = ni; }
        }
    }
    const size_t row0 = (size_t)(b * SEQ + c * 128);
    LAS bf16_t* Hs = (LAS bf16_t*)wlds;
    u32x4 uwn = {0u, 0u, 0u, 0u};
    if (fq < 2) uwn = *(const u32x4*)(PROJ + (row0 + fr) * INW + 2560 + g * 16 + 8 * fq);
#pragma unroll 1
    for (int blk = 0; blk < 8; ++blk) {
        const u32x4 uw = uwn;
        if (fq < 2) uwn = *(const u32x4*)(PROJ + (row0 + 16 * (blk < 7 ? blk + 1 : blk) + fr) * INW + 2560 + g * 16 + 8 * fq);
        const bf16x8 uf = as_bf8(uw);
        f32x4 bu[8];
#pragma unroll
        for (int k = 0; k < 8; ++k) bu[k] = __builtin_amdgcn_mfma_f32_16x16x32_bf16(uf, bfr[k], (f32x4){0.f, 0.f, 0.f, 0.f}, 0, 0, 0);
#pragma unroll
        for (int cb = 0; cb < 4; ++cb) {
            const float ar = pr[cb][0], ai = pi[cb][0], a4r = pr[cb][3], a4i = pi[cb][3];
            float lr_[4], li_[4];
            lr_[0] = bu[cb][0]; li_[0] = bu[cb + 4][0];
#pragma unroll
            for (int i = 1; i < 4; ++i) { lr_[i] = ar * lr_[i - 1] - ai * li_[i - 1] + bu[cb][i]; li_[i] = ar * li_[i - 1] + ai * lr_[i - 1] + bu[cb + 4][i]; }
            float cr = hr[cb], ci = hi[cb];
#pragma unroll
            for (int j = 0; j < 3; ++j) {
                const float er = __shfl(lr_[3], fr + 16 * j), ei = __shfl(li_[3], fr + 16 * j);
                const float nr = a4r * cr - a4i * ci + er, ni = a4r * ci + a4i * cr + ei;
                if (j < fq) { cr = nr; ci = ni; }
            }
            float h_r[4], h_i[4];
#pragma unroll
            for (int i = 0; i < 4; ++i) { h_r[i] = lr_[i] + pr[cb][i] * cr - pi[cb][i] * ci; h_i[i] = li_[i] + pr[cb][i] * ci + pi[cb][i] * cr; }
            hr[cb] = __shfl(h_r[3], fr + 48); hi[cb] = __shfl(h_i[3], fr + 48);
            if (P3) {
#pragma unroll
                for (int i = 0; i < 4; ++i) { Hs[(4 * fq + i) * 136 + 16 * cb + fr] = (bf16_t)f2bf(h_r[i]); Hs[(4 * fq + i) * 136 + 64 + 16 * cb + fr] = (bf16_t)f2bf(h_i[i]); }
            }
        }
        if (P3) {
            f32x4 y = (f32x4){0.f, 0.f, 0.f, 0.f};
            asm volatile("s_waitcnt lgkmcnt(0)" ::: "memory");
            bf16x8 hf[4];
#pragma unroll
            for (int ks = 0; ks < 4; ++ks) hf[ks] = *(const LAS bf16x8*)(Hs + fr * 136 + 32 * ks + 8 * fq);
            asm volatile("s_waitcnt lgkmcnt(0)" ::: "memory");
#pragma unroll
            for (int ks = 0; ks < 4; ++ks) y = __builtin_amdgcn_mfma_f32_16x16x32_bf16(hf[ks], cmf[ks], y, 0, 0, 0);
#pragma unroll
            for (int i = 0; i < 4; ++i) {
                const size_t row = row0 + 16 * blk + 4 * fq + i;
                const float uu = __uint_as_float(((unsigned)PROJ[row * INW + 2560 + g * 16 + fr]) << 16);
                YS[row * 512 + g * 16 + fr] = (bf16_t)f2bf(gelu_t(y[i] + dsk * uu));
            }
        }
    }
    if (!P3) { if (fq == 0) {
#pragma unroll
        for (int cb = 0; cb < 4; ++cb) *(float2*)(SST + ((size_t)unit * 64 + 16 * cb + fr) * 2) = make_float2(hr[cb], hi[cb]); } }
}

__device__ __forceinline__ void ssm_coef_phase(CArgs* ap, int l, float* COEF, int gw, int lane) {
    if (gw < 32) {
        const int g = gw, p = lane;
        const float dt = expf(ap->in[13][l * 32 + g]);
        const float lr = ap->in[11][(l * 32 + g) * 64 + p], li = ap->in[12][(l * 32 + g) * 64 + p];
        const float x = lr * dt, y = li * dt;
        const float ex = expf(x), cs = cosf(y), sn = sinf(y), sh = sinf(0.5f * y);
        const float abr = ex * cs, abi = ex * sn;
        const float nr = expm1f(x) * cs - 2.f * sh * sh, ni = abi;
        const float den = 1.f / (lr * lr + li * li);
        *(f32x4*)(COEF + (size_t)(g * 64 + p) * 4) = (f32x4){abr, abi, (nr * lr + ni * li) * den, (ni * lr - nr * li) * den};
    }
}
__device__ __forceinline__ void ssm_setup(CArgs* ap, const float* COEF, int l, int g, int p, float& abr, float& abi, float (&bbr)[16], float (&bbi)[16]) {
    const f32x4 cf = *(const f32x4*)(COEF + (size_t)(g * 64 + p) * 4);
    abr = cf[0]; abi = cf[1];
    const float cr = cf[2], ci = cf[3];
    const float* br = ap->in[14] + ((size_t)(l * 32 + g) * 64 + p) * 16; const float* bi = ap->in[15] + ((size_t)(l * 32 + g) * 64 + p) * 16;
#pragma unroll
    for (int q = 0; q < 4; ++q) { const f32x4 r4 = *(const f32x4*)(br + 4 * q), i4 = *(const f32x4*)(bi + 4 * q);
#pragma unroll
        for (int i = 0; i < 4; ++i) { bbr[4 * q + i] = cr * r4[i] - ci * i4[i]; bbi[4 * q + i] = cr * i4[i] + ci * r4[i]; } }
}
__device__ __forceinline__ void load_u16(const bf16_t* p, float (&u)[16]) {
    const u32x4 w0 = ((const u32x4*)p)[0], w1 = ((const u32x4*)p)[1];
    u[0] = bf_lo(w0.x); u[1] = bf_hi(w0.x); u[2] = bf_lo(w0.y); u[3] = bf_hi(w0.y); u[4] = bf_lo(w0.z); u[5] = bf_hi(w0.z); u[6] = bf_lo(w0.w); u[7] = bf_hi(w0.w);
    u[8] = bf_lo(w1.x); u[9] = bf_hi(w1.x); u[10] = bf_lo(w1.y); u[11] = bf_hi(w1.y); u[12] = bf_lo(w1.z); u[13] = bf_hi(w1.z); u[14] = bf_lo(w1.w); u[15] = bf_hi(w1.w);
}
__device__ __forceinline__ void ssm_pass1(CArgs* ap, const float* COEF, int l, const bf16_t* PROJ, float* SST, int unit, int lane) {
    const int c = unit & 63, g = (unit >> 6) & 31, b = unit >> 11;
    float abr, abi, bbr[16], bbi[16];
    ssm_setup(ap, COEF, l, g, lane, abr, abi, bbr, bbi);
    const bf16_t* up = PROJ + (size_t)(b * SEQ + c * 128) * INW + 2560 + g * 16;
    float hr = 0.f, hi = 0.f;
#pragma unroll 4
    for (int t = 0; t < 128; ++t) {
        float u[16]; load_u16(up + (size_t)t * INW, u);
        float br = 0.f, bi = 0.f;
#pragma unroll
        for (int k = 0; k < 16; ++k) { br += bbr[k] * u[k]; bi += bbi[k] * u[k]; }
        const float nr = abr * hr - abi * hi + br, ni = abr * hi + abi * hr + bi; hr = nr; hi = ni;
    }
    *(float2*)(SST + ((size_t)unit * 64 + lane) * 2) = make_float2(hr, hi);
}
template <int HALFN> __device__ __forceinline__ void rs_stage(float (&v)[64], int lane) {
    if constexpr (HALFN == 32 || HALFN == 16) {
#pragma unroll
        for (int i = 0; i < HALFN; ++i) {
            float a = v[i], b = v[i + HALFN];
            if constexpr (HALFN == 32) asm volatile("s_nop 1\n\tv_permlane32_swap_b32 %0, %1" : "+v"(a), "+v"(b));
            else asm volatile("s_nop 1\n\tv_permlane16_swap_b32 %0, %1" : "+v"(a), "+v"(b));
            v[i] = a + b;
        }
    } else {
        const bool bit = (lane & HALFN) != 0;
#pragma unroll
        for (int i = 0; i < HALFN; ++i) { const float keep = bit ? v[i + HALFN] : v[i], send = bit ? v[i] : v[i + HALFN]; v[i] = keep + __shfl_xor(send, HALFN); }
    }
}
__device__ __forceinline__ void ssm_pass3(CArgs* ap, const float* COEF, int l, const bf16_t* PROJ, const float* SST, bf16_t* YS, int unit, int lane) {
    const int c = unit & 63, g = (unit >> 6) & 31, b = unit >> 11;
    float abr, abi, bbr[16], bbi[16];
    ssm_setup(ap, COEF, l, g, lane, abr, abi, bbr, bbi);
    typedef float f32x2v __attribute__((ext_vector_type(2)));
    f32x2v cre2[8], cim2[8], bb2[16];
#pragma unroll
    for (int k = 0; k < 8; ++k) { cre2[k] = (f32x2v){ap->in[16][((size_t)(l * 32 + g) * 16 + 2 * k) * 64 + lane], ap->in[16][((size_t)(l * 32 + g) * 16 + 2 * k + 1) * 64 + lane]};
        cim2[k] = (f32x2v){ap->in[17][((size_t)(l * 32 + g) * 16 + 2 * k) * 64 + lane], ap->in[17][((size_t)(l * 32 + g) * 16 + 2 * k + 1) * 64 + lane]}; }
#pragma unroll
    for (int k = 0; k < 16; ++k) bb2[k] = (f32x2v){bbr[k], bbi[k]};
    const float dsk = ap->in[18][l * 512 + g * 16 + (lane & 15)];
    float tr = abr, ti = abi;
#pragma unroll
    for (int k = 0; k < 7; ++k) { const float nr = tr * tr - ti * ti, ni = 2.f * tr * ti; tr = nr; ti = ni; }
    float hr = 0.f, hi = 0.f;
    const float* sp = SST + ((size_t)(unit - c) * 64 + lane) * 2;
    int cc = 0;
    for (; cc + 8 <= c; cc += 8) {
        float2 s8[8];
#pragma unroll
        for (int j = 0; j < 8; ++j) s8[j] = *(const float2*)(sp + (size_t)(cc + j) * 128);
#pragma unroll
        for (int j = 0; j < 8; ++j) { const float nr = tr * hr - ti * hi + s8[j].x, ni = tr * hi + ti * hr + s8[j].y; hr = nr; hi = ni; }
    }
    for (; cc < c; ++cc) { const float2 s = *(const float2*)(sp + (size_t)cc * 128); const float nr = tr * hr - ti * hi + s.x, ni = tr * hi + ti * hr + s.y; hr = nr; hi = ni; }
    const size_t row0 = (size_t)(b * SEQ + c * 128);
    const bf16_t* up = PROJ + row0 * INW + 2560 + g * 16;
    u32x4 wn[8];
#pragma unroll
    for (int tt = 0; tt < 4; ++tt) { wn[2 * tt] = ((const u32x4*)(up + (size_t)tt * INW))[0]; wn[2 * tt + 1] = ((const u32x4*)(up + (size_t)tt * INW))[1]; }
    const int ott = lane >> 4, ok = lane & 15;
    unsigned short uun = up[(size_t)ott * INW + ok];
#pragma unroll 1
    for (int t = 0; t < 128; t += 4) {
        float v[64];
        u32x4 wc[8];
#pragma unroll
        for (int j = 0; j < 8; ++j) wc[j] = wn[j];
        const unsigned short uuc = uun;
        const int tn = (t + 4 < 128) ? t + 4 : t;
#pragma unroll
        for (int tt = 0; tt < 4; ++tt) { wn[2 * tt] = ((const u32x4*)(up + (size_t)(tn + tt) * INW))[0]; wn[2 * tt + 1] = ((const u32x4*)(up + (size_t)(tn + tt) * INW))[1]; }
        uun = up[(size_t)(tn + ott) * INW + ok];
#pragma unroll
        for (int tt = 0; tt < 4; ++tt) {
            const u32x4 w0 = wc[2 * tt], w1 = wc[2 * tt + 1];
            float u[16];
            u[0] = bf_lo(w0.x); u[1] = bf_hi(w0.x); u[2] = bf_lo(w0.y); u[3] = bf_hi(w0.y); u[4] = bf_lo(w0.z); u[5] = bf_hi(w0.z); u[6] = bf_lo(w0.w); u[7] = bf_hi(w0.w);
            u[8] = bf_lo(w1.x); u[9] = bf_hi(w1.x); u[10] = bf_lo(w1.y); u[11] = bf_hi(w1.y); u[12] = bf_lo(w1.z); u[13] = bf_hi(w1.z); u[14] = bf_lo(w1.w); u[15] = bf_hi(w1.w);
            f32x2v b2 = (f32x2v){0.f, 0.f};
#pragma unroll
            for (int k = 0; k < 16; ++k) b2 += bb2[k] * u[k];
            const float nr = abr * hr - abi * hi + b2.x, ni = abr * hi + abi * hr + b2.y; hr = nr; hi = ni;
#pragma unroll
            for (int k = 0; k < 8; ++k) { const f32x2v p = cre2[k] * hr - cim2[k] * hi; v[tt * 16 + 2 * k] = p.x; v[tt * 16 + 2 * k + 1] = p.y; }
        }
        rs_stage<32>(v, lane); rs_stage<16>(v, lane); rs_stage<8>(v, lane); rs_stage<4>(v, lane); rs_stage<2>(v, lane); rs_stage<1>(v, lane);
        const float uu = __uint_as_float(((unsigned)uuc) << 16);
        const float y = gelu_t(v[0] + dsk * uu);
        YS[(row0 + t + ott) * 512 + g * 16 + ok] = (bf16_t)f2bf(y);
    }
}

__device__ __forceinline__ void ssm_pass3h(CArgs* ap, const float* COEF, int l, const bf16_t* PROJ, const float* SST, bf16_t* YS, LAS unsigned char* wlds, int unit, int lane) {
    const int c = unit & 63, g = (unit >> 6) & 31, b = unit >> 11;
    const int fr = lane & 15, fq = lane >> 4;
    float abr, abi, bbr[16], bbi[16];
    ssm_setup(ap, COEF, l, g, lane, abr, abi, bbr, bbi);
    typedef float f32x2v __attribute__((ext_vector_type(2)));
    f32x2v bb2[16];
#pragma unroll
    for (int k = 0; k < 16; ++k) bb2[k] = (f32x2v){bbr[k], bbi[k]};
    float cmB[32];
#pragma unroll
    for (int j = 0; j < 8; ++j) {
        const int k0 = 16 * j + 4 * fq;
        const float* src = (j < 4 ? ap->in[16] : ap->in[17]) + ((size_t)(l * 32 + g) * 16 + fr) * 64 + (j < 4 ? k0 : k0 - 64);
        const f32x4 c4 = *(const f32x4*)src;
#pragma unroll
        for (int r = 0; r < 4; ++r) cmB[4 * j + r] = (j < 4) ? c4[r] : -c4[r];
    }
    const float dsk = ap->in[18][l * 512 + g * 16 + fr];
    float tr = abr, ti = abi;
#pragma unroll
    for (int k = 0; k < 7; ++k) { const float nr = tr * tr - ti * ti, ni = 2.f * tr * ti; tr = nr; ti = ni; }
    float hr = 0.f, hi = 0.f;
    const float* sp = SST + ((size_t)(unit - c) * 64 + lane) * 2;
    int cc = 0;
    for (; cc + 8 <= c; cc += 8) {
        float2 s8[8];
#pragma unroll
        for (int j = 0; j < 8; ++j) s8[j] = *(const float2*)(sp + (size_t)(cc + j) * 128);
#pragma unroll
        for (int j = 0; j < 8; ++j) { const float nr = tr * hr - ti * hi + s8[j].x, ni = tr * hi + ti * hr + s8[j].y; hr = nr; hi = ni; }
    }
    for (; cc < c; ++cc) { const float2 s = *(const float2*)(sp + (size_t)cc * 128); const float nr = tr * hr - ti * hi + s.x, ni = tr * hi + ti * hr + s.y; hr = nr; hi = ni; }
    const size_t row0 = (size_t)(b * SEQ + c * 128);
    const bf16_t* up = PROJ + row0 * INW + 2560 + g * 16;
    LAS float* Hf = (LAS float*)wlds;
    u32x4 wn[8];
#pragma unroll
    for (int tt = 0; tt < 4; ++tt) { wn[2 * tt] = ((const u32x4*)(up + (size_t)tt * INW))[0]; wn[2 * tt + 1] = ((const u32x4*)(up + (size_t)tt * INW))[1]; }
#pragma unroll 1
    for (int blk = 0; blk < 8; ++blk) {
        unsigned short uq[4];
#pragma unroll
        for (int i = 0; i < 4; ++i) uq[i] = up[(size_t)(16 * blk + 4 * fq + i) * INW + fr];
#pragma unroll 1
        for (int q = 0; q < 4; ++q) {
            const int t = 16 * blk + 4 * q;
            u32x4 wc[8];
#pragma unroll
            for (int j = 0; j < 8; ++j) wc[j] = wn[j];
            const int tn = (t + 4 < 128) ? t + 4 : t;
#pragma unroll
            for (int tt = 0; tt < 4; ++tt) { wn[2 * tt] = ((const u32x4*)(up + (size_t)(tn + tt) * INW))[0]; wn[2 * tt + 1] = ((const u32x4*)(up + (size_t)(tn + tt) * INW))[1]; }
#pragma unroll
            for (int tt = 0; tt < 4; ++tt) {
                const u32x4 w0 = wc[2 * tt], w1 = wc[2 * tt + 1];
                float u[16];
                u[0] = bf_lo(w0.x); u[1] = bf_hi(w0.x); u[2] = bf_lo(w0.y); u[3] = bf_hi(w0.y); u[4] = bf_lo(w0.z); u[5] = bf_hi(w0.z); u[6] = bf_lo(w0.w); u[7] = bf_hi(w0.w);
                u[8] = bf_lo(w1.x); u[9] = bf_hi(w1.x); u[10] = bf_lo(w1.y); u[11] = bf_hi(w1.y); u[12] = bf_lo(w1.z); u[13] = bf_hi(w1.z); u[14] = bf_lo(w1.w); u[15] = bf_hi(w1.w);
                f32x2v b2 = (f32x2v){0.f, 0.f};
#pragma unroll
                for (int k = 0; k < 16; ++k) b2 += bb2[k] * u[k];
                const float nr = abr * hr - abi * hi + b2.x, ni = abr * hi + abi * hr + b2.y; hr = nr; hi = ni;
                Hf[(4 * q + tt) * 132 + lane] = hr; Hf[(4 * q + tt) * 132 + 64 + lane] = hi;
            }
        }
        asm volatile("s_waitcnt lgkmcnt(0)" ::: "memory");
        f32x4 y = (f32x4){0.f, 0.f, 0.f, 0.f};
#pragma unroll
        for (int j = 0; j < 8; ++j) {
            const f32x4 a4 = *(const LAS f32x4*)(Hf + fr * 132 + 16 * j + 4 * fq);
#pragma unroll
            for (int r = 0; r < 4; ++r) y = __builtin_amdgcn_mfma_f32_16x16x4f32(a4[r], cmB[4 * j + r], y, 0, 0, 0);
        }
        asm volatile("s_waitcnt lgkmcnt(0)" ::: "memory");
#pragma unroll
        for (int i = 0; i < 4; ++i) {
            const size_t row = row0 + 16 * blk + 4 * fq + i;
            YS[row * 512 + g * 16 + fr] = (bf16_t)f2bf(gelu_t(y[i] + dsk * __uint_as_float(((unsigned)uq[i]) << 16)));
        }
    }
}

__device__ __forceinline__ void fixup_phase(const float* RAW, bf16_t* ACT, const float* cw, const float* cb, int gtid, int nthr) {
    constexpr int NC4 = DFF / 4;
    for (int it = gtid; it < 256 * 2 * NC4; it += nthr) {
        const int c = (it % NC4) * 4, r = (it / NC4) & 1, sl = it / (2 * NC4);
        const int tc = (c >> 7) * 256 + (c & 127);
        const float* base = RAW + (size_t)sl * 4 * NUP + tc; const float* prev = base - (size_t)4 * NUP;
        const bool first = (sl & 127) == 0;
        const f32x4 z = (f32x4){0.f, 0.f, 0.f, 0.f};
        const f32x4 g0 = *(const f32x4*)(base + (size_t)r * NUP), v0 = *(const f32x4*)(base + (size_t)r * NUP + 128);
        const f32x4 g63 = first ? z : *(const f32x4*)(prev + (size_t)3 * NUP), v63 = first ? z : *(const f32x4*)(prev + (size_t)3 * NUP + 128);
        f32x4 g1, g2, v1, v2;
        if (r == 1) { g1 = *(const f32x4*)base; v1 = *(const f32x4*)(base + 128); g2 = g63; v2 = v63; }
        else { g1 = g63; v1 = v63; g2 = first ? z : *(const f32x4*)(prev + (size_t)2 * NUP); v2 = first ? z : *(const f32x4*)(prev + (size_t)2 * NUP + 128); }
        const f32x4 cgt = *(const f32x4*)(cb + c) + *(const f32x4*)(cw + c) * g0 + *(const f32x4*)(cw + NUP + c) * g1 + *(const f32x4*)(cw + 2 * NUP + c) * g2;
        const f32x4 cvl = *(const f32x4*)(cb + DFF + c) + *(const f32x4*)(cw + DFF + c) * v0 + *(const f32x4*)(cw + NUP + DFF + c) * v1 + *(const f32x4*)(cw + 2 * NUP + DFF + c) * v2;
        const f32x4 o = pg8::gelu4(cgt) * cvl;
        u32x2 w; w.x = cvt_pk_bf16(o[0], o[1]); w.y = cvt_pk_bf16(o[2], o[3]);
        *(u32x2*)(ACT + (size_t)(64 * sl + r) * DFF + c) = w;
    }
}

#define XB_TMO      128
#define XB_XCNT(j)  (256  + 64 * (j))
#define XB_XSUB(j)  (1280 + 64 * (j))
#define XB_XGEN(j)  (2304 + 64 * (j))
#define XB_TOP      3328
#define XB_TOPGEN   3392
#define XCD_BAR_WORDS 3456
#define XB_SPIN_CAP (1u << 18)

__device__ __forceinline__ unsigned xb_ld(unsigned* p)              { return __hip_atomic_load(p, __ATOMIC_RELAXED, __HIP_MEMORY_SCOPE_AGENT); }
__device__ __forceinline__ unsigned xb_add(unsigned* p, unsigned v) { return __hip_atomic_fetch_add(p, v, __ATOMIC_RELAXED, __HIP_MEMORY_SCOPE_AGENT); }
__device__ __forceinline__ unsigned xb_xcc_id() { return (unsigned)__builtin_amdgcn_s_getreg((3 << 11) | 20) & 0xFu; }
#define XB_SPIN(cond, bar) do { unsigned _sp = 0; while (cond) { __builtin_amdgcn_s_sleep(1); \
    if ((++_sp & 255u) == 0u) { if (xb_ld(&(bar)[XB_TMO])) break; if (_sp > XB_SPIN_CAP) { atomicAdd(&(bar)[XB_TMO], 1u); break; } } } } while (0)

struct XcdBarrier {
    unsigned* bar; unsigned x;
    volatile LAS unsigned* st;
};

__device__ __forceinline__ XcdBarrier xcd_barrier_post(unsigned* bar, volatile LAS unsigned* st) {
    XcdBarrier b; b.bar = bar; b.x = xb_xcc_id(); b.st = st;
    if (threadIdx.x == 0) (void)xb_add(&bar[XB_XCNT(b.x)], 1u);
    return b;
}
__device__ __forceinline__ void xcd_barrier_complete(unsigned* bar, unsigned x, unsigned& nloc, unsigned& nx) {
    const unsigned G = gridDim.x * gridDim.y * gridDim.z;
    unsigned sum, cnt, mine, sp = 0u;
    for (;;) {
        sum = 0u; cnt = 0u; mine = 0u;
#pragma unroll
        for (unsigned j = 0; j < 16; ++j) { const unsigned c = xb_ld(&bar[XB_XCNT(j)]); sum += c; cnt += (c > 0u) ? 1u : 0u; mine = (j == x) ? c : mine; }
        if (sum == G) break;
        __builtin_amdgcn_s_sleep(1);
        if ((++sp & 255u) == 0u) { if (xb_ld(&bar[XB_TMO])) break; if (sp > XB_SPIN_CAP) { atomicAdd(&bar[XB_TMO], 1u); break; } }
    }
    nloc = mine > 0u ? mine : 1u; nx = cnt > 0u ? cnt : 1u;
}

__device__ __forceinline__ void xcd_barrier(const XcdBarrier& b) {
    asm volatile("s_waitcnt vmcnt(0)" ::: "memory");
    __syncthreads();
    if (threadIdx.x == 0) {
        unsigned* bar = b.bar;
        __builtin_amdgcn_s_waitcnt(0);
        unsigned nloc = b.st[0], nx = b.st[1];
        if (nloc == 0u) { xcd_barrier_complete(bar, b.x, nloc, nx); b.st[0] = nloc; b.st[1] = nx; }
        const unsigned old = xb_add(&bar[XB_XSUB(b.x)], 1u);
        const unsigned gen = old / nloc;
        if (old + 1u == (gen + 1u) * nloc) {
            __builtin_amdgcn_fence(__ATOMIC_RELEASE, "agent");
            asm volatile("s_waitcnt vmcnt(0)" ::: "memory");
            const unsigned og = xb_add(&bar[XB_TOP], 1u);
            const unsigned tg = og / nx;
            if (og + 1u == (tg + 1u) * nx) xb_add(&bar[XB_TOPGEN], 1u);
            else XB_SPIN(xb_ld(&bar[XB_TOPGEN]) == tg, bar);
            __builtin_amdgcn_fence(__ATOMIC_ACQUIRE, "agent");
            xb_add(&bar[XB_XGEN(b.x)], 1u);
            asm volatile("s_waitcnt vmcnt(0)" ::: "memory");
        } else {
            XB_SPIN(xb_ld(&bar[XB_XGEN(b.x)]) == gen, bar);
            __builtin_amdgcn_fence(__ATOMIC_ACQUIRE, "agent");
            asm volatile("s_waitcnt vmcnt(0)" ::: "memory");
        }
    }
    __syncthreads();
}

#ifdef ONLY_MODE
#define ONLY_MODE_OK(m) ((m) == ONLY_MODE)
#else
#define ONLY_MODE_OK(m) true
#endif
#ifndef PG8_SP2
#define PG8_SP2 true
#endif
#ifndef PG8_ALIGN
#define PG8_ALIGN true
#endif
template <int MODE> __device__ __forceinline__ void run_gemm(LAS unsigned char* lds, const bf16_t* A, int lda, const bf16_t* Bt, int Mr, int N, int K, const pg8::Epi<MODE>& E, int wave_in) {
    pg8::Gemm g{A, Bt, Mr, N, K, lda}; pg8::StaticOrder S; S.init(Mr, N, (int)gridDim.x, (int)blockIdx.x);
#if !defined(NO_GEMM) && (!defined(ONLY_MODE) || 1)
    if (ONLY_MODE_OK(MODE)) pg8::gemm_phase<pg8::Epi<MODE>, pg8::StaticOrder, PG8_ALIGN, PG8_SP2>(lds, g, S, E, wave_in);
#endif
}

__global__ void __launch_bounds__(NTHR, 2) fwd(Args a) {
    extern __shared__ __attribute__((aligned(16))) unsigned char lds_raw[];
    LAS unsigned char* lds = (LAS unsigned char*)lds_raw;
    cg::grid_group grid = cg::this_grid();
    const int ph_lo = a.ph_lo, ph_hi = a.ph_hi;
    const int wave_s = __builtin_amdgcn_readfirstlane((int)threadIdx.x >> 6);
    constexpr int MISC_OFF = 139264;
    if (threadIdx.x < 16) ((LAS unsigned*)(lds + MISC_OFF))[threadIdx.x] = 0u;
    __syncthreads();
    (void)xcd_barrier_post((unsigned*)(a.ws + WS_BAR), (volatile LAS unsigned*)(lds + MISC_OFF) + 8);
    for (int ph = ph_lo; ph < ph_hi; ++ph) {
        CArgs* ap = (CArgs*)__builtin_amdgcn_kernarg_segment_ptr();
        asm volatile("" : "+s"(ap));
        int tid_ = wave_s * 64 + (int)__builtin_amdgcn_mbcnt_hi(~0u, __builtin_amdgcn_mbcnt_lo(~0u, 0u)); asm volatile("" : "+v"(tid_));
        const int tid = tid_, lane = tid & 63, wave = wave_s;
        const int G = gridDim.x, gw = blockIdx.x * NWAVES + wave, NGW = G * NWAVES;
        unsigned char* ws = ap->ws;
        bf16_t* XB = (bf16_t*)(ws + WS_XB); bf16_t* MRG = (bf16_t*)(ws + WS_MRG);
        bf16_t* PROJ = (bf16_t*)(ws + WS_PROJ); bf16_t* YCAT = (bf16_t*)(ws + WS_YCAT); bf16_t* YS = (bf16_t*)(ws + WS_YS); float* SST = (float*)(ws + WS_SST);
        bf16_t* ACT = (bf16_t*)(ws + WS_ACT); float* RAW = (float*)(ws + WS_RAW);
        {
            const int l = ph / PPL, sp = ph % PPL;
            const unsigned char* wl = ws + WS_W;
            float* SS = (float*)(ws + WS_SS);
            float* COEF = (float*)(ws + WS_COEF);
            if (sp == 0) { ssm_coef_phase(ap, l, COEF, gw, lane); convert_phase(ap, l, lds, gw, NGW, wave, lane); if (l == 0) xb_phase(ap->in[0], XB, SS, gw, NGW, lane); }
            else if (sp == 1) { pg8::Epi<pg8::EP_INPROJ> E{PROJ, INW, ap->in[3] + l * 6144, nullptr, 0, nullptr, nullptr, SS + (size_t)(2 * l) * M, nullptr, nullptr}; run_gemm<pg8::EP_INPROJ>(lds, XB, D, (const bf16_t*)(wl + O_WIN), M, INW, D, E, wave); }
            else if (sp == 2) {
                for (int u = blockIdx.x; u < 256; u += G) attn_unit(lds, PROJ, YCAT, ap->in[4] + l * 128, ap->in[5] + l * 128, ap->in[6] + l * 8, u, tid, wave, lane);
                for (int u = blockIdx.x; u < 512; u += G) sg_unit(lds, PROJ, YCAT, ap->in[7] + l * 512, ap->in[8] + l * 512, ap->in[9] + (size_t)l * 4 * 128 * 128, ap->in[10] + l * 512, u, tid, wave, lane);
                for (int u = gw; u < 4096; u += NGW) ssm_unit<false>(ap, COEF, l, PROJ, SST, YS, lds + wave * 4352, u, lane);
            }
            else if (sp == 3) { for (int u = gw; u < 4096; u += NGW) ssm_pass3h(ap, COEF, l, PROJ, SST, YS, lds + wave * 8448, u, lane); }
            else if (sp == 4) { pg8::Epi<pg8::EP_GLU> E{YCAT + 1536, D, ap->in[20] + l * 512, YS, 512, nullptr}; run_gemm<pg8::EP_GLU>(lds, YS, 512, (const bf16_t*)(wl + O_WGLU), M, 512, 512, E, wave); }
            else if (sp == 5) {
                { pg8::Epi<pg8::EP_MERGE0> E{MRG, D, nullptr, PROJ + 3072, INW, nullptr}; run_gemm<pg8::EP_MERGE0>(lds, YCAT, D, (const bf16_t*)(wl + O_WA), M, D, 1024, E, wave); }
#pragma unroll 1
                for (int j = 1; j < 3; ++j) { pg8::Epi<pg8::EP_MERGE1> E{MRG, D, nullptr, PROJ + 3072 + j * D, INW, nullptr};
                    run_gemm<pg8::EP_MERGE1>(lds, YCAT + 512 + 512 * j, D, (const bf16_t*)(wl + (j == 1 ? O_WSG : O_WSSM)), M, D, 512, E, wave); }
            }
            else if (sp == 7) { pg8::Epi<pg8::EP_UPCONV> E{ACT, DFF, ap->in[27] + (size_t)l * 3 * NUP, nullptr, 0, ap->in[28] + (size_t)l * NUP, RAW, SS + (size_t)(2 * l + 1) * M, nullptr, nullptr};
                run_gemm<pg8::EP_UPCONV>(lds, XB, D, (const bf16_t*)(wl + O_WUP), M, NUP, D, E, wave); }
            else if (sp == 8) fixup_phase(RAW, ACT, ap->in[27] + (size_t)l * 3 * NUP, ap->in[28] + (size_t)l * NUP, blockIdx.x * NTHR + tid, G * NTHR);
            else {
                const bf16_t* A; const bf16_t* Bt; int K; float* sso;
                if (sp == 6) { A = MRG; Bt = (const bf16_t*)(wl + O_WOUT); K = D; sso = SS + (size_t)(2 * l + 1) * M; }
                else { A = ACT; Bt = (const bf16_t*)(wl + O_WDN); K = DFF; sso = (l == 0) ? SS + (size_t)2 * M : nullptr; }
                pg8::Epi<pg8::EP_RESID> E{sso ? nullptr : ap->out, D, nullptr, nullptr, 0, nullptr, nullptr, nullptr, XB, sso};
                run_gemm<pg8::EP_RESID>(lds, A, K, Bt, M, D, K, E, wave);
            }
        }
        if (ph + 1 < ph_hi) {
            if (ph == ph_lo) grid.sync();
            else { XcdBarrier bar; bar.bar = (unsigned*)(ws + WS_BAR); bar.x = xb_xcc_id(); bar.st = (volatile LAS unsigned*)(lds + MISC_OFF) + 8; xcd_barrier(bar); }
        }
    }
}
}

extern "C" void kernel_launch(void* const* d_in, const int* in_sizes, int n_in, void* d_out, int out_size, void* d_ws, size_t ws_size, hipStream_t stream) {
    using namespace mk;
    static int grid = 0;
    if (grid == 0) {
        if (n_in != 30 || out_size != M * D || ws_size < WS_END) { fprintf(stderr, "kernel_launch: unexpected problem (n_in %d out %d ws %zu need %zu)\n", n_in, out_size, ws_size, (size_t)WS_END); grid = -1; return; }
        int dev = 0, cus = 0, per_cu = 0;
        (void)hipGetDevice(&dev); (void)hipDeviceGetAttribute(&cus, hipDeviceAttributeMultiprocessorCount, dev);
        (void)hipFuncSetAttribute((const void*)fwd, hipFuncAttributeMaxDynamicSharedMemorySize, LDS_BYTES);
        if (hipOccupancyMaxActiveBlocksPerMultiprocessor(&per_cu, (const void*)fwd, NTHR, LDS_BYTES) != hipSuccess || per_cu < 1) { fprintf(stderr, "kernel_launch: occupancy query gave %d\n", per_cu); per_cu = 1; }
        (void)hipGetLastError();
        grid = cus * 1;
    }
    if (grid < 0) return;
    Args a{};
    for (int i = 0; i < 30; ++i) a.in[i] = (const float*)d_in[i];
    a.out = (float*)d_out; a.ws = (unsigned char*)d_ws;
    (void)hipMemsetAsync((unsigned char*)d_ws + WS_SS, 0, (size_t)1 * MiB, stream);
#if MK_MULTI
    for (int p = 0; p < NPH; ++p) { a.ph_lo = p; a.ph_hi = p + 1; hipLaunchKernelGGL(fwd, dim3(grid), dim3(NTHR), LDS_BYTES, stream, a); }
#else
    a.ph_lo = 0; a.ph_hi = NPH;
    void* args[] = {&a};
    hipError_t e = hipLaunchCooperativeKernel((const void*)fwd, dim3(grid), dim3(NTHR), args, LDS_BYTES, stream);
    if (e != hipSuccess) fprintf(stderr, "cooperative launch failed: %s (grid %d)\n", hipGetErrorString(e), grid);
#endif
}
```

```cpp
#include <hip/hip_runtime.h>
#include <hip/hip_cooperative_groups.h>
#include <cstdio>
#include <cstdint>
#include <cmath>
namespace cg = cooperative_groups;
#ifndef REP_CONVERT
#define REP_CONVERT 1
#endif
#ifndef REP_SSM
#define REP_SSM 1
#endif
#ifndef REP_ATT
#define REP_ATT 1
#endif
#ifndef MK_MULTI
#define MK_MULTI 0
#endif
namespace pg8 {
#define PG8_LAS __attribute__((address_space(3)))
typedef unsigned short bf16_t;
typedef short bf16x8 __attribute__((ext_vector_type(8)));
typedef float f32x4 __attribute__((ext_vector_type(4)));
typedef unsigned u32x4 __attribute__((ext_vector_type(4)));
constexpr int BM = 256, BK = 64, HALF = 128, HTB = HALF * BK * 2  , STAGE_BYTES = 8 * HTB, NXCD = 8, WGM = 8;

__host__ __device__ __forceinline__ int lds_byte(int r, int c) { const int st = (r >> 4) * 2 + (c >> 5), rr = r & 15, cc = c & 31, ob = rr * 64 + cc * 2; return st * 1024 + (ob ^ (((ob >> 9) & 1) << 5)); }
__host__ __device__ __forceinline__ void stage_rc(int b, int& R, int& C) { const int st = b / 1024, sb = b % 1024, swz = sb ^ (((sb >> 9) & 1) << 5); R = (st >> 1) * 16 + swz / 64; C = (st & 1) * 32 + (swz % 64) / 2; }
__host__ __device__ __forceinline__ int perm32(int rho) { const int n = rho >> 4, i = rho & 15; return 8 * (i >> 2) + 4 * n + (i & 3); }

struct Unit { int pm, pn; };
struct Gemm { const bf16_t* A; const bf16_t* Bt; int M, N, K, lda; };

struct StaticOrder {
    int nM, nN, nwg, G, c;
    __host__ __device__ void init(int M, int N, int G_, int c_) { nM = M / BM; nN = N / BM; nwg = nM * nN; G = G_; c = c_; }
    __host__ __device__ bool next(int i, Unit& u) const {
        const long L = (long)i * G + c; if (L >= nwg) return false;
        int wgid = (int)L; { const int q = nwg / NXCD, r = nwg % NXCD, xcd = wgid % NXCD, off = wgid / NXCD; wgid = (xcd < r ? xcd * (q + 1) : r * (q + 1) + (xcd - r) * q) + off; }
        const int nig = WGM * nN, gid = wgid / nig, fm = gid * WGM, gsz = (nM - fm) < WGM ? (nM - fm) : WGM;
        u.pm = fm + ((wgid % nig) % gsz); u.pn = (wgid % nig) / gsz; return true;
    }
    __device__ __forceinline__ void a_ready(const Unit&) const {}
    __device__ __forceinline__ void done(const Unit&) const {}
};

__device__ __forceinline__ unsigned cvt_pk_bf16(float lo, float hi) { unsigned r; asm volatile("v_cvt_pk_bf16_f32 %0, %1, %2" : "=v"(r) : "v"(lo), "v"(hi)); return r; }
__device__ __forceinline__ float bf_lo(unsigned w) { return __uint_as_float(w << 16); }
__device__ __forceinline__ float bf_hi(unsigned w) { return __uint_as_float(w & 0xffff0000u); }
__device__ __forceinline__ float sigm(float x) { return __builtin_amdgcn_rcpf(1.f + __expf(-x)); }
__device__ __forceinline__ float gelu_t(float x) { const float p = __builtin_fmaf(x * x, -0.10294324f, -2.30220819f); return x * __builtin_amdgcn_rcpf(1.f + __builtin_amdgcn_exp2f(x * p)); }
__device__ __forceinline__ f32x4 sigm4(f32x4 v) { return (f32x4){sigm(v[0]), sigm(v[1]), sigm(v[2]), sigm(v[3])}; }
__device__ __forceinline__ f32x4 gelu4(f32x4 v) { return (f32x4){gelu_t(v[0]), gelu_t(v[1]), gelu_t(v[2]), gelu_t(v[3])}; }
__device__ __forceinline__ u32x4 pack8(f32x4 a, f32x4 b) { u32x4 w; w.x = cvt_pk_bf16(a[0], a[1]); w.y = cvt_pk_bf16(a[2], a[3]); w.z = cvt_pk_bf16(b[0], b[1]); w.w = cvt_pk_bf16(b[2], b[3]); return w; }
__device__ __forceinline__ void unpack8(u32x4 w, f32x4& a, f32x4& b) { a = (f32x4){bf_lo(w.x), bf_hi(w.x), bf_lo(w.y), bf_hi(w.y)}; b = (f32x4){bf_lo(w.z), bf_hi(w.z), bf_lo(w.w), bf_hi(w.w)}; }
enum { EP_INPROJ = 0, EP_GLU = 1, EP_MERGE0 = 2, EP_MERGE1 = 3, EP_RESID = 4, EP_RAW = 5, EP_UPCONV = 6 };
template <int CTRL> __device__ __forceinline__ float dpp_f(float x) { return __builtin_bit_cast(float, __builtin_amdgcn_update_dpp(0, __builtin_bit_cast(int, x), CTRL, 0xf, 0xf, false)); }
template <int CTRL> __device__ __forceinline__ f32x4 dpp4(f32x4 v) { return (f32x4){dpp_f<CTRL>(v[0]), dpp_f<CTRL>(v[1]), dpp_f<CTRL>(v[2]), dpp_f<CTRL>(v[3])}; }
template <int MODE> struct Epi {
    static constexpr bool PERM = true, AFTER_DRAIN = false;
    void* O; int ldc; const float* bias; const bf16_t* aux; int ldaux; const float* xin; float* raw; const float* ss; bf16_t* xb; float* ssout;
    __device__ __forceinline__ void operator()(const f32x4 (&acc)[2][2][4][2], const Unit& u, int wr, int wc, int fr, int fq) const {
        const int row0 = u.pm * BM + wr * 64 + fr, col0 = u.pn * BM + wc * 32 + 8 * fq;
        if constexpr (MODE == EP_UPCONV) {
            constexpr int NUPc = 11264, DFFc = 5632;
            const int cgl = u.pn * 128 + wc * 32 + 8 * fq, tcol = u.pn * 256 + wc * 32 + 8 * fq;
            float rs[2][4];
#pragma unroll
            for (int ai = 0; ai < 2; ++ai)
#pragma unroll
                for (int m = 0; m < 4; ++m) rs[ai][m] = rsqrtf(ss[row0 + ai * HALF + m * 16] * (1.f / 2048.f) + 1e-6f);
#pragma unroll
            for (int ai = 0; ai < 2; ++ai) {
                const int slab = u.pm * 4 + ai * 2 + wr;
                if (fr < 2) {
#pragma unroll
                    for (int bj = 0; bj < 2; ++bj)
#pragma unroll
                        for (int n = 0; n < 2; ++n) *(f32x4*)(raw + (size_t)(slab * 4 + fr) * NUPc + tcol + bj * 128 + 4 * n) = acc[ai][bj][0][n] * rs[ai][0];
                }
                if (fr >= 14) {
#pragma unroll
                    for (int bj = 0; bj < 2; ++bj)
#pragma unroll
                        for (int n = 0; n < 2; ++n) *(f32x4*)(raw + (size_t)(slab * 4 + fr - 12) * NUPc + tcol + bj * 128 + 4 * n) = acc[ai][bj][3][n] * rs[ai][3];
                }
            }
#pragma unroll
            for (int n = 0; n < 2; ++n) {
                const int c = cgl + 4 * n;
                const f32x4 wg0 = *(const f32x4*)(bias + c), wg1 = *(const f32x4*)(bias + NUPc + c), wg2 = *(const f32x4*)(bias + 2 * NUPc + c), bg = *(const f32x4*)(xin + c);
                const f32x4 wv0 = *(const f32x4*)(bias + DFFc + c), wv1 = *(const f32x4*)(bias + NUPc + DFFc + c), wv2 = *(const f32x4*)(bias + 2 * NUPc + DFFc + c), bv = *(const f32x4*)(xin + DFFc + c);
#pragma unroll
                for (int ai = 0; ai < 2; ++ai) {
                    f32x4 pg1 = (f32x4){0.f, 0.f, 0.f, 0.f}, pg2 = pg1, pv1 = pg1, pv2 = pg1;
#pragma unroll
                    for (int m = 0; m < 4; ++m) {
                        const f32x4 g = acc[ai][0][m][n] * rs[ai][m], v = acc[ai][1][m][n] * rs[ai][m];
                        const f32x4 g1 = dpp4<0x121>(g), g2 = dpp4<0x122>(g), v1 = dpp4<0x121>(v), v2 = dpp4<0x122>(v);
                        const f32x4 gp1 = (fr >= 1) ? g1 : pg1, gp2 = (fr >= 2) ? g2 : pg2, vp1 = (fr >= 1) ? v1 : pv1, vp2 = (fr >= 2) ? v2 : pv2;
                        const f32x4 cgt = bg + wg0 * g + wg1 * gp1 + wg2 * gp2, cvl = bv + wv0 * v + wv1 * vp1 + wv2 * vp2;
                        const f32x4 o = gelu4(cgt) * cvl;
                        typedef unsigned u32x2e __attribute__((ext_vector_type(2)));
                        u32x2e w; w.x = cvt_pk_bf16(o[0], o[1]); w.y = cvt_pk_bf16(o[2], o[3]);
                        if (!(m == 0 && fr < 2)) *(u32x2e*)((bf16_t*)O + (size_t)(row0 + ai * HALF + m * 16) * DFFc + c) = w;
                        pg1 = g1; pg2 = g2; pv1 = v1; pv2 = v2;
                    }
                }
            }
            return;
        }
        int kind = 0;
        if (MODE == EP_INPROJ) kind = (u.pn >= 12) ? 2 : ((u.pn >= 6 && u.pn < 10) ? 1 : 0);
        float rsr[2][4]; f32x4 cb0[2], cb1[2];
#pragma unroll
        for (int bj = 0; bj < 2; ++bj) { cb0[bj] = (f32x4){0.f, 0.f, 0.f, 0.f}; cb1[bj] = cb0[bj]; }
        if (MODE == EP_INPROJ) {
#pragma unroll
            for (int ai = 0; ai < 2; ++ai)
#pragma unroll
                for (int m = 0; m < 4; ++m) rsr[ai][m] = rsqrtf(ss[row0 + ai * HALF + m * 16] * (1.f / 2048.f) + 1e-6f);
            if (kind == 2) {
#pragma unroll
                for (int bj = 0; bj < 2; ++bj) { cb0[bj] = *(const f32x4*)(bias + (col0 + bj * HALF - 3072)); cb1[bj] = *(const f32x4*)(bias + (col0 + bj * HALF - 3072) + 4); }
            }
        }
        if (MODE == EP_GLU) {
#pragma unroll
            for (int bj = 0; bj < 2; ++bj) { cb0[bj] = *(const f32x4*)(bias + col0 + bj * HALF); cb1[bj] = *(const f32x4*)(bias + col0 + bj * HALF + 4); }
        }
#pragma unroll
        for (int ai = 0; ai < 2; ++ai)
#pragma unroll
            for (int m = 0; m < 4; ++m) {
                const size_t row = (size_t)(row0 + ai * HALF + m * 16);
                float ssq = 0.f;
#pragma unroll
                for (int bj = 0; bj < 2; ++bj) {
                    const int col = col0 + bj * HALF;
                    f32x4 v0 = acc[ai][bj][m][0], v1 = acc[ai][bj][m][1];
                    if (MODE == EP_INPROJ) {
                        const float rs = rsr[ai][m];
                        v0 = v0 * rs; v1 = v1 * rs;
                        if (kind == 1) { v0 = gelu4(v0); v1 = gelu4(v1); }
                        else if (kind == 2) { v0 = sigm4(v0 + cb0[bj]); v1 = sigm4(v1 + cb1[bj]); }
                        *(u32x4*)((bf16_t*)O + row * ldc + col) = pack8(v0, v1);
                    } else if (MODE == EP_GLU) {
                        f32x4 y0, y1; unpack8(*(const u32x4*)(aux + row * ldaux + col), y0, y1);
                        v0 = y0 * sigm4(v0 + cb0[bj]); v1 = y1 * sigm4(v1 + cb1[bj]);
                        *(u32x4*)((bf16_t*)O + row * ldc + col) = pack8(v0, v1);
                    } else if (MODE == EP_MERGE0 || MODE == EP_MERGE1) {
                        f32x4 g0, g1; unpack8(*(const u32x4*)(aux + row * ldaux + col), g0, g1);
                        v0 = g0 * v0; v1 = g1 * v1;
                        if (MODE == EP_MERGE1) { f32x4 o0, o1; unpack8(*(const u32x4*)((const bf16_t*)O + row * ldc + col), o0, o1); v0 = v0 + o0; v1 = v1 + o1; }
                        *(u32x4*)((bf16_t*)O + row * ldc + col) = pack8(v0, v1);
                    } else if (MODE == EP_RESID) {
                        f32x4 x0, x1; unpack8(*(const u32x4*)(xb + row * ldc + col), x0, x1); x0 = x0 + v0; x1 = x1 + v1;
                        if (O) { *(f32x4*)((float*)O + row * ldc + col) = x0; *(f32x4*)((float*)O + row * ldc + col + 4) = x1; }
                        if (ssout) {
                            *(u32x4*)(xb + row * ldc + col) = pack8(x0, x1);
                            const float q = (x0[0] * x0[0] + x0[1] * x0[1]) + (x0[2] * x0[2] + x0[3] * x0[3]) + (x1[0] * x1[0] + x1[1] * x1[1]) + (x1[2] * x1[2] + x1[3] * x1[3]);
                            if (bj == 0) ssq = q; else ssq += q;
                        }
                    } else {
                        *(u32x4*)((bf16_t*)O + row * ldc + col) = pack8(v0, v1);
                    }
                }
                if (MODE == EP_RESID) { if (ssout) { ssq += __shfl_xor(ssq, 16); ssq += __shfl_xor(ssq, 32); if (fq == 0) unsafeAtomicAdd(ssout + row, ssq); } }
                if (m == 3) asm volatile("" ::: "memory");
            }
    }
};
template <class Epi, class Sched, bool ALIGN_EPI = false, bool SP2 = false>
__device__ __forceinline__ void gemm_phase(PG8_LAS unsigned char* lds, const Gemm g, const Sched& S, const Epi& E, int wave_in) {
    int tid_ = wave_in * 64 + (int)__builtin_amdgcn_mbcnt_hi(~0u, __builtin_amdgcn_mbcnt_lo(~0u, 0u)); asm volatile("" : "+v"(tid_));
    const int tid = tid_, wid = __builtin_amdgcn_readfirstlane(tid >> 6), lane = tid & 63, wr = wid >> 2, wc = wid & 3, fr = lane & 15, fq = lane >> 4;
    const int K = g.K, nt = K / BK;
    unsigned voffA[2], voffB[2];
#pragma unroll
    for (int i = 0; i < 2; ++i) { int R, C; stage_rc(tid * 16 + i * 8192, R, C); const int Rb = Epi::PERM ? ((R & ~31) + perm32(R & 31)) : R;
        voffA[i] = (unsigned)(R * g.lda + C) * 2u; voffB[i] = (unsigned)(Rb * K + C) * 2u; }
    const size_t kstep = (size_t)(BK * 2);
    const size_t hstep = (size_t)HALF * K * 2;
    const size_t tstep = 2 * hstep; const size_t hstepA = (size_t)HALF * g.lda * 2, tstepA = 2 * hstepA;
    const unsigned ldsw = (unsigned)wid * 1024u;
    const int aoff = lds_byte(wr * 64 + fr, fq * 8), boff = lds_byte(wc * 32 + fr, fq * 8);
#define PG8_SA(b, h) (((b) * 2 + (h)) * HTB)
#define PG8_SB(b, h) ((4 + (b) * 2 + (h)) * HTB)
#define PG8_STAGE(bufoff, gbase, voff) do { _Pragma("unroll") for (int _i = 0; _i < 2; ++_i) \
        __builtin_amdgcn_global_load_lds((const unsigned*)((const char*)(gbase) + (voff)[_i]), (PG8_LAS unsigned*)(lds + (bufoff) + ldsw + _i * 8192), 16, 0, 0); } while (0)
#define PG8_LDA(dst, b, h) do { _Pragma("unroll") for (int m = 0; m < 4; ++m) _Pragma("unroll") for (int k = 0; k < 2; ++k) dst[m][k] = *(const PG8_LAS bf16x8*)(lds + PG8_SA(b, h) + aoff + m * 2048 + k * 1024); } while (0)
#define PG8_LDB(dst, b, h) do { _Pragma("unroll") for (int n = 0; n < 2; ++n) _Pragma("unroll") for (int k = 0; k < 2; ++k) dst[n][k] = *(const PG8_LAS bf16x8*)(lds + PG8_SB(b, h) + boff + n * 2048 + k * 1024); } while (0)
#define PG8_MMA(ai, bj, At, Bt) do { __builtin_amdgcn_s_setprio(1); _Pragma("unroll") for (int m = 0; m < 4; ++m) _Pragma("unroll") for (int n = 0; n < 2; ++n) _Pragma("unroll") for (int k = 0; k < 2; ++k) \
        acc[ai][bj][m][n] = __builtin_amdgcn_mfma_f32_16x16x32_bf16(Bt[n][k], At[m][k], acc[ai][bj][m][n], 0, 0, 0); __builtin_amdgcn_s_setprio(0); } while (0)
#define PG8_WAIT_V(n) asm volatile("s_waitcnt vmcnt(" #n ")" ::: "memory")
#define PG8_WAIT_L(n) asm volatile("s_waitcnt lgkmcnt(" #n ")" ::: "memory")
#define PG8_BAR __builtin_amdgcn_s_barrier()
#define PG8_SCHED __builtin_amdgcn_sched_barrier(0)
    Unit cur, nxt; int ui = 0;
    if (!S.next(0, cur)) return;
    f32x4 acc[2][2][4][2];
#pragma unroll
    for (int a = 0; a < 2; ++a)
#pragma unroll
        for (int b = 0; b < 2; ++b)
#pragma unroll
            for (int m = 0; m < 4; ++m)
#pragma unroll
                for (int n = 0; n < 2; ++n) acc[a][b][m][n] = (f32x4){0.f, 0.f, 0.f, 0.f};
    bf16x8 At[4][2], B0[2][2], B1[2][2];
    const char* cA = (const char*)g.A + (size_t)cur.pm * tstepA; const char* cB = (const char*)g.Bt + (size_t)cur.pn * tstep;
    S.a_ready(cur);
    if constexpr (SP2) {
        PG8_STAGE(PG8_SB(0, 0), cB, voffB); PG8_STAGE(PG8_SB(0, 1), cB + hstep, voffB); PG8_STAGE(PG8_SA(0, 0), cA, voffA); PG8_STAGE(PG8_SA(0, 1), cA + hstepA, voffA);
        if (wr == 1) PG8_BAR;
        PG8_WAIT_V(2); PG8_BAR;
        PG8_STAGE(PG8_SB(1, 0), cB + kstep, voffB); PG8_STAGE(PG8_SA(1, 0), cA + kstep, voffA); PG8_STAGE(PG8_SB(1, 1), cB + hstep + kstep, voffB);
        PG8_WAIT_V(6); PG8_BAR;
    } else {
        PG8_STAGE(PG8_SB(0, 0), cB, voffB); PG8_STAGE(PG8_SA(0, 0), cA, voffA); PG8_STAGE(PG8_SB(0, 1), cB + hstep, voffB); PG8_STAGE(PG8_SA(0, 1), cA + hstepA, voffA);
        if (wr == 1) PG8_BAR;
        PG8_WAIT_V(4); PG8_BAR;
        PG8_STAGE(PG8_SB(1, 0), cB + kstep, voffB); PG8_STAGE(PG8_SA(1, 0), cA + kstep, voffA); PG8_STAGE(PG8_SB(1, 1), cB + hstep + kstep, voffB);
        PG8_WAIT_V(6); PG8_BAR;
    }
    for (;;) {
        const bool has_next = S.next(ui + 1, nxt);
        const char* nA = has_next ? (const char*)g.A + (size_t)nxt.pm * tstepA : cA; const char* nB = has_next ? (const char*)g.Bt + (size_t)nxt.pn * tstep : cB;
        for (int t = 0; t < nt; t += 2) {
            const bool last = (t == nt - 2);
            const char* a1 = cA + (size_t)(t + 1) * kstep;
            const char* a2 = last ? nA : cA + (size_t)(t + 2) * kstep; const char* b2 = last ? nB : cB + (size_t)(t + 2) * kstep;
            const char* a3 = a2 + kstep; const char* b3 = b2 + kstep;
            if (last && has_next) S.a_ready(nxt);
            if constexpr (SP2) {
            PG8_LDB(B0, 0, 0); PG8_LDB(B1, 0, 1); PG8_SCHED; PG8_LDA(At, 0, 0); PG8_STAGE(PG8_SA(1, 1), a1 + hstepA, voffA);
            PG8_WAIT_V(8); PG8_WAIT_L(0); PG8_BAR; PG8_MMA(0, 0, At, B0); PG8_MMA(0, 1, At, B1); PG8_BAR; PG8_SCHED;
            PG8_LDA(At, 0, 1); PG8_STAGE(PG8_SB(0, 0), b2, voffB); PG8_STAGE(PG8_SB(0, 1), b2 + hstep, voffB); PG8_STAGE(PG8_SA(0, 0), a2, voffA);
            PG8_WAIT_V(8); PG8_WAIT_L(0); PG8_BAR; PG8_MMA(1, 0, At, B0); PG8_MMA(1, 1, At, B1); PG8_BAR; PG8_SCHED;
            PG8_LDB(B0, 1, 0); PG8_LDB(B1, 1, 1); PG8_SCHED; PG8_LDA(At, 1, 0); PG8_STAGE(PG8_SA(0, 1), a2 + hstepA, voffA);
            PG8_WAIT_V(8); PG8_WAIT_L(0); PG8_BAR; PG8_MMA(0, 0, At, B0); PG8_MMA(0, 1, At, B1); PG8_BAR; PG8_SCHED;
            PG8_LDA(At, 1, 1); PG8_STAGE(PG8_SB(1, 0), b3, voffB); PG8_STAGE(PG8_SB(1, 1), b3 + hstep, voffB); PG8_STAGE(PG8_SA(1, 0), a3, voffA);
            PG8_WAIT_V(8); PG8_WAIT_L(0); PG8_BAR; PG8_MMA(1, 0, At, B0); PG8_MMA(1, 1, At, B1); PG8_BAR; PG8_SCHED;
            } else {
            PG8_LDB(B0, 0, 0); PG8_SCHED; PG8_LDA(At, 0, 0); PG8_STAGE(PG8_SA(1, 1), a1 + hstepA, voffA);
            PG8_WAIT_L(8); PG8_BAR; PG8_WAIT_L(0); PG8_MMA(0, 0, At, B0); PG8_BAR; PG8_SCHED;
            PG8_LDB(B1, 0, 1); PG8_STAGE(PG8_SB(0, 0), b2, voffB);
            PG8_BAR; PG8_WAIT_L(0); PG8_MMA(0, 1, At, B1); PG8_BAR;
            PG8_LDA(At, 0, 1); PG8_STAGE(PG8_SA(0, 0), a2, voffA);
            PG8_BAR; PG8_WAIT_L(0); PG8_MMA(1, 0, At, B0); PG8_BAR; PG8_SCHED;
            PG8_STAGE(PG8_SB(0, 1), b2 + hstep, voffB);
            PG8_WAIT_V(6); PG8_BAR; PG8_MMA(1, 1, At, B1); PG8_BAR;
            PG8_LDB(B0, 1, 0); PG8_SCHED; PG8_LDA(At, 1, 0); PG8_STAGE(PG8_SA(0, 1), a2 + hstepA, voffA);
            PG8_WAIT_L(8); PG8_BAR; PG8_WAIT_L(0); PG8_MMA(0, 0, At, B0); PG8_BAR; PG8_SCHED;
            PG8_LDB(B1, 1, 1); PG8_STAGE(PG8_SB(1, 0), b3, voffB);
            PG8_BAR; PG8_WAIT_L(0); PG8_MMA(0, 1, At, B1); PG8_BAR;
            PG8_LDA(At, 1, 1); PG8_STAGE(PG8_SA(1, 0), a3, voffA);
            PG8_BAR; PG8_WAIT_L(0); PG8_MMA(1, 0, At, B0); PG8_BAR; PG8_SCHED;
            PG8_STAGE(PG8_SB(1, 1), b3 + hstep, voffB);
            PG8_WAIT_V(6); PG8_BAR; PG8_MMA(1, 1, At, B1); PG8_BAR;
            }
        }
        if constexpr (ALIGN_EPI) { if (wr == 0) PG8_BAR; }
        if constexpr (!Epi::AFTER_DRAIN) { E(acc, cur, wr, wc, fr, fq); S.done(cur); }
        if (!has_next) break;
#pragma unroll
        for (int a = 0; a < 2; ++a)
#pragma unroll
            for (int b = 0; b < 2; ++b)
#pragma unroll
                for (int m = 0; m < 4; ++m)
#pragma unroll
                    for (int n = 0; n < 2; ++n) acc[a][b][m][n] = (f32x4){0.f, 0.f, 0.f, 0.f};
        cur = nxt; cA = nA; cB = nB; ++ui;
        if constexpr (ALIGN_EPI) { if (wr == 1) PG8_BAR; }
    }
    PG8_WAIT_V(0);
    if constexpr (!ALIGN_EPI) { if (wr == 0) PG8_BAR; }
    PG8_BAR;
    if constexpr (Epi::AFTER_DRAIN) { E.fused(acc, cur, wr, wc, fr, fq, lds, wid, lane); S.done(cur); }
#undef PG8_SA
#undef PG8_SB
#undef PG8_STAGE
#undef PG8_LDA
#undef PG8_LDB
#undef PG8_MMA
#undef PG8_WAIT_V
#undef PG8_WAIT_L
#undef PG8_BAR
#undef PG8_SCHED
}
}

namespace mk {
using pg8::bf16_t; using pg8::bf16x8; using pg8::f32x4; using pg8::u32x4; using pg8::bf_lo; using pg8::bf_hi; using pg8::cvt_pk_bf16; using pg8::gelu_t;
#define LAS __attribute__((address_space(3)))
typedef unsigned u32x2 __attribute__((ext_vector_type(2)));
constexpr int M = 16384, D = 2048, SEQ = 8192, INW = 9216, DFF = 5632, NUP = 11264, MH = 8192;
constexpr int NWAVES = 8, NTHR = 512;
constexpr int LDS_BYTES = 143360;
constexpr float EPS = 1e-6f;
constexpr size_t O_WIN = 0, O_WA = O_WIN + (size_t)INW * D * 2, O_WSG = O_WA + (size_t)D * 1024 * 2, O_WSSM = O_WSG + (size_t)D * 512 * 2, O_WOUT = O_WSSM + (size_t)D * 512 * 2,
                 O_WUP = O_WOUT + (size_t)D * D * 2, O_WDN = O_WUP + (size_t)NUP * D * 2, O_WGLU = O_WDN + (size_t)D * DFF * 2, WLAYER = O_WGLU + (size_t)512 * 512 * 2;
constexpr size_t MiB = 1u << 20;
constexpr size_t WS_W = 0, WS_XB = 119 * MiB, WS_MRG = WS_XB + 64 * MiB, WS_PROJ = WS_MRG + 64 * MiB, WS_YCAT = WS_PROJ + 288 * MiB, WS_YS = WS_YCAT + 64 * MiB, WS_SST = WS_YS + 16 * MiB, WS_SS = WS_SST + 2 * MiB, WS_BAR = WS_SS + 512 * 1024, WS_COEF = WS_SS + 768 * 1024, WS_END = WS_SS + 1 * MiB;
static_assert(WLAYER <= 119 * MiB, "one layer of bf16 weights");
constexpr size_t WS_ACT = WS_PROJ, WS_RAW = WS_PROJ + 176 * MiB;
static_assert(WLAYER % 256 == 0 && (size_t)M * INW * 2 == 288 * MiB && (size_t)M * DFF * 2 == 176 * MiB && (size_t)256 * 4 * NUP * 4 <= 112 * MiB, "ws map");
constexpr int PPL = 10, NPH = PPL * 2;

struct Args { const float* in[30]; float* out; unsigned char* ws; int ph_lo, ph_hi; };
typedef __attribute__((address_space(4))) const Args CArgs;

__device__ __forceinline__ float wave_sum(float v) {
#pragma unroll
    for (int o = 1; o < 64; o <<= 1) v += __shfl_xor(v, o);
    return v;
}
__device__ __forceinline__ unsigned f2bf(float f) { unsigned u = __builtin_bit_cast(unsigned, f); return (u + 0x7fffu + ((u >> 16) & 1u)) >> 16; }
__device__ __forceinline__ unsigned pk2(float lo, float hi) { return f2bf(lo) | (f2bf(hi) << 16); }

__device__ __forceinline__ void titem_load(const float* W, int N, int item, int lane, float (&wv)[32]) {
    const int nblk = N / 32, kb = item / nblk, nb = item % nblk;
    const float* wp = W + (size_t)(64 * kb + (lane >> 5)) * N + 32 * nb + (lane & 31);
#pragma unroll
    for (int i = 0; i < 32; ++i) wv[i] = __builtin_nontemporal_load(wp + (size_t)(2 * i) * N);
}
__device__ __forceinline__ void titem_finish(const float (&wv)[32], int K, int N, bf16_t* WT, LAS float* scr, int item, int lane, bool upperm, const float* gain) {
    const int nblk = N / 32, kb = item / nblk, nb = item % nblk, k0 = 64 * kb, n0 = 32 * nb;
    int nd0 = n0; if (upperm) { const int hi = n0 >= 5632, nn = n0 - hi * 5632; nd0 = 256 * (nn >> 7) + 128 * hi + (nn & 127); }
#pragma unroll
    for (int i = 0; i < 32; ++i) scr[(2 * i + (lane >> 5)) * 33 + (lane & 31)] = wv[i];
    asm volatile("s_waitcnt lgkmcnt(0)" ::: "memory");
    const int c = lane & 7;
    f32x4 g0 = (f32x4){1.f, 1.f, 1.f, 1.f}, g1 = g0;
    if (gain) { g0 = *(const f32x4*)(gain + k0 + 8 * c); g1 = *(const f32x4*)(gain + k0 + 8 * c + 4); }
#pragma unroll
    for (int j = 0; j < 4; ++j) { const int n = (lane >> 3) + 8 * j; const LAS float* s = scr + (8 * c) * 33 + n;
        u32x4 o; o.x = cvt_pk_bf16(s[0 * 33] * g0[0], s[1 * 33] * g0[1]); o.y = cvt_pk_bf16(s[2 * 33] * g0[2], s[3 * 33] * g0[3]); o.z = cvt_pk_bf16(s[4 * 33] * g1[0], s[5 * 33] * g1[1]); o.w = cvt_pk_bf16(s[6 * 33] * g1[2], s[7 * 33] * g1[3]);
        *(u32x4*)(WT + (size_t)(nd0 + n) * K + k0 + 8 * c) = o; }
    asm volatile("s_waitcnt lgkmcnt(0)" ::: "memory");
}
__device__ __forceinline__ void convert_phase(CArgs* ap, int l, LAS unsigned char* lds, int gw, int NGW, int wave, int lane) {
    LAS float* scr = (LAS float*)(lds + wave * 8448);
    {
        unsigned char* wb = ap->ws + WS_W;
#pragma unroll 1
        for (int mi = 0; mi < 8; ++mi) {
            const float* W; int K, N; size_t off;
            switch (mi) {
                case 0: W = ap->in[2] + (size_t)l * D * INW; K = D; N = INW; off = O_WIN; break;
                case 1: W = ap->in[21] + (size_t)l * 1024 * D; K = 1024; N = D; off = O_WA; break;
                case 2: W = ap->in[22] + (size_t)l * 512 * D; K = 512; N = D; off = O_WSG; break;
                case 3: W = ap->in[23] + (size_t)l * 512 * D; K = 512; N = D; off = O_WSSM; break;
                case 4: W = ap->in[24] + (size_t)l * D * D; K = D; N = D; off = O_WOUT; break;
                case 5: W = ap->in[26] + (size_t)l * D * NUP; K = D; N = NUP; off = O_WUP; break;
                case 6: W = ap->in[29] + (size_t)l * DFF * D; K = DFF; N = D; off = O_WDN; break;
                default: W = ap->in[19] + (size_t)l * 512 * 512; K = 512; N = 512; off = O_WGLU; break;
            }
            const int nitems = (K / 64) * (N / 32);
            const float* gain = mi == 0 ? ap->in[1] + l * D : (mi == 5 ? ap->in[25] + l * D : nullptr);
            float wc[32], wn[32];
            int it = gw;
            if (it < nitems) titem_load(W, N, it, lane, wc);
            while (it < nitems) {
                const int nx = it + NGW;
                if (nx < nitems) titem_load(W, N, nx, lane, wn);
                titem_finish(wc, K, N, (bf16_t*)(wb + off), scr, it, lane, mi == 5, gain);
#pragma unroll
                for (int i = 0; i < 32; ++i) wc[i] = wn[i];
                it = nx;
            }
        }
    }
}

__device__ __forceinline__ void xb_phase(const float* x, bf16_t* XB, float* SS, int gw, int NGW, int lane) {
    for (int m = 2 * gw; m < M; m += 2 * NGW) {
        const f32x4* xr0 = (const f32x4*)(x + (size_t)m * D) + lane; const f32x4* xr1 = xr0 + D / 4;
        f32x4 v0[8], v1[8]; float s0 = 0.f, s1 = 0.f;
#pragma unroll
        for (int j = 0; j < 8; ++j) { v0[j] = __builtin_nontemporal_load(xr0 + 64 * j); v1[j] = __builtin_nontemporal_load(xr1 + 64 * j); }
#pragma unroll
        for (int j = 0; j < 8; ++j) { s0 += (v0[j][0] * v0[j][0] + v0[j][1] * v0[j][1]) + (v0[j][2] * v0[j][2] + v0[j][3] * v0[j][3]); s1 += (v1[j][0] * v1[j][0] + v1[j][1] * v1[j][1]) + (v1[j][2] * v1[j][2] + v1[j][3] * v1[j][3]); }
        s0 = wave_sum(s0); s1 = wave_sum(s1);
        if (lane == 0) { SS[m] = s0; SS[m + 1] = s1; }
        u32x2* o0 = (u32x2*)(XB + (size_t)m * D) + lane; u32x2* o1 = o0 + D / 4;
#pragma unroll
        for (int j = 0; j < 8; ++j) { u32x2 w; w.x = cvt_pk_bf16(v0[j][0], v0[j][1]); w.y = cvt_pk_bf16(v0[j][2], v0[j][3]); o0[64 * j] = w; w.x = cvt_pk_bf16(v1[j][0], v1[j][1]); w.y = cvt_pk_bf16(v1[j][2], v1[j][3]); o1[64 * j] = w; }
    }
}

__device__ __forceinline__ bf16x8 as_bf8(u32x4 w) { return __builtin_bit_cast(bf16x8, w); }

__device__ __forceinline__ void attn_unit(LAS unsigned char* lds, const bf16_t* PROJ, bf16_t* YCAT, const float* qg, const float* kg, const float* sinks, int unit, int tid, int wave, int lane) {
    const int kvh = unit & 1, blk = (unit >> 1) & 63, b = unit >> 7;
    const int t0 = b * SEQ + blk * 128;
    LAS bf16_t* Ks = (LAS bf16_t*)lds; LAS bf16_t* Vt = (LAS bf16_t*)(lds + 69632);
    {
        const int c16 = tid & 15;
        const f32x4 g0 = *(const f32x4*)(kg + 8 * c16), g1 = *(const f32x4*)(kg + 8 * c16 + 4);
#pragma unroll 2
        for (int pass = 0; pass < 8; ++pass) {
            const int kidx = (tid >> 4) + 32 * pass;
            u32x4 w = {0u, 0u, 0u, 0u};
            if (!(blk == 0 && pass < 4)) w = *(const u32x4*)(PROJ + (size_t)(t0 - 128 + kidx) * INW + 1024 + kvh * 128 + 8 * c16);
            f32x4 v0, v1; pg8::unpack8(w, v0, v1);
            float ss = (v0[0] * v0[0] + v0[1] * v0[1]) + (v0[2] * v0[2] + v0[3] * v0[3]) + (v1[0] * v1[0] + v1[1] * v1[1]) + (v1[2] * v1[2] + v1[3] * v1[3]);
            ss += __shfl_xor(ss, 1); ss += __shfl_xor(ss, 2); ss += __shfl_xor(ss, 4); ss += __shfl_xor(ss, 8);
            const float rs = rsqrtf(ss * (1.f / 128.f) + EPS);
            *(LAS u32x4*)(Ks + kidx * 136 + 8 * c16) = pg8::pack8(v0 * rs * g0, v1 * rs * g1);
        }
    }
    {
#pragma unroll 1
        for (int rg = 0; rg < 4; ++rg) {
            const int kidx = 64 * rg + lane, kk = kidx & 31, pos = (kidx & ~31) + 8 * ((kk >> 2) & 3) + 4 * (kk >> 4) + (kk & 3);
#pragma unroll
            for (int cc = 0; cc < 2; ++cc) {
                const int c16 = 2 * wave + cc;
                u32x4 w = {0u, 0u, 0u, 0u};
                if (!(blk == 0 && rg < 2)) w = *(const u32x4*)(PROJ + (size_t)(t0 - 128 + kidx) * INW + 1280 + kvh * 128 + 8 * c16);
                LAS bf16_t* d = Vt + (8 * c16) * 264 + pos;
                d[0 * 264] = (bf16_t)(w.x & 0xffffu); d[1 * 264] = (bf16_t)(w.x >> 16); d[2 * 264] = (bf16_t)(w.y & 0xffffu); d[3 * 264] = (bf16_t)(w.y >> 16);
                d[4 * 264] = (bf16_t)(w.z & 0xffffu); d[5 * 264] = (bf16_t)(w.z >> 16); d[6 * 264] = (bf16_t)(w.w & 0xffffu); d[7 * 264] = (bf16_t)(w.w >> 16);
            }
        }
    }
    __syncthreads();
    const int fr = lane & 15, fq = lane >> 4, qrow = 16 * wave + fr;
#pragma unroll 1
    for (int hq = 4 * kvh; hq < 4 * kvh + 4; ++hq) {
    bf16x8 qf[4];
    {
        const bf16_t* qp = PROJ + (size_t)(t0 + qrow) * INW + hq * 128 + 8 * fq;
        u32x4 w[4]; float ss = 0.f;
#pragma unroll
        for (int ks = 0; ks < 4; ++ks) { w[ks] = *(const u32x4*)(qp + 32 * ks); f32x4 v0, v1; pg8::unpack8(w[ks], v0, v1);
            ss += (v0[0] * v0[0] + v0[1] * v0[1]) + (v0[2] * v0[2] + v0[3] * v0[3]) + (v1[0] * v1[0] + v1[1] * v1[1]) + (v1[2] * v1[2] + v1[3] * v1[3]); }
        ss += __shfl_xor(ss, 16); ss += __shfl_xor(ss, 32);
        const float rs = rsqrtf(ss * (1.f / 128.f) + EPS) * 0.08838834764831845f;
#pragma unroll
        for (int ks = 0; ks < 4; ++ks) { f32x4 v0, v1; pg8::unpack8(w[ks], v0, v1);
            const f32x4 g0 = *(const f32x4*)(qg + 32 * ks + 8 * fq), g1 = *(const f32x4*)(qg + 32 * ks + 8 * fq + 4);
            qf[ks] = as_bf8(pg8::pack8(v0 * rs * g0, v1 * rs * g1)); }
    }
    const int wp = wave & ~1;
    f32x4 s[10];
#pragma unroll
    for (int rel = 0; rel < 10; ++rel) {
        s[rel] = (f32x4){0.f, 0.f, 0.f, 0.f};
#pragma unroll
        for (int ks = 0; ks < 4; ++ks) {
            const bf16x8 kf = *(const LAS bf16x8*)(Ks + (16 * (wp + rel) + fr) * 136 + 32 * ks + 8 * fq);
            s[rel] = __builtin_amdgcn_mfma_f32_16x16x32_bf16(kf, qf[ks], s[rel], 0, 0, 0);
        }
    }
    const float slope = exp2f(-(float)(hq + 1)), sink = sinks[hq];
    const int qidx = 128 + qrow;
    float mx = -INFINITY;
#pragma unroll
    for (int rel = 0; rel < 10; ++rel)
#pragma unroll
        for (int i = 0; i < 4; ++i) {
            const int kidx = 16 * (wp + rel) + 4 * fq + i, dist = qidx - kidx;
            const bool valid = (dist >= 0) && (dist < 128) && (blk > 0 || kidx >= 128);
            const float val = valid ? s[rel][i] - slope * (float)dist : -INFINITY;
            s[rel][i] = val; mx = fmaxf(mx, val);
        }
    mx = fmaxf(mx, __shfl_xor(mx, 16)); mx = fmaxf(mx, __shfl_xor(mx, 32));
    const float mm = fmaxf(mx, sink);
    float ls = 0.f;
#pragma unroll
    for (int rel = 0; rel < 10; ++rel)
#pragma unroll
        for (int i = 0; i < 4; ++i) { const float p = __expf(s[rel][i] - mm); s[rel][i] = p; ls += p; }
    ls += __shfl_xor(ls, 16); ls += __shfl_xor(ls, 32);
    const float inv = 1.f / (ls + __expf(sink - mm));
    bf16x8 pf[5];
#pragma unroll
    for (int g = 0; g < 5; ++g) pf[g] = as_bf8(pg8::pack8(s[2 * g], s[2 * g + 1]));
    bf16_t* op = YCAT + (size_t)(t0 + qrow) * D + hq * 128 + 4 * fq;
#pragma unroll
    for (int db = 0; db < 8; ++db) {
        f32x4 o = (f32x4){0.f, 0.f, 0.f, 0.f};
#pragma unroll
        for (int g = 0; g < 5; ++g) {
            const bf16x8 vf = *(const LAS bf16x8*)(Vt + (16 * db + fr) * 264 + 32 * ((wp >> 1) + g) + 8 * fq);
            o = __builtin_amdgcn_mfma_f32_16x16x32_bf16(vf, pf[g], o, 0, 0, 0);
        }
        u32x2 w; w.x = cvt_pk_bf16(o[0] * inv, o[1] * inv); w.y = cvt_pk_bf16(o[2] * inv, o[3] * inv);
        *(u32x2*)(op + 16 * db) = w;
    }
    }
    __syncthreads();
}

__device__ __forceinline__ void sg_unit(LAS unsigned char* lds, const bf16_t* PROJ, bf16_t* YCAT, const float* lng, const float* lnb, const float* sgw, const float* sgb, int unit, int tid, int wave, int lane) {
    const int g = unit & 3, ch = (unit >> 2) & 63, b = unit >> 8;
    const int t0 = b * SEQ + ch * 128;
    LAS bf16_t* Zt = (LAS bf16_t*)lds; LAS float* st = (LAS float*)(lds + 34816);
    const bf16_t* zv = PROJ + (size_t)t0 * INW + 2048 + g * 128;
    {
        const int c16 = tid & 15;
#pragma unroll
        for (int pass = 0; pass < 4; ++pass) {
            const int r = (tid >> 4) + 32 * pass;
            f32x4 v0, v1; pg8::unpack8(*(const u32x4*)(zv + (size_t)r * INW + 8 * c16), v0, v1);
            float sm = (v0[0] + v0[1]) + (v0[2] + v0[3]) + (v1[0] + v1[1]) + (v1[2] + v1[3]);
            sm += __shfl_xor(sm, 1); sm += __shfl_xor(sm, 2); sm += __shfl_xor(sm, 4); sm += __shfl_xor(sm, 8);
            const float mean = sm * (1.f / 128.f);
            v0 = v0 - mean; v1 = v1 - mean;
            float q = (v0[0] * v0[0] + v0[1] * v0[1]) + (v0[2] * v0[2] + v0[3] * v0[3]) + (v1[0] * v1[0] + v1[1] * v1[1]) + (v1[2] * v1[2] + v1[3] * v1[3]);
            q += __shfl_xor(q, 1); q += __shfl_xor(q, 2); q += __shfl_xor(q, 4); q += __shfl_xor(q, 8);
            if (c16 == 0) { st[2 * r] = mean; st[2 * r + 1] = rsqrtf(q * (1.f / 128.f) + EPS); }
        }
    }
    __syncthreads();
#pragma unroll 1
    for (int rg = 0; rg < 2; ++rg) {
        const int r = 64 * rg + lane; const float mean = st[2 * r], rstd = st[2 * r + 1];
#pragma unroll
        for (int cc = 0; cc < 2; ++cc) {
            const int c16 = 2 * wave + cc;
            f32x4 v0, v1; pg8::unpack8(*(const u32x4*)(zv + (size_t)r * INW + 8 * c16), v0, v1);
            const f32x4 a0 = *(const f32x4*)(lng + g * 128 + 8 * c16), a1 = *(const f32x4*)(lng + g * 128 + 8 * c16 + 4);
            const f32x4 b0 = *(const f32x4*)(lnb + g * 128 + 8 * c16), b1 = *(const f32x4*)(lnb + g * 128 + 8 * c16 + 4);
            v0 = (v0 - mean) * rstd * a0 + b0; v1 = (v1 - mean) * rstd * a1 + b1;
            LAS bf16_t* d = Zt + (8 * c16) * 136 + r;
            d[0 * 136] = (bf16_t)f2bf(v0[0]); d[1 * 136] = (bf16_t)f2bf(v0[1]); d[2 * 136] = (bf16_t)f2bf(v0[2]); d[3 * 136] = (bf16_t)f2bf(v0[3]);
            d[4 * 136] = (bf16_t)f2bf(v1[0]); d[5 * 136] = (bf16_t)f2bf(v1[1]); d[6 * 136] = (bf16_t)f2bf(v1[2]); d[7 * 136] = (bf16_t)f2bf(v1[3]);
        }
    }
    __syncthreads();
    const int fr = lane & 15, fq = lane >> 4, t = 16 * wave + fr, nks = (wave >> 1) + 1;
    bf16x8 wf[4];
#pragma unroll
    for (int ks = 0; ks < 4; ++ks) {
        u32x4 w = {0u, 0u, 0u, 0u};
        if (ks < nks) {
            const float* wp = sgw + ((size_t)(g * 128 + t)) * 128 + 32 * ks + 8 * fq;
            f32x4 a0 = *(const f32x4*)wp, a1 = *(const f32x4*)(wp + 4);
            const int s0 = 32 * ks + 8 * fq;
#pragma unroll
            for (int i = 0; i < 4; ++i) { if (s0 + i > t) a0[i] = 0.f; if (s0 + 4 + i > t) a1[i] = 0.f; }
            w = pg8::pack8(a0, a1);
        }
        wf[ks] = as_bf8(w);
    }
    const float bs = sgb[g * 128 + t];
    const bf16_t* zu = PROJ + (size_t)(t0 + t) * INW + 1536 + g * 128 + 4 * fq;
    bf16_t* op = YCAT + (size_t)(t0 + t) * D + 1024 + g * 128 + 4 * fq;
#pragma unroll
    for (int cb = 0; cb < 8; ++cb) {
        f32x4 acc = (f32x4){0.f, 0.f, 0.f, 0.f};
#pragma unroll
        for (int ks = 0; ks < 4; ++ks) if (ks < nks) {
            const bf16x8 zf = *(const LAS bf16x8*)(Zt + (16 * cb + fr) * 136 + 32 * ks + 8 * fq);
            acc = __builtin_amdgcn_mfma_f32_16x16x32_bf16(zf, wf[ks], acc, 0, 0, 0);
        }
        const u32x2 zw = *(const u32x2*)(zu + 16 * cb);
        u32x2 w; w.x = cvt_pk_bf16(bf_lo(zw.x) * (acc[0] + bs), bf_hi(zw.x) * (acc[1] + bs)); w.y = cvt_pk_bf16(bf_lo(zw.y) * (acc[2] + bs), bf_hi(zw.y) * (acc[3] + bs));
        *(u32x2*)(op + 16 * cb) = w;
    }
    __syncthreads();
}

template <bool P3> __device__ __forceinline__ void ssm_unit(CArgs* ap, const float* COEF, int l, const bf16_t* PROJ, float* SST, bf16_t* YS, LAS unsigned char* wlds, int unit, int lane) {
    const int c = unit & 63, g = (unit >> 6) & 31, b = unit >> 11;
    const int fr = lane & 15, fq = lane >> 4;
    float pr[4][4], pi[4][4]; bf16x8 bfr[8];
#pragma unroll
    for (int cb = 0; cb < 4; ++cb) {
        const int gp = (l * 32 + g) * 64 + 16 * cb + fr;
        const f32x4 cf = *(const f32x4*)(COEF + (size_t)(g * 64 + 16 * cb + fr) * 4);
        const float abr = cf[0], abi = cf[1];
        pr[cb][0] = abr; pi[cb][0] = abi;
#pragma unroll
        for (int i = 1; i < 4; ++i) { pr[cb][i] = pr[cb][i - 1] * abr - pi[cb][i - 1] * abi; pi[cb][i] = pr[cb][i - 1] * abi + pi[cb][i - 1] * abr; }
        const float cr = cf[2], ci = cf[3];
        u32x4 wre = {0u, 0u, 0u, 0u}, wim = {0u, 0u, 0u, 0u};
        if (fq < 2) {
            const float* br = ap->in[14] + (size_t)gp * 16 + 8 * fq; const float* bi = ap->in[15] + (size_t)gp * 16 + 8 * fq;
            const f32x4 r0 = *(const f32x4*)br, r1 = *(const f32x4*)(br + 4), i0 = *(const f32x4*)bi, i1 = *(const f32x4*)(bi + 4);
            wre = pg8::pack8(cr * r0 - ci * i0, cr * r1 - ci * i1); wim = pg8::pack8(cr * i0 + ci * r0, cr * i1 + ci * r1);
        }
        bfr[cb] = as_bf8(wre); bfr[cb + 4] = as_bf8(wim);
    }
    bf16x8 cmf[4]; float dsk = 0.f;
    if (P3) {
#pragma unroll
        for (int ks = 0; ks < 4; ++ks) {
            const int k0 = 32 * ks + 8 * fq;
            const float* src = (ks < 2 ? ap->in[16] : ap->in[17]) + ((size_t)(l * 32 + g) * 16 + fr) * 64 + (ks < 2 ? k0 : k0 - 64);
            f32x4 c0 = *(const f32x4*)src, c1 = *(const f32x4*)(src + 4);
            if (ks >= 2) { c0 = -c0; c1 = -c1; }
            cmf[ks] = as_bf8(pg8::pack8(c0, c1));
        }
        dsk = ap->in[18][l * 512 + g * 16 + fr];
    }
    float hr[4], hi[4];
#pragma unroll
    for (int cb = 0; cb < 4; ++cb) { hr[cb] = 0.f; hi[cb] = 0.f; }
    if (P3) {
        float tr[4], ti[4];
#pragma unroll
        for (int cb = 0; cb < 4; ++cb) { tr[cb] = pr[cb][3]; ti[cb] = pi[cb][3];
#pragma unroll
            for (int k = 0; k < 5; ++k) { const float nr = tr[cb] * tr[cb] - ti[cb] * ti[cb], ni = 2.f * tr[cb] * ti[cb]; tr[cb] = nr; ti[cb] = ni; } }
        const float* sp = SST + ((size_t)(unit - c) * 64 + fr) * 2;
        for (int cc = 0; cc < c; ++cc) {
#pragma unroll
            for (int cb = 0; cb < 4; ++cb) { const float2 s = *(const float2*)(sp + (size_t)cc * 128 + 32 * cb);
                const float nr = tr[cb] * hr[cb] - ti[cb] * hi[cb] + s.x, ni = tr[cb] * hi[cb] + ti[cb] * hr[cb] + s.y; hr[cb] = nr; hi[cb] = ni; }
        }
    }
    const size_t row0 = (size_t)(b * SEQ + c * 128);
    LAS bf16_t* Hs = (LAS bf16_t*)wlds;
    u32x4 uwn = {0u, 0u, 0u, 0u};
    if (fq < 2) uwn = *(const u32x4*)(PROJ + (row0 + fr) * INW + 2560 + g * 16 + 8 * fq);
#pragma unroll 1
    for (int blk = 0; blk < 8; ++blk) {
        const u32x4 uw = uwn;
        if (fq < 2) uwn = *(const u32x4*)(PROJ + (row0 + 16 * (blk < 7 ? blk + 1 : blk) + fr) * INW + 2560 + g * 16 + 8 * fq);
        const bf16x8 uf = as_bf8(uw);
        f32x4 bu[8];
#pragma unroll
        for (int k = 0; k < 8; ++k) bu[k] = __builtin_amdgcn_mfma_f32_16x16x32_bf16(uf, bfr[k], (f32x4){0.f, 0.f, 0.f, 0.f}, 0, 0, 0);
#pragma unroll
        for (int cb = 0; cb < 4; ++cb) {
            const float ar = pr[cb][0], ai = pi[cb][0], a4r = pr[cb][3], a4i = pi[cb][3];
            float lr_[4], li_[4];
            lr_[0] = bu[cb][0]; li_[0] = bu[cb + 4][0];
#pragma unroll
            for (int i = 1; i < 4; ++i) { lr_[i] = ar * lr_[i - 1] - ai * li_[i - 1] + bu[cb][i]; li_[i] = ar * li_[i - 1] + ai * lr_[i - 1] + bu[cb + 4][i]; }
            float cr = hr[cb], ci = hi[cb];
#pragma unroll
            for (int j = 0; j < 3; ++j) {
                const float er = __shfl(lr_[3], fr + 16 * j), ei = __shfl(li_[3], fr + 16 * j);
                const float nr = a4r * cr - a4i * ci + er, ni = a4r * ci + a4i * cr + ei;
                if (j < fq) { cr = nr; ci = ni; }
            }
            float h_r[4], h_i[4];
#pragma unroll
            for (int i = 0; i < 4; ++i) { h_r[i] = lr_[i] + pr[cb][i] * cr - pi[cb][i] * ci; h_i[i] = li_[i] + pr[cb][i] * ci + pi[cb][i] * cr; }
            hr[cb] = __shfl(h_r[3], fr + 48); hi[cb] = __shfl(h_i[3], fr + 48);
            if (P3) {
#pragma unroll
                for (int i = 0; i < 4; ++i) { Hs[(4 * fq + i) * 136 + 16 * cb + fr] = (bf16_t)f2bf(h_r[i]); Hs[(4 * fq + i) * 136 + 64 + 16 * cb + fr] = (bf16_t)f2bf(h_i[i]); }
            }
        }
        if (P3) {
            f32x4 y = (f32x4){0.f, 0.f, 0.f, 0.f};
            asm volatile("s_waitcnt lgkmcnt(0)" ::: "memory");
            bf16x8 hf[4];
#pragma unroll
            for (int ks = 0; ks < 4; ++ks) hf[ks] = *(const LAS bf16x8*)(Hs + fr * 136 + 32 * ks + 8 * fq);
            asm volatile("s_waitcnt lgkmcnt(0)" ::: "memory");
#pragma unroll
            for (int ks = 0; ks < 4; ++ks) y = __builtin_amdgcn_mfma_f32_16x16x32_bf16(hf[ks], cmf[ks], y, 0, 0, 0);
#pragma unroll
            for (int i = 0; i < 4; ++i) {
                const size_t row = row0 + 16 * blk + 4 * fq + i;
                const float uu = __uint_as_float(((unsigned)PROJ[row * INW + 2560 + g * 16 + fr]) << 16);
                YS[row * 512 + g * 16 + fr] = (bf16_t)f2bf(gelu_t(y[i] + dsk * uu));
            }
        }
    }
    if (!P3) { if (fq == 0) {
#pragma unroll
        for (int cb = 0; cb < 4; ++cb) *(float2*)(SST + ((size_t)unit * 64 + 16 * cb + fr) * 2) = make_float2(hr[cb], hi[cb]); } }
}

__device__ __forceinline__ void ssm_coef_phase(CArgs* ap, int l, float* COEF, int gw, int lane) {
    if (gw < 32) {
        const int g = gw, p = lane;
        const float dt = expf(ap->in[13][l * 32 + g]);
        const float lr = ap->in[11][(l * 32 + g) * 64 + p], li = ap->in[12][(l * 32 + g) * 64 + p];
        const float x = lr * dt, y = li * dt;
        const float ex = expf(x), cs = cosf(y), sn = sinf(y), sh = sinf(0.5f * y);
        const float abr = ex * cs, abi = ex * sn;
        const float nr = expm1f(x) * cs - 2.f * sh * sh, ni = abi;
        const float den = 1.f / (lr * lr + li * li);
        *(f32x4*)(COEF + (size_t)(g * 64 + p) * 4) = (f32x4){abr, abi, (nr * lr + ni * li) * den, (ni * lr - nr * li) * den};
    }
}
__device__ __forceinline__ void ssm_setup(CArgs* ap, const float* COEF, int l, int g, int p, float& abr, float& abi, float (&bbr)[16], float (&bbi)[16]) {
    const f32x4 cf = *(const f32x4*)(COEF + (size_t)(g * 64 + p) * 4);
    abr = cf[0]; abi = cf[1];
    const float cr = cf[2], ci = cf[3];
    const float* br = ap->in[14] + ((size_t)(l * 32 + g) * 64 + p) * 16; const float* bi = ap->in[15] + ((size_t)(l * 32 + g) * 64 + p) * 16;
#pragma unroll
    for (int q = 0; q < 4; ++q) { const f32x4 r4 = *(const f32x4*)(br + 4 * q), i4 = *(const f32x4*)(bi + 4 * q);
#pragma unroll
        for (int i = 0; i < 4; ++i) { bbr[4 * q + i] = cr * r4[i] - ci * i4[i]; bbi[4 * q + i] = cr * i4[i] + ci * r4[i]; } }
}
__device__ __forceinline__ void load_u16(const bf16_t* p, float (&u)[16]) {
    const u32x4 w0 = ((const u32x4*)p)[0], w1 = ((const u32x4*)p)[1];
    u[0] = bf_lo(w0.x); u[1] = bf_hi(w0.x); u[2] = bf_lo(w0.y); u[3] = bf_hi(w0.y); u[4] = bf_lo(w0.z); u[5] = bf_hi(w0.z); u[6] = bf_lo(w0.w); u[7] = bf_hi(w0.w);
    u[8] = bf_lo(w1.x); u[9] = bf_hi(w1.x); u[10] = bf_lo(w1.y); u[11] = bf_hi(w1.y); u[12] = bf_lo(w1.z); u[13] = bf_hi(w1.z); u[14] = bf_lo(w1.w); u[15] = bf_hi(w1.w);
}
__device__ __forceinline__ void ssm_pass1(CArgs* ap, const float* COEF, int l, const bf16_t* PROJ, float* SST, int unit, int lane) {
    const int c = unit & 63, g = (unit >> 6) & 31, b = unit >> 11;
    float abr, abi, bbr[16], bbi[16];
    ssm_setup(ap, COEF, l, g, lane, abr, abi, bbr, bbi);
    const bf16_t* up = PROJ + (size_t)(b * SEQ + c * 128) * INW + 2560 + g * 16;
    float hr = 0.f, hi = 0.f;
#pragma unroll 4
    for (int t = 0; t < 128; ++t) {
        float u[16]; load_u16(up + (size_t)t * INW, u);
        float br = 0.f, bi = 0.f;
#pragma unroll
        for (int k = 0; k < 16; ++k) { br += bbr[k] * u[k]; bi += bbi[k] * u[k]; }
        const float nr = abr * hr - abi * hi + br, ni = abr * hi + abi * hr + bi; hr = nr; hi = ni;
    }
    *(float2*)(SST + ((size_t)unit * 64 + lane) * 2) = make_float2(hr, hi);
}
template <int HALFN> __device__ __forceinline__ void rs_stage(float (&v)[64], int lane) {
    if constexpr (HALFN == 32 || HALFN == 16) {
#pragma unroll
        for (int i = 0; i < HALFN; ++i) {
            float a = v[i], b = v[i + HALFN];
            if constexpr (HALFN == 32) asm volatile("s_nop 1\n\tv_permlane32_swap_b32 %0, %1" : "+v"(a), "+v"(b));
            else asm volatile("s_nop 1\n\tv_permlane16_swap_b32 %0, %1" : "+v"(a), "+v"(b));
            v[i] = a + b;
        }
    } else {
        const bool bit = (lane & HALFN) != 0;
#pragma unroll
        for (int i = 0; i < HALFN; ++i) { const float keep = bit ? v[i + HALFN] : v[i], send = bit ? v[i] : v[i + HALFN]; v[i] = keep + __shfl_xor(send, HALFN); }
    }
}
__device__ __forceinline__ void ssm_pass3(CArgs* ap, const float* COEF, int l, const bf16_t* PROJ, const float* SST, bf16_t* YS, int unit, int lane) {
    const int c = unit & 63, g = (unit >> 6) & 31, b = unit >> 11;
    float abr, abi, bbr[16], bbi[16];
    ssm_setup(ap, COEF, l, g, lane, abr, abi, bbr, bbi);
    typedef float f32x2v __attribute__((ext_vector_type(2)));
    f32x2v cre2[8], cim2[8], bb2[16];
#pragma unroll
    for (int k = 0; k < 8; ++k) { cre2[k] = (f32x2v){ap->in[16][((size_t)(l * 32 + g) * 16 + 2 * k) * 64 + lane], ap->in[16][((size_t)(l * 32 + g) * 16 + 2 * k + 1) * 64 + lane]};
        cim2[k] = (f32x2v){ap->in[17][((size_t)(l * 32 + g) * 16 + 2 * k) * 64 + lane], ap->in[17][((size_t)(l * 32 + g) * 16 + 2 * k + 1) * 64 + lane]}; }
#pragma unroll
    for (int k = 0; k < 16; ++k) bb2[k] = (f32x2v){bbr[k], bbi[k]};
    const float dsk = ap->in[18][l * 512 + g * 16 + (lane & 15)];
    float tr = abr, ti = abi;
#pragma unroll
    for (int k = 0; k < 7; ++k) { const float nr = tr * tr - ti * ti, ni = 2.f * tr * ti; tr = nr; ti = ni; }
    float hr = 0.f, hi = 0.f;
    const float* sp = SST + ((size_t)(unit - c) * 64 + lane) * 2;
    int cc = 0;
    for (; cc + 8 <= c; cc += 8) {
        float2 s8[8];
#pragma unroll
        for (int j = 0; j < 8; ++j) s8[j] = *(const float2*)(sp + (size_t)(cc + j) * 128);
#pragma unroll
        for (int j = 0; j < 8; ++j) { const float nr = tr * hr - ti * hi + s8[j].x, ni = tr * hi + ti * hr + s8[j].y; hr = nr; hi = ni; }
    }
    for (; cc < c; ++cc) { const float2 s = *(const float2*)(sp + (size_t)cc * 128); const float nr = tr * hr - ti * hi + s.x, ni = tr * hi + ti * hr + s.y; hr = nr; hi = ni; }
    const size_t row0 = (size_t)(b * SEQ + c * 128);
    const bf16_t* up = PROJ + row0 * INW + 2560 + g * 16;
    u32x4 wn[8];
#pragma unroll
    for (int tt = 0; tt < 4; ++tt) { wn[2 * tt] = ((const u32x4*)(up + (size_t)tt * INW))[0]; wn[2 * tt + 1] = ((const u32x4*)(up + (size_t)tt * INW))[1]; }
    const int ott = lane >> 4, ok = lane & 15;
    unsigned short uun = up[(size_t)ott * INW + ok];
#pragma unroll 1
    for (int t = 0; t < 128; t += 4) {
        float v[64];
        u32x4 wc[8];
#pragma unroll
        for (int j = 0; j < 8; ++j) wc[j] = wn[j];
        const unsigned short uuc = uun;
        const int tn = (t + 4 < 128) ? t + 4 : t;
#pragma unroll
        for (int tt = 0; tt < 4; ++tt) { wn[2 * tt] = ((const u32x4*)(up + (size_t)(tn + tt) * INW))[0]; wn[2 * tt + 1] = ((const u32x4*)(up + (size_t)(tn + tt) * INW))[1]; }
        uun = up[(size_t)(tn + ott) * INW + ok];
#pragma unroll
        for (int tt = 0; tt < 4; ++tt) {
            const u32x4 w0 = wc[2 * tt], w1 = wc[2 * tt + 1];
            float u[16];
            u[0] = bf_lo(w0.x); u[1] = bf_hi(w0.x); u[2] = bf_lo(w0.y); u[3] = bf_hi(w0.y); u[4] = bf_lo(w0.z); u[5] = bf_hi(w0.z); u[6] = bf_lo(w0.w); u[7] = bf_hi(w0.w);
            u[8] = bf_lo(w1.x); u[9] = bf_hi(w1.x); u[10] = bf_lo(w1.y); u[11] = bf_hi(w1.y); u[12] = bf_lo(w1.z); u[13] = bf_hi(w1.z); u[14] = bf_lo(w1.w); u[15] = bf_hi(w1.w);
            f32x2v b2 = (f32x2v){0.f, 0.f};
#pragma unroll
            for (int k = 0; k < 16; ++k) b2 += bb2[k] * u[k];
            const float nr = abr * hr - abi * hi + b2.x, ni = abr * hi + abi * hr + b2.y; hr = nr; hi = ni;
#pragma unroll
            for (int k = 0; k < 8; ++k) { const f32x2v p = cre2[k] * hr - cim2[k] * hi; v[tt * 16 + 2 * k] = p.x; v[tt * 16 + 2 * k + 1] = p.y; }
        }
        rs_stage<32>(v, lane); rs_stage<16>(v, lane); rs_stage<8>(v, lane); rs_stage<4>(v, lane); rs_stage<2>(v, lane); rs_stage<1>(v, lane);
        const float uu = __uint_as_float(((unsigned)uuc) << 16);
        const float y = gelu_t(v[0] + dsk * uu);
        YS[(row0 + t + ott) * 512 + g * 16 + ok] = (bf16_t)f2bf(y);
    }
}

__device__ __forceinline__ void ssm_pass3h(CArgs* ap, const float* COEF, int l, const bf16_t* PROJ, const float* SST, bf16_t* YS, LAS unsigned char* wlds, int unit, int lane) {
    const int c = unit & 63, g = (unit >> 6) & 31, b = unit >> 11;
    const int fr = lane & 15, fq = lane >> 4;
    float abr, abi, bbr[16], bbi[16];
    ssm_setup(ap, COEF, l, g, lane, abr, abi, bbr, bbi);
    typedef float f32x2v __attribute__((ext_vector_type(2)));
    f32x2v bb2[16];
#pragma unroll
    for (int k = 0; k < 16; ++k) bb2[k] = (f32x2v){bbr[k], bbi[k]};
    float cmB[32];
#pragma unroll
    for (int j = 0; j < 8; ++j) {
        const int k0 = 16 * j + 4 * fq;
        const float* src = (j < 4 ? ap->in[16] : ap->in[17]) + ((size_t)(l * 32 + g) * 16 + fr) * 64 + (j < 4 ? k0 : k0 - 64);
        const f32x4 c4 = *(const f32x4*)src;
#pragma unroll
        for (int r = 0; r < 4; ++r) cmB[4 * j + r] = (j < 4) ? c4[r] : -c4[r];
    }
    const float dsk = ap->in[18][l * 512 + g * 16 + fr];
    float tr = abr, ti = abi;
#pragma unroll
    for (int k = 0; k < 7; ++k) { const float nr = tr * tr - ti * ti, ni = 2.f * tr * ti; tr = nr; ti = ni; }
    float hr = 0.f, hi = 0.f;
    const float* sp = SST + ((size_t)(unit - c) * 64 + lane) * 2;
    int cc = 0;
    for (; cc + 8 <= c; cc += 8) {
        float2 s8[8];
#pragma unroll
        for (int j = 0; j < 8; ++j) s8[j] = *(const float2*)(sp + (size_t)(cc + j) * 128);
#pragma unroll
        for (int j = 0; j < 8; ++j) { const float nr = tr * hr - ti * hi + s8[j].x, ni = tr * hi + ti * hr + s8[j].y; hr = nr; hi = ni; }
    }
    for (; cc < c; ++cc) { const float2 s = *(const float2*)(sp + (size_t)cc * 128); const float nr = tr * hr - ti * hi + s.x, ni = tr * hi + ti * hr + s.y; hr = nr; hi = ni; }
    const size_t row0 = (size_t)(b * SEQ + c * 128);
    const bf16_t* up = PROJ + row0 * INW + 2560 + g * 16;
    LAS float* Hf = (LAS float*)wlds;
    u32x4 wn[8];
#pragma unroll
    for (int tt = 0; tt < 4; ++tt) { wn[2 * tt] = ((const u32x4*)(up + (size_t)tt * INW))[0]; wn[2 * tt + 1] = ((const u32x4*)(up + (size_t)tt * INW))[1]; }
#pragma unroll 1
    for (int blk = 0; blk < 8; ++blk) {
        unsigned short uq[4];
#pragma unroll
        for (int i = 0; i < 4; ++i) uq[i] = up[(size_t)(16 * blk + 4 * fq + i) * INW + fr];
#pragma unroll 1
        for (int q = 0; q < 4; ++q) {
            const int t = 16 * blk + 4 * q;
            u32x4 wc[8];
#pragma unroll
            for (int j = 0; j < 8; ++j) wc[j] = wn[j];
            const int tn = (t + 4 < 128) ? t + 4 : t;
#pragma unroll
            for (int tt = 0; tt < 4; ++tt) { wn[2 * tt] = ((const u32x4*)(up + (size_t)(tn + tt) * INW))[0]; wn[2 * tt + 1] = ((const u32x4*)(up + (size_t)(tn + tt) * INW))[1]; }
#pragma unroll
            for (int tt = 0; tt < 4; ++tt) {
                const u32x4 w0 = wc[2 * tt], w1 = wc[2 * tt + 1];
                float u[16];
                u[0] = bf_lo(w0.x); u[1] = bf_hi(w0.x); u[2] = bf_lo(w0.y); u[3] = bf_hi(w0.y); u[4] = bf_lo(w0.z); u[5] = bf_hi(w0.z); u[6] = bf_lo(w0.w); u[7] = bf_hi(w0.w);
                u[8] = bf_lo(w1.x); u[9] = bf_hi(w1.x); u[10] = bf_lo(w1.y); u[11] = bf_hi(w1.y); u[12] = bf_lo(w1.z); u[13] = bf_hi(w1.z); u[14] = bf_lo(w1.w); u[15] = bf_hi(w1.w);
                f32x2v b2 = (f32x2v){0.f, 0.f};
#pragma unroll
                for (int k = 0; k < 16; ++k) b2 += bb2[k] * u[k];
                const float nr = abr * hr - abi * hi + b2.x, ni = abr * hi + abi * hr + b2.y; hr = nr; hi = ni;
                Hf[(4 * q + tt) * 132 + lane] = hr; Hf[(4 * q + tt) * 132 + 64 + lane] = hi;
            }
        }
        asm volatile("s_waitcnt lgkmcnt(0)" ::: "memory");
        f32x4 y = (f32x4){0.f, 0.f, 0.f, 0.f};
#pragma unroll
        for (int j = 0; j < 8; ++j) {
            const f32x4 a4 = *(const LAS f32x4*)(Hf + fr * 132 + 16 * j + 4 * fq);
#pragma unroll
            for (int r = 0; r < 4; ++r) y = __builtin_amdgcn_mfma_f32_16x16x4f32(a4[r], cmB[4 * j + r], y, 0, 0, 0);
        }
        asm volatile("s_waitcnt lgkmcnt(0)" ::: "memory");
#pragma unroll
        for (int i = 0; i < 4; ++i) {
            const size_t row = row0 + 16 * blk + 4 * fq + i;
            YS[row * 512 + g * 16 + fr] = (bf16_t)f2bf(gelu_t(y[i] + dsk * __uint_as_float(((unsigned)uq[i]) << 16)));
        }
    }
}

__device__ __forceinline__ void fixup_phase(const float* RAW, bf16_t* ACT, const float* cw, const float* cb, int gtid, int nthr) {
    constexpr int NC4 = DFF / 4;
    for (int it = gtid; it < 256 * 2 * NC4; it += nthr) {
        const int c = (it % NC4) * 4, r = (it / NC4) & 1, sl = it / (2 * NC4);
        const int tc = (c >> 7) * 256 + (c & 127);
        const float* base = RAW + (size_t)sl * 4 * NUP + tc; const float* prev = base - (size_t)4 * NUP;
        const bool first = (sl & 127) == 0;
        const f32x4 z = (f32x4){0.f, 0.f, 0.f, 0.f};
        const f32x4 g0 = *(const f32x4*)(base + (size_t)r * NUP), v0 = *(const f32x4*)(base + (size_t)r * NUP + 128);
        const f32x4 g63 = first ? z : *(const f32x4*)(prev + (size_t)3 * NUP), v63 = first ? z : *(const f32x4*)(prev + (size_t)3 * NUP + 128);
        f32x4 g1, g2, v1, v2;
        if (r == 1) { g1 = *(const f32x4*)base; v1 = *(const f32x4*)(base + 128); g2 = g63; v2 = v63; }
        else { g1 = g63; v1 = v63; g2 = first ? z : *(const f32x4*)(prev + (size_t)2 * NUP); v2 = first ? z : *(const f32x4*)(prev + (size_t)2 * NUP + 128); }
        const f32x4 cgt = *(const f32x4*)(cb + c) + *(const f32x4*)(cw + c) * g0 + *(const f32x4*)(cw + NUP + c) * g1 + *(const f32x4*)(cw + 2 * NUP + c) * g2;
        const f32x4 cvl = *(const f32x4*)(cb + DFF + c) + *(const f32x4*)(cw + DFF + c) * v0 + *(const f32x4*)(cw + NUP + DFF + c) * v1 + *(const f32x4*)(cw + 2 * NUP + DFF + c) * v2;
        const f32x4 o = pg8::gelu4(cgt) * cvl;
        u32x2 w; w.x = cvt_pk_bf16(o[0], o[1]); w.y = cvt_pk_bf16(o[2], o[3]);
        *(u32x2*)(ACT + (size_t)(64 * sl + r) * DFF + c) = w;
    }
}

#define XB_TMO      128
#define XB_XCNT(j)  (256  + 64 * (j))
#define XB_XSUB(j)  (1280 + 64 * (j))
#define XB_XGEN(j)  (2304 + 64 * (j))
#define XB_TOP      3328
#define XB_TOPGEN   3392
#define XCD_BAR_WORDS 3456
#define XB_SPIN_CAP (1u << 18)

__device__ __forceinline__ unsigned xb_ld(unsigned* p)              { return __hip_atomic_load(p, __ATOMIC_RELAXED, __HIP_MEMORY_SCOPE_AGENT); }
__device__ __forceinline__ unsigned xb_add(unsigned* p, unsigned v) { return __hip_atomic_fetch_add(p, v, __ATOMIC_RELAXED, __HIP_MEMORY_SCOPE_AGENT); }
__device__ __forceinline__ unsigned xb_xcc_id() { return (unsigned)__builtin_amdgcn_s_getreg((3 << 11) | 20) & 0xFu; }
#define XB_SPIN(cond, bar) do { unsigned _sp = 0; while (cond) { __builtin_amdgcn_s_sleep(1); \
    if ((++_sp & 255u) == 0u) { if (xb_ld(&(bar)[XB_TMO])) break; if (_sp > XB_SPIN_CAP) { atomicAdd(&(bar)[XB_TMO], 1u); break; } } } } while (0)

struct XcdBarrier {
    unsigned* bar; unsigned x;
    volatile LAS unsigned* st;
};

__device__ __forceinline__ XcdBarrier xcd_barrier_post(unsigned* bar, volatile LAS unsigned* st) {
    XcdBarrier b; b.bar = bar; b.x = xb_xcc_id(); b.st = st;
    if (threadIdx.x == 0) (void)xb_add(&bar[XB_XCNT(b.x)], 1u);
    return b;
}
__device__ __forceinline__ void xcd_barrier_complete(unsigned* bar, unsigned x, unsigned& nloc, unsigned& nx) {
    const unsigned G = gridDim.x * gridDim.y * gridDim.z;
    unsigned sum, cnt, mine, sp = 0u;
    for (;;) {
        sum = 0u; cnt = 0u; mine = 0u;
#pragma unroll
        for (unsigned j = 0; j < 16; ++j) { const unsigned c = xb_ld(&bar[XB_XCNT(j)]); sum += c; cnt += (c > 0u) ? 1u : 0u; mine = (j == x) ? c : mine; }
        if (sum == G) break;
        __builtin_amdgcn_s_sleep(1);
        if ((++sp & 255u) == 0u) { if (xb_ld(&bar[XB_TMO])) break; if (sp > XB_SPIN_CAP) { atomicAdd(&bar[XB_TMO], 1u); break; } }
    }
    nloc = mine > 0u ? mine : 1u; nx = cnt > 0u ? cnt : 1u;
}

__device__ __forceinline__ void xcd_barrier(const XcdBarrier& b) {
    asm volatile("s_waitcnt vmcnt(0)" ::: "memory");
    __syncthreads();
    if (threadIdx.x == 0) {
        unsigned* bar = b.bar;
        __builtin_amdgcn_s_waitcnt(0);
        unsigned nloc = b.st[0], nx = b.st[1];
        if (nloc == 0u) { xcd_barrier_complete(bar, b.x, nloc, nx); b.st[0] = nloc; b.st[1] = nx; }
        const unsigned old = xb_add(&bar[XB_XSUB(b.x)], 1u);
        const unsigned gen = old / nloc;
        if (old + 1u == (gen + 1u) * nloc) {
            __builtin_amdgcn_fence(__ATOMIC_RELEASE, "agent");
            asm volatile("s_waitcnt vmcnt(0)" ::: "memory");
            const unsigned og = xb_add(&bar[XB_TOP], 1u);
            const unsigned tg = og / nx;
            if (og + 1u == (tg + 1u) * nx) xb_add(&bar[XB_TOPGEN], 1u);
            else XB_SPIN(xb_ld(&bar[XB_TOPGEN]) == tg, bar);
            __builtin_amdgcn_fence(__ATOMIC_ACQUIRE, "agent");
            xb_add(&bar[XB_XGEN(b.x)], 1u);
            asm volatile("s_waitcnt vmcnt(0)" ::: "memory");
        } else {
            XB_SPIN(xb_ld(&bar[XB_XGEN(b.x)]) == gen, bar);
            __builtin_amdgcn_fence(__ATOMIC_ACQUIRE, "agent");
            asm volatile("s_waitcnt vmcnt(0)" ::: "memory");
        }
    }
    __syncthreads();
}

#ifdef ONLY_MODE
#define ONLY_MODE_OK(m) ((m) == ONLY_MODE)
#else
#define ONLY_MODE_OK(m) true
#endif
#ifndef PG8_SP2
#define PG8_SP2 true
#endif
#ifndef PG8_ALIGN
#define PG8_ALIGN true
#endif
template <int MODE> __device__ __forceinline__ void run_gemm(LAS unsigned char* lds, const bf16_t* A, int lda, const bf16_t* Bt, int Mr, int N, int K, const pg8::Epi<MODE>& E, int wave_in) {
    pg8::Gemm g{A, Bt, Mr, N, K, lda}; pg8::StaticOrder S; S.init(Mr, N, (int)gridDim.x, (int)blockIdx.x);
#if !defined(NO_GEMM) && (!defined(ONLY_MODE) || 1)
    if (ONLY_MODE_OK(MODE)) pg8::gemm_phase<pg8::Epi<MODE>, pg8::StaticOrder, PG8_ALIGN, PG8_SP2>(lds, g, S, E, wave_in);
#endif
}

__global__ void __launch_bounds__(NTHR, 2) fwd(Args a) {
    extern __shared__ __attribute__((aligned(16))) unsigned char lds_raw[];
    LAS unsigned char* lds = (LAS unsigned char*)lds_raw;
    cg::grid_group grid = cg::this_grid();
    const int ph_lo = a.ph_lo, ph_hi = a.ph_hi;
    const int wave_s = __builtin_amdgcn_readfirstlane((int)threadIdx.x >> 6);
    constexpr int MISC_OFF = 139264;
    if (threadIdx.x < 16) ((LAS unsigned*)(lds + MISC_OFF))[threadIdx.x] = 0u;
    __syncthreads();
    (void)xcd_barrier_post((unsigned*)(a.ws + WS_BAR), (volatile LAS unsigned*)(lds + MISC_OFF) + 8);
    for (int ph = ph_lo; ph < ph_hi; ++ph) {
        CArgs* ap = (CArgs*)__builtin_amdgcn_kernarg_segment_ptr();
        asm volatile("" : "+s"(ap));
        int tid_ = wave_s * 64 + (int)__builtin_amdgcn_mbcnt_hi(~0u, __builtin_amdgcn_mbcnt_lo(~0u, 0u)); asm volatile("" : "+v"(tid_));
        const int tid = tid_, lane = tid & 63, wave = wave_s;
        const int G = gridDim.x, gw = blockIdx.x * NWAVES + wave, NGW = G * NWAVES;
        unsigned char* ws = ap->ws;
        bf16_t* XB = (bf16_t*)(ws + WS_XB); bf16_t* MRG = (bf16_t*)(ws + WS_MRG);
        bf16_t* PROJ = (bf16_t*)(ws + WS_PROJ); bf16_t* YCAT = (bf16_t*)(ws + WS_YCAT); bf16_t* YS = (bf16_t*)(ws + WS_YS); float* SST = (float*)(ws + WS_SST);
        bf16_t* ACT = (bf16_t*)(ws + WS_ACT); float* RAW = (float*)(ws + WS_RAW);
        {
            const int l = ph / PPL, sp = ph % PPL;
            const unsigned char* wl = ws + WS_W;
            float* SS = (float*)(ws + WS_SS);
            float* COEF = (float*)(ws + WS_COEF);
            if (sp == 0) { ssm_coef_phase(ap, l, COEF, gw, lane); convert_phase(ap, l, lds, gw, NGW, wave, lane); if (l == 0) xb_phase(ap->in[0], XB, SS, gw, NGW, lane); }
            else if (sp == 1) { pg8::Epi<pg8::EP_INPROJ> E{PROJ, INW, ap->in[3] + l * 6144, nullptr, 0, nullptr, nullptr, SS + (size_t)(2 * l) * M, nullptr, nullptr}; run_gemm<pg8::EP_INPROJ>(lds, XB, D, (const bf16_t*)(wl + O_WIN), M, INW, D, E, wave); }
            else if (sp == 2) {
                for (int u = blockIdx.x; u < 256; u += G) attn_unit(lds, PROJ, YCAT, ap->in[4] + l * 128, ap->in[5] + l * 128, ap->in[6] + l * 8, u, tid, wave, lane);
                for (int u = blockIdx.x; u < 512; u += G) sg_unit(lds, PROJ, YCAT, ap->in[7] + l * 512, ap->in[8] + l * 512, ap->in[9] + (size_t)l * 4 * 128 * 128, ap->in[10] + l * 512, u, tid, wave, lane);
                for (int u = gw; u < 4096; u += NGW) ssm_unit<false>(ap, COEF, l, PROJ, SST, YS, lds + wave * 4352, u, lane);
            }
            else if (sp == 3) { for (int u = gw; u < 4096; u += NGW) ssm_pass3h(ap, COEF, l, PROJ, SST, YS, lds + wave * 8448, u, lane); }
            else if (sp == 4) { pg8::Epi<pg8::EP_GLU> E{YCAT + 1536, D, ap->in[20] + l * 512, YS, 512, nullptr}; run_gemm<pg8::EP_GLU>(lds, YS, 512, (const bf16_t*)(wl + O_WGLU), M, 512, 512, E, wave); }
            else if (sp == 5) {
                { pg8::Epi<pg8::EP_MERGE0> E{MRG, D, nullptr, PROJ + 3072, INW, nullptr}; run_gemm<pg8::EP_MERGE0>(lds, YCAT, D, (const bf16_t*)(wl + O_WA), M, D, 1024, E, wave); }
#pragma unroll 1
                for (int j = 1; j < 3; ++j) { pg8::Epi<pg8::EP_MERGE1> E{MRG, D, nullptr, PROJ + 3072 + j * D, INW, nullptr};
                    run_gemm<pg8::EP_MERGE1>(lds, YCAT + 512 + 512 * j, D, (const bf16_t*)(wl + (j == 1 ? O_WSG : O_WSSM)), M, D, 512, E, wave); }
            }
            else if (sp == 7) { pg8::Epi<pg8::EP_UPCONV> E{ACT, DFF, ap->in[27] + (size_t)l * 3 * NUP, nullptr, 0, ap->in[28] + (size_t)l * NUP, RAW, SS + (size_t)(2 * l + 1) * M, nullptr, nullptr};
                run_gemm<pg8::EP_UPCONV>(lds, XB, D, (const bf16_t*)(wl + O_WUP), M, NUP, D, E, wave); }
            else if (sp == 8) fixup_phase(RAW, ACT, ap->in[27] + (size_t)l * 3 * NUP, ap->in[28] + (size_t)l * NUP, blockIdx.x * NTHR + tid, G * NTHR);
            else {
                const bf16_t* A; const bf16_t* Bt; int K; float* sso;
                if (sp == 6) { A = MRG; Bt = (const bf16_t*)(wl + O_WOUT); K = D; sso = SS + (size_t)(2 * l + 1) * M; }
                else { A = ACT; Bt = (const bf16_t*)(wl + O_WDN); K = DFF; sso = (l == 0) ? SS + (size_t)2 * M : nullptr; }
                pg8::Epi<pg8::EP_RESID> E{sso ? nullptr : ap->out, D, nullptr, nullptr, 0, nullptr, nullptr, nullptr, XB, sso};
                run_gemm<pg8::EP_RESID>(lds, A, K, Bt, M, D, K, E, wave);
            }
        }
        if (ph + 1 < ph_hi) {
            if (ph == ph_lo) grid.sync();
            else { XcdBarrier bar; bar.bar = (unsigned*)(ws + WS_BAR); bar.x = xb_xcc_id(); bar.st = (volatile LAS unsigned*)(lds + MISC_OFF) + 8; xcd_barrier(bar); }
        }
    }
}
}

extern "C" void kernel_launch(void* const* d_in, const int* in_sizes, int n_in, void* d_out, int out_size, void* d_ws, size_t ws_size, hipStream_t stream) {
    using namespace mk;
    static int grid = 0;
    if (grid == 0) {
        if (n_in != 30 || out_size != M * D || ws_size < WS_END) { fprintf(stderr, "kernel_launch: unexpected problem (n_in %d out %d ws %zu need %zu)\n", n_in, out_size, ws_size, (size_t)WS_END); grid = -1; return; }
        int dev = 0, cus = 0, per_cu = 0;
        (void)hipGetDevice(&dev); (void)hipDeviceGetAttribute(&cus, hipDeviceAttributeMultiprocessorCount, dev);
        (void)hipFuncSetAttribute((const void*)fwd, hipFuncAttributeMaxDynamicSharedMemorySize, LDS_BYTES);
        if (hipOccupancyMaxActiveBlocksPerMultiprocessor(&per_cu, (const void*)fwd, NTHR, LDS_BYTES) != hipSuccess || per_cu < 1) { fprintf(stderr, "kernel_launch: occupancy query gave %d\n", per_cu); per_cu = 1; }
        (void)hipGetLastError();
        grid = cus * 1;
    }
    if (grid < 0) return;
    Args a{};
    for (int i = 0; i < 30; ++i) a.in[i] = (const float*)d_in[i];
    a.out = (float*)d_out; a.ws = (unsigned char*)d_ws;
    (void)hipMemsetAsync((unsigned char*)d_ws + WS_SS, 0, (size_t)1 * MiB, stream);
#if MK_MULTI
    for (int p = 0; p < NPH; ++p) { a.ph_lo = p; a.ph_hi = p + 1; hipLaunchKernelGGL(fwd, dim3(grid), dim3(NTHR), LDS_BYTES, stream, a); }
#else
    a.ph_lo = 0; a.ph_hi = NPH;
    void* args[] = {&a};
    hipError_t e = hipLaunchCooperativeKernel((const void*)fwd, dim3(grid), dim3(NTHR), args, LDS_BYTES, stream);
    if (e != hipSuccess) fprintf(stderr, "cooperative launch failed: %s (grid %d)\n", hipGetErrorString(e), grid);
#endif
}
```

```cpp
#include <hip/hip_runtime.h>
#include <hip/hip_cooperative_groups.h>
#include <cstdio>
#include <cstdint>
#include <cmath>
namespace cg = cooperative_groups;
#ifndef REP_CONVERT
#define REP_CONVERT 1
#endif
#ifndef REP_SSM
#define REP_SSM 1
#endif
#ifndef REP_ATT
#define REP_ATT 1
#endif
#ifndef MK_MULTI
#define MK_MULTI 0
#endif
namespace pg8 {
#define PG8_LAS __attribute__((address_space(3)))
typedef unsigned short bf16_t;
typedef short bf16x8 __attribute__((ext_vector_type(8)));
typedef float f32x4 __attribute__((ext_vector_type(4)));
typedef unsigned u32x4 __attribute__((ext_vector_type(4)));
constexpr int BM = 256, BK = 64, HALF = 128, HTB = HALF * BK * 2  , STAGE_BYTES = 8 * HTB, NXCD = 8, WGM = 8;

__host__ __device__ __forceinline__ int lds_byte(int r, int c) { const int st = (r >> 4) * 2 + (c >> 5), rr = r & 15, cc = c & 31, ob = rr * 64 + cc * 2; return st * 1024 + (ob ^ (((ob >> 9) & 1) << 5)); }
__host__ __device__ __forceinline__ void stage_rc(int b, int& R, int& C) { const int st = b / 1024, sb = b % 1024, swz = sb ^ (((sb >> 9) & 1) << 5); R = (st >> 1) * 16 + swz / 64; C = (st & 1) * 32 + (swz % 64) / 2; }
__host__ __device__ __forceinline__ int perm32(int rho) { const int n = rho >> 4, i = rho & 15; return 8 * (i >> 2) + 4 * n + (i & 3); }

struct Unit { int pm, pn; };
struct Gemm { const bf16_t* A; const bf16_t* Bt; int M, N, K, lda; };

struct StaticOrder {
    int nM, nN, nwg, G, c;
    __host__ __device__ void init(int M, int N, int G_, int c_) { nM = M / BM; nN = N / BM; nwg = nM * nN; G = G_; c = c_; }
    __host__ __device__ bool next(int i, Unit& u) const {
        const long L = (long)i * G + c; if (L >= nwg) return false;
        int wgid = (int)L; { const int q = nwg / NXCD, r = nwg % NXCD, xcd = wgid % NXCD, off = wgid / NXCD; wgid = (xcd < r ? xcd * (q + 1) : r * (q + 1) + (xcd - r) * q) + off; }
        const int nig = WGM * nN, gid = wgid / nig, fm = gid * WGM, gsz = (nM - fm) < WGM ? (nM - fm) : WGM;
        u.pm = fm + ((wgid % nig) % gsz); u.pn = (wgid % nig) / gsz; return true;
    }
    __device__ __forceinline__ void a_ready(const Unit&) const {}
    __device__ __forceinline__ void done(const Unit&) const {}
};

__device__ __forceinline__ unsigned cvt_pk_bf16(float lo, float hi) { unsigned r; asm volatile("v_cvt_pk_bf16_f32 %0, %1, %2" : "=v"(r) : "v"(lo), "v"(hi)); return r; }
__device__ __forceinline__ float bf_lo(unsigned w) { return __uint_as_float(w << 16); }
__device__ __forceinline__ float bf_hi(unsigned w) { return __uint_as_float(w & 0xffff0000u); }
__device__ __forceinline__ float sigm(float x) { return __builtin_amdgcn_rcpf(1.f + __expf(-x)); }
__device__ __forceinline__ float gelu_t(float x) { const float p = __builtin_fmaf(x * x, -0.10294324f, -2.30220819f); return x * __builtin_amdgcn_rcpf(1.f + __builtin_amdgcn_exp2f(x * p)); }
__device__ __forceinline__ f32x4 sigm4(f32x4 v) { return (f32x4){sigm(v[0]), sigm(v[1]), sigm(v[2]), sigm(v[3])}; }
__device__ __forceinline__ f32x4 gelu4(f32x4 v) { return (f32x4){gelu_t(v[0]), gelu_t(v[1]), gelu_t(v[2]), gelu_t(v[3])}; }
__device__ __forceinline__ u32x4 pack8(f32x4 a, f32x4 b) { u32x4 w; w.x = cvt_pk_bf16(a[0], a[1]); w.y = cvt_pk_bf16(a[2], a[3]); w.z = cvt_pk_bf16(b[0], b[1]); w.w = cvt_pk_bf16(b[2], b[3]); return w; }
__device__ __forceinline__ void unpack8(u32x4 w, f32x4& a, f32x4& b) { a = (f32x4){bf_lo(w.x), bf_hi(w.x), bf_lo(w.y), bf_hi(w.y)}; b = (f32x4){bf_lo(w.z), bf_hi(w.z), bf_lo(w.w), bf_hi(w.w)}; }
enum { EP_INPROJ = 0, EP_GLU = 1, EP_MERGE0 = 2, EP_MERGE1 = 3, EP_RESID = 4, EP_RAW = 5, EP_UPCONV = 6 };
template <int CTRL> __device__ __forceinline__ float dpp_f(float x) { return __builtin_bit_cast(float, __builtin_amdgcn_update_dpp(0, __builtin_bit_cast(int, x), CTRL, 0xf, 0xf, false)); }
template <int CTRL> __device__ __forceinline__ f32x4 dpp4(f32x4 v) { return (f32x4){dpp_f<CTRL>(v[0]), dpp_f<CTRL>(v[1]), dpp_f<CTRL>(v[2]), dpp_f<CTRL>(v[3])}; }
template <int MODE> struct Epi {
    static constexpr bool PERM = true, AFTER_DRAIN = false;
    void* O; int ldc; const float* bias; const bf16_t* aux; int ldaux; const float* xin; float* raw; const float* ss; bf16_t* xb; float* ssout;
    __device__ __forceinline__ void operator()(const f32x4 (&acc)[2][2][4][2], const Unit& u, int wr, int wc, int fr, int fq) const {
        const int row0 = u.pm * BM + wr * 64 + fr, col0 = u.pn * BM + wc * 32 + 8 * fq;
        if constexpr (MODE == EP_UPCONV) {
            constexpr int NUPc = 11264, DFFc = 5632;
            const int cgl = u.pn * 128 + wc * 32 + 8 * fq, tcol = u.pn * 256 + wc * 32 + 8 * fq;
            float rs[2][4];
#pragma unroll
            for (int ai = 0; ai < 2; ++ai)
#pragma unroll
                for (int m = 0; m < 4; ++m) rs[ai][m] = rsqrtf(ss[row0 + ai * HALF + m * 16] * (1.f / 2048.f) + 1e-6f);
#pragma unroll
            for (int ai = 0; ai < 2; ++ai) {
                const int slab = u.pm * 4 + ai * 2 + wr;
                if (fr < 2) {
#pragma unroll
                    for (int bj = 0; bj < 2; ++bj)
#pragma unroll
                        for (int n = 0; n < 2; ++n) *(f32x4*)(raw + (size_t)(slab * 4 + fr) * NUPc + tcol + bj * 128 + 4 * n) = acc[ai][bj][0][n] * rs[ai][0];
                }
                if (fr >= 14) {
#pragma unroll
                    for (int bj = 0; bj < 2; ++bj)
#pragma unroll
                        for (int n = 0; n < 2; ++n) *(f32x4*)(raw + (size_t)(slab * 4 + fr - 12) * NUPc + tcol + bj * 128 + 4 * n) = acc[ai][bj][3][n] * rs[ai][3];
                }
            }
#pragma unroll
            for (int n = 0; n < 2; ++n) {
                const int c = cgl + 4 * n;
                const f32x4 wg0 = *(const f32x4*)(bias + c), wg1 = *(const f32x4*)(bias + NUPc + c), wg2 = *(const f32x4*)(bias + 2 * NUPc + c), bg = *(const f32x4*)(xin + c);
                const f32x4 wv0 = *(const f32x4*)(bias + DFFc + c), wv1 = *(const f32x4*)(bias + NUPc + DFFc + c), wv2 = *(const f32x4*)(bias + 2 * NUPc + DFFc + c), bv = *(const f32x4*)(xin + DFFc + c);
#pragma unroll
                for (int ai = 0; ai < 2; ++ai) {
                    f32x4 pg1 = (f32x4){0.f, 0.f, 0.f, 0.f}, pg2 = pg1, pv1 = pg1, pv2 = pg1;
#pragma unroll
                    for (int m = 0; m < 4; ++m) {
                        const f32x4 g = acc[ai][0][m][n] * rs[ai][m], v = acc[ai][1][m][n] * rs[ai][m];
                        const f32x4 g1 = dpp4<0x121>(g), g2 = dpp4<0x122>(g), v1 = dpp4<0x121>(v), v2 = dpp4<0x122>(v);
                        const f32x4 gp1 = (fr >= 1) ? g1 : pg1, gp2 = (fr >= 2) ? g2 : pg2, vp1 = (fr >= 1) ? v1 : pv1, vp2 = (fr >= 2) ? v2 : pv2;
                        const f32x4 cgt = bg + wg0 * g + wg1 * gp1 + wg2 * gp2, cvl = bv + wv0 * v + wv1 * vp1 + wv2 * vp2;
                        const f32x4 o = gelu4(cgt) * cvl;
                        typedef unsigned u32x2e __attribute__((ext_vector_type(2)));
                        u32x2e w; w.x = cvt_pk_bf16(o[0], o[1]); w.y = cvt_pk_bf16(o[2], o[3]);
                        if (!(m == 0 && fr < 2)) *(u32x2e*)((bf16_t*)O + (size_t)(row0 + ai * HALF + m * 16) * DFFc + c) = w;
                        pg1 = g1; pg2 = g2; pv1 = v1; pv2 = v2;
                    }
                }
            }
            return;
        }
        int kind = 0;
        if (MODE == EP_INPROJ) kind = (u.pn >= 12) ? 2 : ((u.pn >= 6 && u.pn < 10) ? 1 : 0);
        float rsr[2][4]; f32x4 cb0[2], cb1[2];
#pragma unroll
        for (int bj = 0; bj < 2; ++bj) { cb0[bj] = (f32x4){0.f, 0.f, 0.f, 0.f}; cb1[bj] = cb0[bj]; }
        if (MODE == EP_INPROJ) {
#pragma unroll
            for (int ai = 0; ai < 2; ++ai)
#pragma unroll
                for (int m = 0; m < 4; ++m) rsr[ai][m] = rsqrtf(ss[row0 + ai * HALF + m * 16] * (1.f / 2048.f) + 1e-6f);
            if (kind == 2) {
#pragma unroll
                for (int bj = 0; bj < 2; ++bj) { cb0[bj] = *(const f32x4*)(bias + (col0 + bj * HALF - 3072)); cb1[bj] = *(const f32x4*)(bias + (col0 + bj * HALF - 3072) + 4); }
            }
        }
        if (MODE == EP_GLU) {
#pragma unroll
            for (int bj = 0; bj < 2; ++bj) { cb0[bj] = *(const f32x4*)(bias + col0 + bj * HALF); cb1[bj] = *(const f32x4*)(bias + col0 + bj * HALF + 4); }
        }
#pragma unroll
        for (int ai = 0; ai < 2; ++ai)
#pragma unroll
            for (int m = 0; m < 4; ++m) {
                const size_t row = (size_t)(row0 + ai * HALF + m * 16);
                float ssq = 0.f;
#pragma unroll
                for (int bj = 0; bj < 2; ++bj) {
                    const int col = col0 + bj * HALF;
                    f32x4 v0 = acc[ai][bj][m][0], v1 = acc[ai][bj][m][1];
                    if (MODE == EP_INPROJ) {
                        const float rs = rsr[ai][m];
                        v0 = v0 * rs; v1 = v1 * rs;
                        if (kind == 1) { v0 = gelu4(v0); v1 = gelu4(v1); }
                        else if (kind == 2) { v0 = sigm4(v0 + cb0[bj]); v1 = sigm4(v1 + cb1[bj]); }
                        *(u32x4*)((bf16_t*)O + row * ldc + col) = pack8(v0, v1);
                    } else if (MODE == EP_GLU) {
                        f32x4 y0, y1; unpack8(*(const u32x4*)(aux + row * ldaux + col), y0, y1);
                        v0 = y0 * sigm4(v0 + cb0[bj]); v1 = y1 * sigm4(v1 + cb1[bj]);
                        *(u32x4*)((bf16_t*)O + row * ldc + col) = pack8(v0, v1);
                    } else if (MODE == EP_MERGE0 || MODE == EP_MERGE1) {
                        f32x4 g0, g1; unpack8(*(const u32x4*)(aux + row * ldaux + col), g0, g1);
                        v0 = g0 * v0; v1 = g1 * v1;
                        if (MODE == EP_MERGE1) { f32x4 o0, o1; unpack8(*(const u32x4*)((const bf16_t*)O + row * ldc + col), o0, o1); v0 = v0 + o0; v1 = v1 + o1; }
                        *(u32x4*)((bf16_t*)O + row * ldc + col) = pack8(v0, v1);
                    } else if (MODE == EP_RESID) {
                        f32x4 x0, x1; unpack8(*(const u32x4*)(xb + row * ldc + col), x0, x1); x0 = x0 + v0; x1 = x1 + v1;
                        if (O) { *(f32x4*)((float*)O + row * ldc + col) = x0; *(f32x4*)((float*)O + row * ldc + col + 4) = x1; }
                        if (ssout) {
                            *(u32x4*)(xb + row * ldc + col) = pack8(x0, x1);
                            const float q = (x0[0] * x0[0] + x0[1] * x0[1]) + (x0[2] * x0[2] + x0[3] * x0[3]) + (x1[0] * x1[0] + x1[1] * x1[1]) + (x1[2] * x1[2] + x1[3] * x1[3]);
                            if (bj == 0) ssq = q; else ssq += q;
                        }
                    } else {
                        *(u32x4*)((bf16_t*)O + row * ldc + col) = pack8(v0, v1);
                    }
                }
                if (MODE == EP_RESID) { if (ssout) { ssq += __shfl_xor(ssq, 16); ssq += __shfl_xor(ssq, 32); if (fq == 0) unsafeAtomicAdd(ssout + row, ssq); } }
                if (m == 3) asm volatile("" ::: "memory");
            }
    }
};
template <class Epi, class Sched, bool ALIGN_EPI = false, bool SP2 = false>
__device__ __forceinline__ void gemm_phase(PG8_LAS unsigned char* lds, const Gemm g, const Sched& S, const Epi& E, int wave_in) {
    int tid_ = wave_in * 64 + (int)__builtin_amdgcn_mbcnt_hi(~0u, __builtin_amdgcn_mbcnt_lo(~0u, 0u)); asm volatile("" : "+v"(tid_));
    const int tid = tid_, wid = __builtin_amdgcn_readfirstlane(tid >> 6), lane = tid & 63, wr = wid >> 2, wc = wid & 3, fr = lane & 15, fq = lane >> 4;
    const int K = g.K, nt = K / BK;
    unsigned voffA[2], voffB[2];
#pragma unroll
    for (int i = 0; i < 2; ++i) { int R, C; stage_rc(tid * 16 + i * 8192, R, C); const int Rb = Epi::PERM ? ((R & ~31) + perm32(R & 31)) : R;
        voffA[i] = (unsigned)(R * g.lda + C) * 2u; voffB[i] = (unsigned)(Rb * K + C) * 2u; }
    const size_t kstep = (size_t)(BK * 2);
    const size_t hstep = (size_t)HALF * K * 2;
    const size_t tstep = 2 * hstep; const size_t hstepA = (size_t)HALF * g.lda * 2, tstepA = 2 * hstepA;
    const unsigned ldsw = (unsigned)wid * 1024u;
    const int aoff = lds_byte(wr * 64 + fr, fq * 8), boff = lds_byte(wc * 32 + fr, fq * 8);
#define PG8_SA(b, h) (((b) * 2 + (h)) * HTB)
#define PG8_SB(b, h) ((4 + (b) * 2 + (h)) * HTB)
#define PG8_STAGE(bufoff, gbase, voff) do { _Pragma("unroll") for (int _i = 0; _i < 2; ++_i) \
        __builtin_amdgcn_global_load_lds((const unsigned*)((const char*)(gbase) + (voff)[_i]), (PG8_LAS unsigned*)(lds + (bufoff) + ldsw + _i * 8192), 16, 0, 0); } while (0)
#define PG8_LDA(dst, b, h) do { _Pragma("unroll") for (int m = 0; m < 4; ++m) _Pragma("unroll") for (int k = 0; k < 2; ++k) dst[m][k] = *(const PG8_LAS bf16x8*)(lds + PG8_SA(b, h) + aoff + m * 2048 + k * 1024); } while (0)
#define PG8_LDB(dst, b, h) do { _Pragma("unroll") for (int n = 0; n < 2; ++n) _Pragma("unroll") for (int k = 0; k < 2; ++k) dst[n][k] = *(const PG8_LAS bf16x8*)(lds + PG8_SB(b, h) + boff + n * 2048 + k * 1024); } while (0)
#define PG8_MMA(ai, bj, At, Bt) do { __builtin_amdgcn_s_setprio(1); _Pragma("unroll") for (int m = 0; m < 4; ++m) _Pragma("unroll") for (int n = 0; n < 2; ++n) _Pragma("unroll") for (int k = 0; k < 2; ++k) \
        acc[ai][bj][m][n] = __builtin_amdgcn_mfma_f32_16x16x32_bf16(Bt[n][k], At[m][k], acc[ai][bj][m][n], 0, 0, 0); __builtin_amdgcn_s_setprio(0); } while (0)
#define PG8_WAIT_V(n) asm volatile("s_waitcnt vmcnt(" #n ")" ::: "memory")
#define PG8_WAIT_L(n) asm volatile("s_waitcnt lgkmcnt(" #n ")" ::: "memory")
#define PG8_BAR __builtin_amdgcn_s_barrier()
#define PG8_SCHED __builtin_amdgcn_sched_barrier(0)
    Unit cur, nxt; int ui = 0;
    if (!S.next(0, cur)) return;
    f32x4 acc[2][2][4][2];
#pragma unroll
    for (int a = 0; a < 2; ++a)
#pragma unroll
        for (int b = 0; b < 2; ++b)
#pragma unroll
            for (int m = 0; m < 4; ++m)
#pragma unroll
                for (int n = 0; n < 2; ++n) acc[a][b][m][n] = (f32x4){0.f, 0.f, 0.f, 0.f};
    bf16x8 At[4][2], B0[2][2], B1[2][2];
    const char* cA = (const char*)g.A + (size_t)cur.pm * tstepA; const char* cB = (const char*)g.Bt + (size_t)cur.pn * tstep;
    S.a_ready(cur);
    if constexpr (SP2) {
        PG8_STAGE(PG8_SB(0, 0), cB, voffB); PG8_STAGE(PG8_SB(0, 1), cB + hstep, voffB); PG8_STAGE(PG8_SA(0, 0), cA, voffA); PG8_STAGE(PG8_SA(0, 1), cA + hstepA, voffA);
        if (wr == 1) PG8_BAR;
        PG8_WAIT_V(2); PG8_BAR;
        PG8_STAGE(PG8_SB(1, 0), cB + kstep, voffB); PG8_STAGE(PG8_SA(1, 0), cA + kstep, voffA); PG8_STAGE(PG8_SB(1, 1), cB + hstep + kstep, voffB);
        PG8_WAIT_V(6); PG8_BAR;
    } else {
        PG8_STAGE(PG8_SB(0, 0), cB, voffB); PG8_STAGE(PG8_SA(0, 0), cA, voffA); PG8_STAGE(PG8_SB(0, 1), cB + hstep, voffB); PG8_STAGE(PG8_SA(0, 1), cA + hstepA, voffA);
        if (wr == 1) PG8_BAR;
        PG8_WAIT_V(4); PG8_BAR;
        PG8_STAGE(PG8_SB(1, 0), cB + kstep, voffB); PG8_STAGE(PG8_SA(1, 0), cA + kstep, voffA); PG8_STAGE(PG8_SB(1, 1), cB + hstep + kstep, voffB);
        PG8_WAIT_V(6); PG8_BAR;
    }
    for (;;) {
        const bool has_next = S.next(ui + 1, nxt);
        const char* nA = has_next ? (const char*)g.A + (size_t)nxt.pm * tstepA : cA; const char* nB = has_next ? (const char*)g.Bt + (size_t)nxt.pn * tstep : cB;
        for (int t = 0; t < nt; t += 2) {
            const bool last = (t == nt - 2);
            const char* a1 = cA + (size_t)(t + 1) * kstep;
            const char* a2 = last ? nA : cA + (size_t)(t + 2) * kstep; const char* b2 = last ? nB : cB + (size_t)(t + 2) * kstep;
            const char* a3 = a2 + kstep; const char* b3 = b2 + kstep;
            if (last && has_next) S.a_ready(nxt);
            if constexpr (SP2) {
            PG8_LDB(B0, 0, 0); PG8_LDB(B1, 0, 1); PG8_SCHED; PG8_LDA(At, 0, 0); PG8_STAGE(PG8_SA(1, 1), a1 + hstepA, voffA);
            PG8_WAIT_V(8); PG8_WAIT_L(0); PG8_BAR; PG8_MMA(0, 0, At, B0); PG8_MMA(0, 1, At, B1); PG8_BAR; PG8_SCHED;
            PG8_LDA(At, 0, 1); PG8_STAGE(PG8_SB(0, 0), b2, voffB); PG8_STAGE(PG8_SB(0, 1), b2 + hstep, voffB); PG8_STAGE(PG8_SA(0, 0), a2, voffA);
            PG8_WAIT_V(8); PG8_WAIT_L(0); PG8_BAR; PG8_MMA(1, 0, At, B0); PG8_MMA(1, 1, At, B1); PG8_BAR; PG8_SCHED;
            PG8_LDB(B0, 1, 0); PG8_LDB(B1, 1, 1); PG8_SCHED; PG8_LDA(At, 1, 0); PG8_STAGE(PG8_SA(0, 1), a2 + hstepA, voffA);
            PG8_WAIT_V(8); PG8_WAIT_L(0); PG8_BAR; PG8_MMA(0, 0, At, B0); PG8_MMA(0, 1, At, B1); PG8_BAR; PG8_SCHED;
            PG8_LDA(At, 1, 1); PG8_STAGE(PG8_SB(1, 0), b3, voffB); PG8_STAGE(PG8_SB(1, 1), b3 + hstep, voffB); PG8_STAGE(PG8_SA(1, 0), a3, voffA);
            PG8_WAIT_V(8); PG8_WAIT_L(0); PG8_BAR; PG8_MMA(1, 0, At, B0); PG8_MMA(1, 1, At, B1); PG8_BAR; PG8_SCHED;
            } else {
            PG8_LDB(B0, 0, 0); PG8_SCHED; PG8_LDA(At, 0, 0); PG8_STAGE(PG8_SA(1, 1), a1 + hstepA, voffA);
            PG8_WAIT_L(8); PG8_BAR; PG8_WAIT_L(0); PG8_MMA(0, 0, At, B0); PG8_BAR; PG8_SCHED;
            PG8_LDB(B1, 0, 1); PG8_STAGE(PG8_SB(0, 0), b2, voffB);
            PG8_BAR; PG8_WAIT_L(0); PG8_MMA(0, 1, At, B1); PG8_BAR;
            PG8_LDA(At, 0, 1); PG8_STAGE(PG8_SA(0, 0), a2, voffA);
            PG8_BAR; PG8_WAIT_L(0); PG8_MMA(1, 0, At, B0); PG8_BAR; PG8_SCHED;
            PG8_STAGE(PG8_SB(0, 1), b2 + hstep, voffB);
            PG8_WAIT_V(6); PG8_BAR; PG8_MMA(1, 1, At, B1); PG8_BAR;
            PG8_LDB(B0, 1, 0); PG8_SCHED; PG8_LDA(At, 1, 0); PG8_STAGE(PG8_SA(0, 1), a2 + hstepA, voffA);
            PG8_WAIT_L(8); PG8_BAR; PG8_WAIT_L(0); PG8_MMA(0, 0, At, B0); PG8_BAR; PG8_SCHED;
            PG8_LDB(B1, 1, 1); PG8_STAGE(PG8_SB(1, 0), b3, voffB);
            PG8_BAR; PG8_WAIT_L(0); PG8_MMA(0, 1, At, B1); PG8_BAR;
            PG8_LDA(At, 1, 1); PG8_STAGE(PG8_SA(1, 0), a3, voffA);
            PG8_BAR; PG8_WAIT_L(0); PG8_MMA(1, 0, At, B0); PG8_BAR; PG8_SCHED;
            PG8_STAGE(PG8_SB(1, 1), b3 + hstep, voffB);
            PG8_WAIT_V(6); PG8_BAR; PG8_MMA(1, 1, At, B1); PG8_BAR;
            }
        }
        if constexpr (ALIGN_EPI) { if (wr == 0) PG8_BAR; }
        if constexpr (!Epi::AFTER_DRAIN) { E(acc, cur, wr, wc, fr, fq); S.done(cur); }
        if (!has_next) break;
#pragma unroll
        for (int a = 0; a < 2; ++a)
#pragma unroll
            for (int b = 0; b < 2; ++b)
#pragma unroll
                for (int m = 0; m < 4; ++m)
#pragma unroll
                    for (int n = 0; n < 2; ++n) acc[a][b][m][n] = (f32x4){0.f, 0.f, 0.f, 0.f};
        cur = nxt; cA = nA; cB = nB; ++ui;
        if constexpr (ALIGN_EPI) { if (wr == 1) PG8_BAR; }
    }
    PG8_WAIT_V(0);
    if constexpr (!ALIGN_EPI) { if (wr == 0) PG8_BAR; }
    PG8_BAR;
    if constexpr (Epi::AFTER_DRAIN) { E.fused(acc, cur, wr, wc, fr, fq, lds, wid, lane); S.done(cur); }
#undef PG8_SA
#undef PG8_SB
#undef PG8_STAGE
#undef PG8_LDA
#undef PG8_LDB
#undef PG8_MMA
#undef PG8_WAIT_V
#undef PG8_WAIT_L
#undef PG8_BAR
#undef PG8_SCHED
}
}

namespace mk {
using pg8::bf16_t; using pg8::bf16x8; using pg8::f32x4; using pg8::u32x4; using pg8::bf_lo; using pg8::bf_hi; using pg8::cvt_pk_bf16; using pg8::gelu_t;
#define LAS __attribute__((address_space(3)))
typedef unsigned u32x2 __attribute__((ext_vector_type(2)));
constexpr int M = 16384, D = 2048, SEQ = 8192, INW = 9216, DFF = 5632, NUP = 11264, MH = 8192;
constexpr int NWAVES = 8, NTHR = 512;
constexpr int LDS_BYTES = 143360;
constexpr float EPS = 1e-6f;
constexpr size_t O_WIN = 0, O_WA = O_WIN + (size_t)INW * D * 2, O_WSG = O_WA + (size_t)D * 1024 * 2, O_WSSM = O_WSG + (size_t)D * 512 * 2, O_WOUT = O_WSSM + (size_t)D * 512 * 2,
                 O_WUP = O_WOUT + (size_t)D * D * 2, O_WDN = O_WUP + (size_t)NUP * D * 2, O_WGLU = O_WDN + (size_t)D * DFF * 2, WLAYER = O_WGLU + (size_t)512 * 512 * 2;
constexpr size_t MiB = 1u << 20;
constexpr size_t WS_W = 0, WS_XB = 119 * MiB, WS_MRG = WS_XB + 64 * MiB, WS_PROJ = WS_MRG + 64 * MiB, WS_YCAT = WS_PROJ + 288 * MiB, WS_YS = WS_YCAT + 64 * MiB, WS_SST = WS_YS + 16 * MiB, WS_SS = WS_SST + 2 * MiB, WS_BAR = WS_SS + 512 * 1024, WS_COEF = WS_SS + 768 * 1024, WS_END = WS_SS + 1 * MiB;
static_assert(WLAYER <= 119 * MiB, "one layer of bf16 weights");
constexpr size_t WS_ACT = WS_PROJ, WS_RAW = WS_PROJ + 176 * MiB;
static_assert(WLAYER % 256 == 0 && (size_t)M * INW * 2 == 288 * MiB && (size_t)M * DFF * 2 == 176 * MiB && (size_t)256 * 4 * NUP * 4 <= 112 * MiB, "ws map");
constexpr int PPL = 10, NPH = PPL * 2;

struct Args { const float* in[30]; float* out; unsigned char* ws; int ph_lo, ph_hi; };
typedef __attribute__((address_space(4))) const Args CArgs;

__device__ __forceinline__ float wave_sum(float v) {
#pragma unroll
    for (int o = 1; o < 64; o <<= 1) v += __shfl_xor(v, o);
    return v;
}
__device__ __forceinline__ unsigned f2bf(float f) { unsigned u = __builtin_bit_cast(unsigned, f); return (u + 0x7fffu + ((u >> 16) & 1u)) >> 16; }
__device__ __forceinline__ unsigned pk2(float lo, float hi) { return f2bf(lo) | (f2bf(hi) << 16); }

__device__ __forceinline__ void titem_load(const float* W, int N, int item, int lane, float (&wv)[32]) {
    const int nblk = N / 32, kb = item / nblk, nb = item % nblk;
    const float* wp = W + (size_t)(64 * kb + (lane >> 5)) * N + 32 * nb + (lane & 31);
#pragma unroll
    for (int i = 0; i < 32; ++i) wv[i] = __builtin_nontemporal_load(wp + (size_t)(2 * i) * N);
}
__device__ __forceinline__ void titem_finish(const float (&wv)[32], int K, int N, bf16_t* WT, LAS float* scr, int item, int lane, bool upperm, const float* gain) {
    const int nblk = N / 32, kb = item / nblk, nb = item % nblk, k0 = 64 * kb, n0 = 32 * nb;
    int nd0 = n0; if (upperm) { const int hi = n0 >= 5632, nn = n0 - hi * 5632; nd0 = 256 * (nn >> 7) + 128 * hi + (nn & 127); }
#pragma unroll
    for (int i = 0; i < 32; ++i) scr[(2 * i + (lane >> 5)) * 33 + (lane & 31)] = wv[i];
    asm volatile("s_waitcnt lgkmcnt(0)" ::: "memory");
    const int c = lane & 7;
    f32x4 g0 = (f32x4){1.f, 1.f, 1.f, 1.f}, g1 = g0;
    if (gain) { g0 = *(const f32x4*)(gain + k0 + 8 * c); g1 = *(const f32x4*)(gain + k0 + 8 * c + 4); }
#pragma unroll
    for (int j = 0; j < 4; ++j) { const int n = (lane >> 3) + 8 * j; const LAS float* s = scr + (8 * c) * 33 + n;
        u32x4 o; o.x = cvt_pk_bf16(s[0 * 33] * g0[0], s[1 * 33] * g0[1]); o.y = cvt_pk_bf16(s[2 * 33] * g0[2], s[3 * 33] * g0[3]); o.z = cvt_pk_bf16(s[4 * 33] * g1[0], s[5 * 33] * g1[1]); o.w = cvt_pk_bf16(s[6 * 33] * g1[2], s[7 * 33] * g1[3]);
        *(u32x4*)(WT + (size_t)(nd0 + n) * K + k0 + 8 * c) = o; }
    asm volatile("s_waitcnt lgkmcnt(0)" ::: "memory");
}
__device__ __forceinline__ void convert_phase(CArgs* ap, int l, LAS unsigned char* lds, int gw, int NGW, int wave, int lane) {
    LAS float* scr = (LAS float*)(lds + wave * 8448);
    {
        unsigned char* wb = ap->ws + WS_W;
#pragma unroll 1
        for (int mi = 0; mi < 8; ++mi) {
            const float* W; int K, N; size_t off;
            switch (mi) {
                case 0: W = ap->in[2] + (size_t)l * D * INW; K = D; N = INW; off = O_WIN; break;
                case 1: W = ap->in[21] + (size_t)l * 1024 * D; K = 1024; N = D; off = O_WA; break;
                case 2: W = ap->in[22] + (size_t)l * 512 * D; K = 512; N = D; off = O_WSG; break;
                case 3: W = ap->in[23] + (size_t)l * 512 * D; K = 512; N = D; off = O_WSSM; break;
                case 4: W = ap->in[24] + (size_t)l * D * D; K = D; N = D; off = O_WOUT; break;
                case 5: W = ap->in[26] + (size_t)l * D * NUP; K = D; N = NUP; off = O_WUP; break;
                case 6: W = ap->in[29] + (size_t)l * DFF * D; K = DFF; N = D; off = O_WDN; break;
                default: W = ap->in[19] + (size_t)l * 512 * 512; K = 512; N = 512; off = O_WGLU; break;
            }
            const int nitems = (K / 64) * (N / 32);
            const float* gain = mi == 0 ? ap->in[1] + l * D : (mi == 5 ? ap->in[25] + l * D : nullptr);
            float wc[32], wn[32];
            int it = gw;
            if (it < nitems) titem_load(W, N, it, lane, wc);
            while (it < nitems) {
                const int nx = it + NGW;
                if (nx < nitems) titem_load(W, N, nx, lane, wn);
                titem_finish(wc, K, N, (bf16_t*)(wb + off), scr, it, lane, mi == 5, gain);
#pragma unroll
                for (int i = 0; i < 32; ++i) wc[i] = wn[i];
                it = nx;
            }
        }
    }
}

__device__ __forceinline__ void xb_phase(const float* x, bf16_t* XB, float* SS, int gw, int NGW, int lane) {
    for (int m = 2 * gw; m < M; m += 2 * NGW) {
        const f32x4* xr0 = (const f32x4*)(x + (size_t)m * D) + lane; const f32x4* xr1 = xr0 + D / 4;
        f32x4 v0[8], v1[8]; float s0 = 0.f, s1 = 0.f;
#pragma unroll
        for (int j = 0; j < 8; ++j) { v0[j] = __builtin_nontemporal_load(xr0 + 64 * j); v1[j] = __builtin_nontemporal_load(xr1 + 64 * j); }
#pragma unroll
        for (int j = 0; j < 8; ++j) { s0 += (v0[j][0] * v0[j][0] + v0[j][1] * v0[j][1]) + (v0[j][2] * v0[j][2] + v0[j][3] * v0[j][3]); s1 += (v1[j][0] * v1[j][0] + v1[j][1] * v1[j][1]) + (v1[j][2] * v1[j][2] + v1[j][3] * v1[j][3]); }
        s0 = wave_sum(s0); s1 = wave_sum(s1);
        if (lane == 0) { SS[m] = s0; SS[m + 1] = s1; }
        u32x2* o0 = (u32x2*)(XB + (size_t)m * D) + lane; u32x2* o1 = o0 + D / 4;
#pragma unroll
        for (int j = 0; j < 8; ++j) { u32x2 w; w.x = cvt_pk_bf16(v0[j][0], v0[j][1]); w.y = cvt_pk_bf16(v0[j][2], v0[j][3]); o0[64 * j] = w; w.x = cvt_pk_bf16(v1[j][0], v1[j][1]); w.y = cvt_pk_bf16(v1[j][2], v1[j][3]); o1[64 * j] = w; }
    }
}

__device__ __forceinline__ bf16x8 as_bf8(u32x4 w) { return __builtin_bit_cast(bf16x8, w); }

__device__ __forceinline__ void attn_unit(LAS unsigned char* lds, const bf16_t* PROJ, bf16_t* YCAT, const float* qg, const float* kg, const float* sinks, int unit, int tid, int wave, int lane) {
    const int kvh = unit & 1, blk = (unit >> 1) & 63, b = unit >> 7;
    const int t0 = b * SEQ + blk * 128;
    LAS bf16_t* Ks = (LAS bf16_t*)lds; LAS bf16_t* Vt = (LAS bf16_t*)(lds + 69632);
    {
        const int c16 = tid & 15;
        const f32x4 g0 = *(const f32x4*)(kg + 8 * c16), g1 = *(const f32x4*)(kg + 8 * c16 + 4);
#pragma unroll 2
        for (int pass = 0; pass < 8; ++pass) {
            const int kidx = (tid >> 4) + 32 * pass;
            u32x4 w = {0u, 0u, 0u, 0u};
            if (!(blk == 0 && pass < 4)) w = *(const u32x4*)(PROJ + (size_t)(t0 - 128 + kidx) * INW + 1024 + kvh * 128 + 8 * c16);
            f32x4 v0, v1; pg8::unpack8(w, v0, v1);
            float ss = (v0[0] * v0[0] + v0[1] * v0[1]) + (v0[2] * v0[2] + v0[3] * v0[3]) + (v1[0] * v1[0] + v1[1] * v1[1]) + (v1[2] * v1[2] + v1[3] * v1[3]);
            ss += __shfl_xor(ss, 1); ss += __shfl_xor(ss, 2); ss += __shfl_xor(ss, 4); ss += __shfl_xor(ss, 8);
            const float rs = rsqrtf(ss * (1.f / 128.f) + EPS);
            *(LAS u32x4*)(Ks + kidx * 136 + 8 * c16) = pg8::pack8(v0 * rs * g0, v1 * rs * g1);
        }
    }
    {
#pragma unroll 1
        for (int rg = 0; rg < 4; ++rg) {
            const int kidx = 64 * rg + lane, kk = kidx & 31, pos = (kidx & ~31) + 8 * ((kk >> 2) & 3) + 4 * (kk >> 4) + (kk & 3);
#pragma unroll
            for (int cc = 0; cc < 2; ++cc) {
                const int c16 = 2 * wave + cc;
                u32x4 w = {0u, 0u, 0u, 0u};
                if (!(blk == 0 && rg < 2)) w = *(const u32x4*)(PROJ + (size_t)(t0 - 128 + kidx) * INW + 1280 + kvh * 128 + 8 * c16);
                LAS bf16_t* d = Vt + (8 * c16) * 264 + pos;
                d[0 * 264] = (bf16_t)(w.x & 0xffffu); d[1 * 264] = (bf16_t)(w.x >> 16); d[2 * 264] = (bf16_t)(w.y & 0xffffu); d[3 * 264] = (bf16_t)(w.y >> 16);
                d[4 * 264] = (bf16_t)(w.z & 0xffffu); d[5 * 264] = (bf16_t)(w.z >> 16); d[6 * 264] = (bf16_t)(w.w & 0xffffu); d[7 * 264] = (bf16_t)(w.w >> 16);
            }
        }
    }
    __syncthreads();
    const int fr = lane & 15, fq = lane >> 4, qrow = 16 * wave + fr;
#pragma unroll 1
    for (int hq = 4 * kvh; hq < 4 * kvh + 4; ++hq) {
    bf16x8 qf[4];
    {
        const bf16_t* qp = PROJ + (size_t)(t0 + qrow) * INW + hq * 128 + 8 * fq;
        u32x4 w[4]; float ss = 0.f;
#pragma unroll
        for (int ks = 0; ks < 4; ++ks) { w[ks] = *(const u32x4*)(qp + 32 * ks); f32x4 v0, v1; pg8::unpack8(w[ks], v0, v1);
            ss += (v0[0] * v0[0] + v0[1] * v0[1]) + (v0[2] * v0[2] + v0[3] * v0[3]) + (v1[0] * v1[0] + v1[1] * v1[1]) + (v1[2] * v1[2] + v1[3] * v1[3]); }
        ss += __shfl_xor(ss, 16); ss += __shfl_xor(ss, 32);
        const float rs = rsqrtf(ss * (1.f / 128.f) + EPS) * 0.08838834764831845f;
#pragma unroll
        for (int ks = 0; ks < 4; ++ks) { f32x4 v0, v1; pg8::unpack8(w[ks], v0, v1);
            const f32x4 g0 = *(const f32x4*)(qg + 32 * ks + 8 * fq), g1 = *(const f32x4*)(qg + 32 * ks + 8 * fq + 4);
            qf[ks] = as_bf8(pg8::pack8(v0 * rs * g0, v1 * rs * g1)); }
    }
    const int wp = wave & ~1;
    f32x4 s[10];
#pragma unroll
    for (int rel = 0; rel < 10; ++rel) {
        s[rel] = (f32x4){0.f, 0.f, 0.f, 0.f};
#pragma unroll
        for (int ks = 0; ks < 4; ++ks) {
            const bf16x8 kf = *(const LAS bf16x8*)(Ks + (16 * (wp + rel) + fr) * 136 + 32 * ks + 8 * fq);
            s[rel] = __builtin_amdgcn_mfma_f32_16x16x32_bf16(kf, qf[ks], s[rel], 0, 0, 0);
        }
    }
    const float slope = exp2f(-(float)(hq + 1)), sink = sinks[hq];
    const int qidx = 128 + qrow;
    float mx = -INFINITY;
#pragma unroll
    for (int rel = 0; rel < 10; ++rel)
#pragma unroll
        for (int i = 0; i < 4; ++i) {
            const int kidx = 16 * (wp + rel) + 4 * fq + i, dist = qidx - kidx;
            const bool valid = (dist >= 0) && (dist < 128) && (blk > 0 || kidx >= 128);
            const float val = valid ? s[rel][i] - slope * (float)dist : -INFINITY;
            s[rel][i] = val; mx = fmaxf(mx, val);
        }
    mx = fmaxf(mx, __shfl_xor(mx, 16)); mx = fmaxf(mx, __shfl_xor(mx, 32));
    const float mm = fmaxf(mx, sink);
    float ls = 0.f;
#pragma unroll
    for (int rel = 0; rel < 10; ++rel)
#pragma unroll
        for (int i = 0; i < 4; ++i) { const float p = __expf(s[rel][i] - mm); s[rel][i] = p; ls += p; }
    ls += __shfl_xor(ls, 16); ls += __shfl_xor(ls, 32);
    const float inv = 1.f / (ls + __expf(sink - mm));
    bf16x8 pf[5];
#pragma unroll
    for (int g = 0; g < 5; ++g) pf[g] = as_bf8(pg8::pack8(s[2 * g], s[2 * g + 1]));
    bf16_t* op = YCAT + (size_t)(t0 + qrow) * D + hq * 128 + 4 * fq;
#pragma unroll
    for (int db = 0; db < 8; ++db) {
        f32x4 o = (f32x4){0.f, 0.f, 0.f, 0.f};
#pragma unroll
        for (int g = 0; g < 5; ++g) {
            const bf16x8 vf = *(const LAS bf16x8*)(Vt + (16 * db + fr) * 264 + 32 * ((wp >> 1) + g) + 8 * fq);
            o = __builtin_amdgcn_mfma_f32_16x16x32_bf16(vf, pf[g], o, 0, 0, 0);
        }
        u32x2 w; w.x = cvt_pk_bf16(o[0] * inv, o[1] * inv); w.y = cvt_pk_bf16(o[2] * inv, o[3] * inv);
        *(u32x2*)(op + 16 * db) = w;
    }
    }
    __syncthreads();
}

__device__ __forceinline__ void sg_unit(LAS unsigned char* lds, const bf16_t* PROJ, bf16_t* YCAT, const float* lng, const float* lnb, const float* sgw, const float* sgb, int unit, int tid, int wave, int lane) {
    const int g = unit & 3, ch = (unit >> 2) & 63, b = unit >> 8;
    const int t0 = b * SEQ + ch * 128;
    LAS bf16_t* Zt = (LAS bf16_t*)lds; LAS float* st = (LAS float*)(lds + 34816);
    const bf16_t* zv = PROJ + (size_t)t0 * INW + 2048 + g * 128;
    {
        const int c16 = tid & 15;
#pragma unroll
        for (int pass = 0; pass < 4; ++pass) {
            const int r = (tid >> 4) + 32 * pass;
            f32x4 v0, v1; pg8::unpack8(*(const u32x4*)(zv + (size_t)r * INW + 8 * c16), v0, v1);
            float sm = (v0[0] + v0[1]) + (v0[2] + v0[3]) + (v1[0] + v1[1]) + (v1[2] + v1[3]);
            sm += __shfl_xor(sm, 1); sm += __shfl_xor(sm, 2); sm += __shfl_xor(sm, 4); sm += __shfl_xor(sm, 8);
            const float mean = sm * (1.f / 128.f);
            v0 = v0 - mean; v1 = v1 - mean;
            float q = (v0[0] * v0[0] + v0[1] * v0[1]) + (v0[2] * v0[2] + v0[3] * v0[3]) + (v1[0] * v1[0] + v1[1] * v1[1]) + (v1[2] * v1[2] + v1[3] * v1[3]);
            q += __shfl_xor(q, 1); q += __shfl_xor(q, 2); q += __shfl_xor(q, 4); q += __shfl_xor(q, 8);
            if (c16 == 0) { st[2 * r] = mean; st[2 * r + 1] = rsqrtf(q * (1.f / 128.f) + EPS); }
        }
    }
    __syncthreads();
#pragma unroll 1
    for (int rg = 0; rg < 2; ++rg) {
        const int r = 64 * rg + lane; const float mean = st[2 * r], rstd = st[2 * r + 1];
#pragma unroll
        for (int cc = 0; cc < 2; ++cc) {
            const int c16 = 2 * wave + cc;
            f32x4 v0, v1; pg8::unpack8(*(const u32x4*)(zv + (size_t)r * INW + 8 * c16), v0, v1);
            const f32x4 a0 = *(const f32x4*)(lng + g * 128 + 8 * c16), a1 = *(const f32x4*)(lng + g * 128 + 8 * c16 + 4);
            const f32x4 b0 = *(const f32x4*)(lnb + g * 128 + 8 * c16), b1 = *(const f32x4*)(lnb + g * 128 + 8 * c16 + 4);
            v0 = (v0 - mean) * rstd * a0 + b0; v1 = (v1 - mean) * rstd * a1 + b1;
            LAS bf16_t* d = Zt + (8 * c16) * 136 + r;
            d[0 * 136] = (bf16_t)f2bf(v0[0]); d[1 * 136] = (bf16_t)f2bf(v0[1]); d[2 * 136] = (bf16_t)f2bf(v0[2]); d[3 * 136] = (bf16_t)f2bf(v0[3]);
            d[4 * 136] = (bf16_t)f2bf(v1[0]); d[5 * 136] = (bf16_t)f2bf(v1[1]); d[6 * 136] = (bf16_t)f2bf(v1[2]); d[7 * 136] = (bf16_t)f2bf(v1[3]);
        }
    }
    __syncthreads();
    const int fr = lane & 15, fq = lane >> 4, t = 16 * wave + fr, nks = (wave >> 1) + 1;
    bf16x8 wf[4];
#pragma unroll
    for (int ks = 0; ks < 4; ++ks) {
        u32x4 w = {0u, 0u, 0u, 0u};
        if (ks < nks) {
            const float* wp = sgw + ((size_t)(g * 128 + t)) * 128 + 32 * ks + 8 * fq;
            f32x4 a0 = *(const f32x4*)wp, a1 = *(const f32x4*)(wp + 4);
            const int s0 = 32 * ks + 8 * fq;
#pragma unroll
            for (int i = 0; i < 4; ++i) { if (s0 + i > t) a0[i] = 0.f; if (s0 + 4 + i > t) a1[i] = 0.f; }
            w = pg8::pack8(a0, a1);
        }
        wf[ks] = as_bf8(w);
    }
    const float bs = sgb[g * 128 + t];
    const bf16_t* zu = PROJ + (size_t)(t0 + t) * INW + 1536 + g * 128 + 4 * fq;
    bf16_t* op = YCAT + (size_t)(t0 + t) * D + 1024 + g * 128 + 4 * fq;
#pragma unroll
    for (int cb = 0; cb < 8; ++cb) {
        f32x4 acc = (f32x4){0.f, 0.f, 0.f, 0.f};
#pragma unroll
        for (int ks = 0; ks < 4; ++ks) if (ks < nks) {
            const bf16x8 zf = *(const LAS bf16x8*)(Zt + (16 * cb + fr) * 136 + 32 * ks + 8 * fq);
            acc = __builtin_amdgcn_mfma_f32_16x16x32_bf16(zf, wf[ks], acc, 0, 0, 0);
        }
        const u32x2 zw = *(const u32x2*)(zu + 16 * cb);
        u32x2 w; w.x = cvt_pk_bf16(bf_lo(zw.x) * (acc[0] + bs), bf_hi(zw.x) * (acc[1] + bs)); w.y = cvt_pk_bf16(bf_lo(zw.y) * (acc[2] + bs), bf_hi(zw.y) * (acc[3] + bs));
        *(u32x2*)(op + 16 * cb) = w;
    }
    __syncthreads();
}

template <bool P3> __device__ __forceinline__ void ssm_unit(CArgs* ap, const float* COEF, int l, const bf16_t* PROJ, float* SST, bf16_t* YS, LAS unsigned char* wlds, int unit, int lane) {
    const int c = unit & 63, g = (unit >> 6) & 31, b = unit >> 11;
    const int fr = lane & 15, fq = lane >> 4;
    float pr[4][4], pi[4][4]; bf16x8 bfr[8];
#pragma unroll
    for (int cb = 0; cb < 4; ++cb) {
        const int gp = (l * 32 + g) * 64 + 16 * cb + fr;
        const f32x4 cf = *(const f32x4*)(COEF + (size_t)(g * 64 + 16 * cb + fr) * 4);
        const float abr = cf[0], abi = cf[1];
        pr[cb][0] = abr; pi[cb][0] = abi;
#pragma unroll
        for (int i = 1; i < 4; ++i) { pr[cb][i] = pr[cb][i - 1] * abr - pi[cb][i - 1] * abi; pi[cb][i] = pr[cb][i - 1] * abi + pi[cb][i - 1] * abr; }
        const float cr = cf[2], ci = cf[3];
        u32x4 wre = {0u, 0u, 0u, 0u}, wim = {0u, 0u, 0u, 0u};
        if (fq < 2) {
            const float* br = ap->in[14] + (size_t)gp * 16 + 8 * fq; const float* bi = ap->in[15] + (size_t)gp * 16 + 8 * fq;
            const f32x4 r0 = *(const f32x4*)br, r1 = *(const f32x4*)(br + 4), i0 = *(const f32x4*)bi, i1 = *(const f32x4*)(bi + 4);
            wre = pg8::pack8(cr * r0 - ci * i0, cr * r1 - ci * i1); wim = pg8::pack8(cr * i0 + ci * r0, cr * i1 + ci * r1);
        }
        bfr[cb] = as_bf8(wre); bfr[cb + 4] = as_bf8(wim);
    }
    bf16x8 cmf[4]; float dsk = 0.f;
    if (P3) {
#pragma unroll
        for (int ks = 0; ks < 4; ++ks) {
            const int k0 = 32 * ks + 8 * fq;
            const float* src = (ks < 2 ? ap->in[16] : ap->in[17]) + ((size_t)(l * 32 + g) * 16 + fr) * 64 + (ks < 2 ? k0 : k0 - 64);
            f32x4 c0 = *(const f32x4*)src, c1 = *(const f32x4*)(src + 4);
            if (ks >= 2) { c0 = -c0; c1 = -c1; }
            cmf[ks] = as_bf8(pg8::pack8(c0, c1));
        }
        dsk = ap->in[18][l * 512 + g * 16 + fr];
    }
    float hr[4], hi[4];
#pragma unroll
    for (int cb = 0; cb < 4; ++cb) { hr[cb] = 0.f; hi[cb] = 0.f; }
    if (P3) {
        float tr[4], ti[4];
#pragma unroll
        for (int cb = 0; cb < 4; ++cb) { tr[cb] = pr[cb][3]; ti[cb] = pi[cb][3];
#pragma unroll
            for (int k = 0; k < 5; ++k) { const float nr = tr[cb] * tr[cb] - ti[cb] * ti[cb], ni = 2.f * tr[cb] * ti[cb]; tr[cb] = nr; ti[cb] = ni; } }
        const float* sp = SST + ((size_t)(unit - c) * 64 + fr) * 2;
        for (int cc = 0; cc < c; ++cc) {
#pragma unroll
            for (int cb = 0; cb < 4; ++cb) { const float2 s = *(const float2*)(sp + (size_t)cc * 128 + 32 * cb);
                const float nr = tr[cb] * hr[cb] - ti[cb] * hi[cb] + s.x, ni = tr[cb] * hi[cb] + ti[cb] * hr[cb] + s.y; hr[cb] = nr; hi[cb] = ni; }
        }
    }
    const size_t row0 = (size_t)(b * SEQ + c * 128);
    LAS bf16_t* Hs = (LAS bf16_t*)wlds;
    u32x4 uwn = {0u, 0u, 0u, 0u};
    if (fq < 2) uwn = *(const u32x4*)(PROJ + (row0 + fr) * INW + 2560 + g * 16 + 8 * fq);
#pragma unroll 1
    for (int blk = 0; blk < 8; ++blk) {
        const u32x4 uw = uwn;
        if (fq < 2) uwn = *(const u32x4*)(PROJ + (row0 + 16 * (blk < 7 ? blk + 1 : blk) + fr) * INW + 2560 + g * 16 + 8 * fq);
        const bf16x8 uf = as_bf8(uw);
        f32x4 bu[8];
#pragma unroll
        for (int k = 0; k < 8; ++k) bu[k] = __builtin_amdgcn_mfma_f32_16x16x32_bf16(uf, bfr[k], (f32x4){0.f, 0.f, 0.f, 0.f}, 0, 0, 0);
#pragma unroll
        for (int cb = 0; cb < 4; ++cb) {
            const float ar = pr[cb][0], ai = pi[cb][0], a4r = pr[cb][3], a4i = pi[cb][3];
            float lr_[4], li_[4];
            lr_[0] = bu[cb][0]; li_[0] = bu[cb + 4][0];
#pragma unroll
            for (int i = 1; i < 4; ++i) { lr_[i] = ar * lr_[i - 1] - ai * li_[i - 1] + bu[cb][i]; li_[i] = ar * li_[i - 1] + ai * lr_[i - 1] + bu[cb + 4][i]; }
            float cr = hr[cb], ci = hi[cb];
#pragma unroll
            for (int j = 0; j < 3; ++j) {
                const float er = __shfl(lr_[3], fr + 16 * j), ei = __shfl(li_[3], fr + 16 * j);
                const float nr = a4r * cr - a4i * ci + er, ni = a4r * ci + a4i * cr + ei;
                if (j < fq) { cr = nr; ci = ni; }
            }
            float h_r[4], h_i[4];
#pragma unroll
            for (int i = 0; i < 4; ++i) { h_r[i] = lr_[i] + pr[cb][i] * cr - pi[cb][i] * ci; h_i[i] = li_[i] + pr[cb][i] * ci + pi[cb][i] * cr; }
            hr[cb] = __shfl(h_r[3], fr + 48); hi[cb] = __shfl(h_i[3], fr + 48);
            if (P3) {
#pragma unroll
                for (int i = 0; i < 4; ++i) { Hs[(4 * fq + i) * 136 + 16 * cb + fr] = (bf16_t)f2bf(h_r[i]); Hs[(4 * fq + i) * 136 + 64 + 16 * cb + fr] = (bf16_t)f2bf(h_i[i]); }
            }
        }
        if (P3) {
            f32x4 y = (f32x4){0.f, 0.f, 0.f, 0.f};
            asm volatile("s_waitcnt lgkmcnt(0)" ::: "memory");
            bf16x8 hf[4];
#pragma unroll
            for (int ks = 0; ks < 4; ++ks) hf[ks] = *(const LAS bf16x8*)(Hs + fr * 136 + 32 * ks + 8 * fq);
            asm volatile("s_waitcnt lgkmcnt(0)" ::: "memory");
#pragma unroll
            for (int ks = 0; ks < 4; ++ks) y = __builtin_amdgcn_mfma_f32_16x16x32_bf16(hf[ks], cmf[ks], y, 0, 0, 0);
#pragma unroll
            for (int i = 0; i < 4; ++i) {
                const size_t row = row0 + 16 * blk + 4 * fq + i;
                const float uu = __uint_as_float(((unsigned)PROJ[row * INW + 2560 + g * 16 + fr]) << 16);
                YS[row * 512 + g * 16 + fr] = (bf16_t)f2bf(gelu_t(y[i] + dsk * uu));
            }
        }
    }
    if (!P3) { if (fq == 0) {
#pragma unroll
        for (int cb = 0; cb < 4; ++cb) *(float2*)(SST + ((size_t)unit * 64 + 16 * cb + fr) * 2) = make_float2(hr[cb], hi[cb]); } }
}

__device__ __forceinline__ void ssm_coef_phase(CArgs* ap, int l, float* COEF, int gw, int lane) {
    if (gw < 32) {
        const int g = gw, p = lane;
        const float dt = expf(ap->in[13][l * 32 + g]);
        const float lr = ap->in[11][(l * 32 + g) * 64 + p], li = ap->in[12][(l * 32 + g) * 64 + p];
        const float x = lr * dt, y = li * dt;
        const float ex = expf(x), cs = cosf(y), sn = sinf(y), sh = sinf(0.5f * y);
        const float abr = ex * cs, abi = ex * sn;
        const float nr = expm1f(x) * cs - 2.f * sh * sh, ni = abi;
        const float den = 1.f / (lr * lr + li * li);
        *(f32x4*)(COEF + (size_t)(g * 64 + p) * 4) = (f32x4){abr, abi, (nr * lr + ni * li) * den, (ni * lr - nr * li) * den};
    }
}
__device__ __forceinline__ void ssm_setup(CArgs* ap, const float* COEF, int l, int g, int p, float& abr, float& abi, float (&bbr)[16], float (&bbi)[16]) {
    const f32x4 cf = *(const f32x4*)(COEF + (size_t)(g * 64 + p) * 4);
    abr = cf[0]; abi = cf[1];
    const float cr = cf[2], ci = cf[3];
    const float* br = ap->in[14] + ((size_t)(l * 32 + g) * 64 + p) * 16; const float* bi = ap->in[15] + ((size_t)(l * 32 + g) * 64 + p) * 16;
#pragma unroll
    for (int q = 0; q < 4; ++q) { const f32x4 r4 = *(const f32x4*)(br + 4 * q), i4 = *(const f32x4*)(bi + 4 * q);
#pragma unroll
        for (int i = 0; i < 4; ++i) { bbr[4 * q + i] = cr * r4[i] - ci * i4[i]; bbi[4 * q + i] = cr * i4[i] + ci * r4[i]; } }
}
__device__ __forceinline__ void load_u16(const bf16_t* p, float (&u)[16]) {
    const u32x4 w0 = ((const u32x4*)p)[0], w1 = ((const u32x4*)p)[1];
    u[0] = bf_lo(w0.x); u[1] = bf_hi(w0.x); u[2] = bf_lo(w0.y); u[3] = bf_hi(w0.y); u[4] = bf_lo(w0.z); u[5] = bf_hi(w0.z); u[6] = bf_lo(w0.w); u[7] = bf_hi(w0.w);
    u[8] = bf_lo(w1.x); u[9] = bf_hi(w1.x); u[10] = bf_lo(w1.y); u[11] = bf_hi(w1.y); u[12] = bf_lo(w1.z); u[13] = bf_hi(w1.z); u[14] = bf_lo(w1.w); u[15] = bf_hi(w1.w);
}
__device__ __forceinline__ void ssm_pass1(CArgs* ap, const float* COEF, int l, const bf16_t* PROJ, float* SST, int unit, int lane) {
    const int c = unit & 63, g = (unit >> 6) & 31, b = unit >> 11;
    float abr, abi, bbr[16], bbi[16];
    ssm_setup(ap, COEF, l, g, lane, abr, abi, bbr, bbi);
    const bf16_t* up = PROJ + (size_t)(b * SEQ + c * 128) * INW + 2560 + g * 16;
    float hr = 0.f, hi = 0.f;
#pragma unroll 4
    for (int t = 0; t < 128; ++t) {
        float u[16]; load_u16(up + (size_t)t * INW, u);
        float br = 0.f, bi = 0.f;
#pragma unroll
        for (int k = 0; k < 16; ++k) { br += bbr[k] * u[k]; bi += bbi[k] * u[k]; }
        const float nr = abr * hr - abi * hi + br, ni = abr * hi + abi * hr + bi; hr = nr; hi = ni;
    }
    *(float2*)(SST + ((size_t)unit * 64 + lane) * 2) = make_float2(hr, hi);
}
template <int HALFN> __device__ __forceinline__ void rs_stage(float (&v)[64], int lane) {
    if constexpr (HALFN == 32 || HALFN == 16) {
#pragma unroll
        for (int i = 0; i < HALFN; ++i) {
            float a = v[i], b = v[i + HALFN];
            if constexpr (HALFN == 32) asm volatile("s_nop 1\n\tv_permlane32_swap_b32 %0, %1" : "+v"(a), "+v"(b));
            else asm volatile("s_nop 1\n\tv_permlane16_swap_b32 %0, %1" : "+v"(a), "+v"(b));
            v[i] = a + b;
        }
    } else {
        const bool bit = (lane & HALFN) != 0;
#pragma unroll
        for (int i = 0; i < HALFN; ++i) { const float keep = bit ? v[i + HALFN] : v[i], send = bit ? v[i] : v[i + HALFN]; v[i] = keep + __shfl_xor(send, HALFN); }
    }
}
__device__ __forceinline__ void ssm_pass3(CArgs* ap, const float* COEF, int l, const bf16_t* PROJ, const float* SST, bf16_t* YS, int unit, int lane) {
    const int c = unit & 63, g = (unit >> 6) & 31, b = unit >> 11;
    float abr, abi, bbr[16], bbi[16];
    ssm_setup(ap, COEF, l, g, lane, abr, abi, bbr, bbi);
    typedef float f32x2v __attribute__((ext_vector_type(2)));
    f32x2v cre2[8], cim2[8], bb2[16];
#pragma unroll
    for (int k = 0; k < 8; ++k) { cre2[k] = (f32x2v){ap->in[16][((size_t)(l * 32 + g) * 16 + 2 * k) * 64 + lane], ap->in[16][((size_t)(l * 32 + g) * 16 + 2 * k + 1) * 64 + lane]};
        cim2[k] = (f32x2v){ap->in[17][((size_t)(l * 32 + g) * 16 + 2 * k) * 64 + lane], ap->in[17][((size_t)(l * 32 + g) * 16 + 2 * k + 1) * 64 + lane]}; }
#pragma unroll
    for (int k = 0; k < 16; ++k) bb2[k] = (f32x2v){bbr[k], bbi[k]};
    const float dsk = ap->in[18][l * 512 + g * 16 + (lane & 15)];
    float tr = abr, ti = abi;
#pragma unroll
    for (int k = 0; k < 7; ++k) { const float nr = tr * tr - ti * ti, ni = 2.f * tr * ti; tr = nr; ti = ni; }
    float hr = 0.f, hi = 0.f;
    const float* sp = SST + ((size_t)(unit - c) * 64 + lane) * 2;
    int cc = 0;
    for (; cc + 8 <= c; cc += 8) {
        float2 s8[8];
#pragma unroll
        for (int j = 0; j < 8; ++j) s8[j] = *(const float2*)(sp + (size_t)(cc + j) * 128);
#pragma unroll
        for (int j = 0; j < 8; ++j) { const float nr = tr * hr - ti * hi + s8[j].x, ni = tr * hi + ti * hr + s8[j].y; hr = nr; hi = ni; }
    }
    for (; cc < c; ++cc) { const float2 s = *(const float2*)(sp + (size_t)cc * 128); const float nr = tr * hr - ti * hi + s.x, ni = tr * hi + ti * hr + s.y; hr = nr; hi = ni; }
    const size_t row0 = (size_t)(b * SEQ + c * 128);
    const bf16_t* up = PROJ + row0 * INW + 2560 + g * 16;
    u32x4 wn[8];
#pragma unroll
    for (int tt = 0; tt < 4; ++tt) { wn[2 * tt] = ((const u32x4*)(up + (size_t)tt * INW))[0]; wn[2 * tt + 1] = ((const u32x4*)(up + (size_t)tt * INW))[1]; }
    const int ott = lane >> 4, ok = lane & 15;
    unsigned short uun = up[(size_t)ott * INW + ok];
#pragma unroll 1
    for (int t = 0; t < 128; t += 4) {
        float v[64];
        u32x4 wc[8];
#pragma unroll
        for (int j = 0; j < 8; ++j) wc[j] = wn[j];
        const unsigned short uuc = uun;
        const int tn = (t + 4 < 128) ? t + 4 : t;
#pragma unroll
        for (int tt = 0; tt < 4; ++tt) { wn[2 * tt] = ((const u32x4*)(up + (size_t)(tn + tt) * INW))[0]; wn[2 * tt + 1] = ((const u32x4*)(up + (size_t)(tn + tt) * INW))[1]; }
        uun = up[(size_t)(tn + ott) * INW + ok];
#pragma unroll
        for (int tt = 0; tt < 4; ++tt) {
            const u32x4 w0 = wc[2 * tt], w1 = wc[2 * tt + 1];
            float u[16];
            u[0] = bf_lo(w0.x); u[1] = bf_hi(w0.x); u[2] = bf_lo(w0.y); u[3] = bf_hi(w0.y); u[4] = bf_lo(w0.z); u[5] = bf_hi(w0.z); u[6] = bf_lo(w0.w); u[7] = bf_hi(w0.w);
            u[8] = bf_lo(w1.x); u[9] = bf_hi(w1.x); u[10] = bf_lo(w1.y); u[11] = bf_hi(w1.y); u[12] = bf_lo(w1.z); u[13] = bf_hi(w1.z); u[14] = bf_lo(w1.w); u[15] = bf_hi(w1.w);
            f32x2v b2 = (f32x2v){0.f, 0.f};
#pragma unroll
            for (int k = 0; k < 16; ++k) b2 += bb2[k] * u[k];
            const float nr = abr * hr - abi * hi + b2.x, ni = abr * hi + abi * hr + b2.y; hr = nr; hi = ni;
#pragma unroll
            for (int k = 0; k < 8; ++k) { const f32x2v p = cre2[k] * hr - cim2[k] * hi; v[tt * 16 + 2 * k] = p.x; v[tt * 16 + 2 * k + 1] = p.y; }
        }
        rs_stage<32>(v, lane); rs_stage<16>(v, lane); rs_stage<8>(v, lane); rs_stage<4>(v, lane); rs_stage<2>(v, lane); rs_stage<1>(v, lane);
        const float uu = __uint_as_float(((unsigned)uuc) << 16);
        const float y = gelu_t(v[0] + dsk * uu);
        YS[(row0 + t + ott) * 512 + g * 16 + ok] = (bf16_t)f2bf(y);
    }
}

__device__ __forceinline__ void ssm_pass3h(CArgs* ap, const float* COEF, int l, const bf16_t* PROJ, const float* SST, bf16_t* YS, LAS unsigned char* wlds, int unit, int lane) {
    const int c = unit & 63, g = (unit >> 6) & 31, b = unit >> 11;
    const int fr = lane & 15, fq = lane >> 4;
    float abr, abi, bbr[16], bbi[16];
    ssm_setup(ap, COEF, l, g, lane, abr, abi, bbr, bbi);
    typedef float f32x2v __attribute__((ext_vector_type(2)));
    f32x2v bb2[16];
#pragma unroll
    for (int k = 0; k < 16; ++k) bb2[k] = (f32x2v){bbr[k], bbi[k]};
    float cmB[32];
#pragma unroll
    for (int j = 0; j < 8; ++j) {
        const int k0 = 16 * j + 4 * fq;
        const float* src = (j < 4 ? ap->in[16] : ap->in[17]) + ((size_t)(l * 32 + g) * 16 + fr) * 64 + (j < 4 ? k0 : k0 - 64);
        const f32x4 c4 = *(const f32x4*)src;
#pragma unroll
        for (int r = 0; r < 4; ++r) cmB[4 * j + r] = (j < 4) ? c4[r] : -c4[r];
    }
    const float dsk = ap->in[18][l * 512 + g * 16 + fr];
    float tr = abr, ti = abi;
#pragma unroll
    for (int k = 0; k < 7; ++k) { const float nr = tr * tr - ti * ti, ni = 2.f * tr * ti; tr = nr; ti = ni; }
    float hr = 0.f, hi = 0.f;
    const float* sp = SST + ((size_t)(unit - c) * 64 + lane) * 2;
    int cc = 0;
    for (; cc + 8 <= c; cc += 8) {
        float2 s8[8];
#pragma unroll
        for (int j = 0; j < 8; ++j) s8[j] = *(const float2*)(sp + (size_t)(cc + j) * 128);
#pragma unroll
        for (int j = 0; j < 8; ++j) { const float nr = tr * hr - ti * hi + s8[j].x, ni = tr * hi + ti * hr + s8[j].y; hr = nr; hi = ni; }
    }
    for (; cc < c; ++cc) { const float2 s = *(const float2*)(sp + (size_t)cc * 128); const float nr = tr * hr - ti * hi + s.x, ni = tr * hi + ti * hr + s.y; hr = nr; hi = ni; }
    const size_t row0 = (size_t)(b * SEQ + c * 128);
    const bf16_t* up = PROJ + row0 * INW + 2560 + g * 16;
    LAS float* Hf = (LAS float*)wlds;
    u32x4 wn[8];
#pragma unroll
    for (int tt = 0; tt < 4; ++tt) { wn[2 * tt] = ((const u32x4*)(up + (size_t)tt * INW))[0]; wn[2 * tt + 1] = ((const u32x4*)(up + (size_t)tt * INW))[1]; }
#pragma unroll 1
    for (int blk = 0; blk < 8; ++blk) {
        unsigned short uq[4];
#pragma unroll
        for (int i = 0; i < 4; ++i) uq[i] = up[(size_t)(16 * blk + 4 * fq + i) * INW + fr];
#pragma unroll 1
        for (int q = 0; q < 4; ++q) {
            const int t = 16 * blk + 4 * q;
            u32x4 wc[8];
#pragma unroll
            for (int j = 0; j < 8; ++j) wc[j] = wn[j];
            const int tn = (t + 4 < 128) ? t + 4 : t;
#pragma unroll
            for (int tt = 0; tt < 4; ++tt) { wn[2 * tt] = ((const u32x4*)(up + (size_t)(tn + tt) * INW))[0]; wn[2 * tt + 1] = ((const u32x4*)(up + (size_t)(tn + tt) * INW))[1]; }
#pragma unroll
            for (int tt = 0; tt < 4; ++tt) {
                const u32x4 w0 = wc[2 * tt], w1 = wc[2 * tt + 1];
                float u[16];
                u[0] = bf_lo(w0.x); u[1] = bf_hi(w0.x); u[2] = bf_lo(w0.y); u[3] = bf_hi(w0.y); u[4] = bf_lo(w0.z); u[5] = bf_hi(w0.z); u[6] = bf_lo(w0.w); u[7] = bf_hi(w0.w);
                u[8] = bf_lo(w1.x); u[9] = bf_hi(w1.x); u[10] = bf_lo(w1.y); u[11] = bf_hi(w1.y); u[12] = bf_lo(w1.z); u[13] = bf_hi(w1.z); u[14] = bf_lo(w1.w); u[15] = bf_hi(w1.w);
                f32x2v b2 = (f32x2v){0.f, 0.f};
#pragma unroll
                for (int k = 0; k < 16; ++k) b2 += bb2[k] * u[k];
                const float nr = abr * hr - abi * hi + b2.x, ni = abr * hi + abi * hr + b2.y; hr = nr; hi = ni;
                Hf[(4 * q + tt) * 132 + lane] = hr; Hf[(4 * q + tt) * 132 + 64 + lane] = hi;
            }
        }
        asm volatile("s_waitcnt lgkmcnt(0)" ::: "memory");
        f32x4 y = (f32x4){0.f, 0.f, 0.f, 0.f};
#pragma unroll
        for (int j = 0; j < 8; ++j) {
            const f32x4 a4 = *(const LAS f32x4*)(Hf + fr * 132 + 16 * j + 4 * fq);
#pragma unroll
            for (int r = 0; r < 4; ++r) y = __builtin_amdgcn_mfma_f32_16x16x4f32(a4[r], cmB[4 * j + r], y, 0, 0, 0);
        }
        asm volatile("s_waitcnt lgkmcnt(0)" ::: "memory");
#pragma unroll
        for (int i = 0; i < 4; ++i) {
            const size_t row = row0 + 16 * blk + 4 * fq + i;
            YS[row * 512 + g * 16 + fr] = (bf16_t)f2bf(gelu_t(y[i] + dsk * __uint_as_float(((unsigned)uq[i]) << 16)));
        }
    }
}

__device__ __forceinline__ void fixup_phase(const float* RAW, bf16_t* ACT, const float* cw, const float* cb, int gtid, int nthr) {
    constexpr int NC4 = DFF / 4;
    for (int it = gtid; it < 256 * 2 * NC4; it += nthr) {
        const int c = (it % NC4) * 4, r = (it / NC4) & 1, sl = it / (2 * NC4);
        const int tc = (c >> 7) * 256 + (c & 127);
        const float* base = RAW + (size_t)sl * 4 * NUP + tc; const float* prev = base - (size_t)4 * NUP;
        const bool first = (sl & 127) == 0;
        const f32x4 z = (f32x4){0.f, 0.f, 0.f, 0.f};
        const f32x4 g0 = *(const f32x4*)(base + (size_t)r * NUP), v0 = *(const f32x4*)(base + (size_t)r * NUP + 128);
        const f32x4 g63 = first ? z : *(const f32x4*)(prev + (size_t)3 * NUP), v63 = first ? z : *(const f32x4*)(prev + (size_t)3 * NUP + 128);
        f32x4 g1, g2, v1, v2;
        if (r == 1) { g1 = *(const f32x4*)base; v1 = *(const f32x4*)(base + 128); g2 = g63; v2 = v63; }
        else { g1 = g63; v1 = v63; g2 = first ? z : *(const f32x4*)(prev + (size_t)2 * NUP); v2 = first ? z : *(const f32x4*)(prev + (size_t)2 * NUP + 128); }
        const f32x4 cgt = *(const f32x4*)(cb + c) + *(const f32x4*)(cw + c) * g0 + *(const f32x4*)(cw + NUP + c) * g1 + *(const f32x4*)(cw + 2 * NUP + c) * g2;
        const f32x4 cvl = *(const f32x4*)(cb + DFF + c) + *(const f32x4*)(cw + DFF + c) * v0 + *(const f32x4*)(cw + NUP + DFF + c) * v1 + *(const f32x4*)(cw + 2 * NUP + DFF + c) * v2;
        const f32x4 o = pg8::gelu4(cgt) * cvl;
        u32x2 w; w.x = cvt_pk_bf16(o[0], o[1]); w.y = cvt_pk_bf16(o[2], o[3]);
        *(u32x2*)(ACT + (size_t)(64 * sl + r) * DFF + c) = w;
    }
}

#define XB_TMO      128
#define XB_XCNT(j)  (256  + 64 * (j))
#define XB_XSUB(j)  (1280 + 64 * (j))
#define XB_XGEN(j)  (2304 + 64 * (j))
#define XB_TOP      3328
#define XB_TOPGEN   3392
#define XCD_BAR_WORDS 3456
#define XB_SPIN_CAP (1u << 18)

__device__ __forceinline__ unsigned xb_ld(unsigned* p)              { return __hip_atomic_load(p, __ATOMIC_RELAXED, __HIP_MEMORY_SCOPE_AGENT); }
__device__ __forceinline__ unsigned xb_add(unsigned* p, unsigned v) { return __hip_atomic_fetch_add(p, v, __ATOMIC_RELAXED, __HIP_MEMORY_SCOPE_AGENT); }
__device__ __forceinline__ unsigned xb_xcc_id() { return (unsigned)__builtin_amdgcn_s_getreg((3 << 11) | 20) & 0xFu; }
#define XB_SPIN(cond, bar) do { unsigned _sp = 0; while (cond) { __builtin_amdgcn_s_sleep(1); \
    if ((++_sp & 255u) == 0u) { if (xb_ld(&(bar)[XB_TMO])) break; if (_sp > XB_SPIN_CAP) { atomicAdd(&(bar)[XB_TMO], 1u); break; } } } } while (0)

struct XcdBarrier {
    unsigned* bar; unsigned x;
    volatile LAS unsigned* st;
};

__device__ __forceinline__ XcdBarrier xcd_barrier_post(unsigned* bar, volatile LAS unsigned* st) {
    XcdBarrier b; b.bar = bar; b.x = xb_xcc_id(); b.st = st;
    if (threadIdx.x == 0) (void)xb_add(&bar[XB_XCNT(b.x)], 1u);
    return b;
}
__device__ __forceinline__ void xcd_barrier_complete(unsigned* bar, unsigned x, unsigned& nloc, unsigned& nx) {
    const unsigned G = gridDim.x * gridDim.y * gridDim.z;
    unsigned sum, cnt, mine, sp = 0u;
    for (;;) {
        sum = 0u; cnt = 0u; mine = 0u;
#pragma unroll
        for (unsigned j = 0; j < 16; ++j) { const unsigned c = xb_ld(&bar[XB_XCNT(j)]); sum += c; cnt += (c > 0u) ? 1u : 0u; mine = (j == x) ? c : mine; }
        if (sum == G) break;
        __builtin_amdgcn_s_sleep(1);
        if ((++sp & 255u) == 0u) { if (xb_ld(&bar[XB_TMO])) break; if (sp > XB_SPIN_CAP) { atomicAdd(&bar[XB_TMO], 1u); break; } }
    }
    nloc = mine > 0u ? mine : 1u; nx = cnt > 0u ? cnt : 1u;
}

__device__ __forceinline__ void xcd_barrier(const XcdBarrier& b) {
    asm volatile("s_waitcnt vmcnt(0)" ::: "memory");
    __syncthreads();
    if (threadIdx.x == 0) {
        unsigned* bar = b.bar;
        __builtin_amdgcn_s_waitcnt(0);
        unsigned nloc = b.st[0], nx = b.st[1];
        if (nloc == 0u) { xcd_barrier_complete(bar, b.x, nloc, nx); b.st[0] = nloc; b.st[1] = nx; }
        const unsigned old = xb_add(&bar[XB_XSUB(b.x)], 1u);
        const unsigned gen = old / nloc;
        if (old + 1u == (gen + 1u) * nloc) {
            __builtin_amdgcn_fence(__ATOMIC_RELEASE, "agent");
            asm volatile("s_waitcnt vmcnt(0)" ::: "memory");
            const unsigned og = xb_add(&bar[XB_TOP], 1u);
            const unsigned tg = og / nx;
            if (og + 1u == (tg + 1u) * nx) xb_add(&bar[XB_TOPGEN], 1u);
            else XB_SPIN(xb_ld(&bar[XB_TOPGEN]) == tg, bar);
            __builtin_amdgcn_fence(__ATOMIC_ACQUIRE, "agent");
            xb_add(&bar[XB_XGEN(b.x)], 1u);
            asm volatile("s_waitcnt vmcnt(0)" ::: "memory");
        } else {
            XB_SPIN(xb_ld(&bar[XB_XGEN(b.x)]) == gen, bar);
            __builtin_amdgcn_fence(__ATOMIC_ACQUIRE, "agent");
            asm volatile("s_waitcnt vmcnt(0)" ::: "memory");
        }
    }
    __syncthreads();
}

#ifdef ONLY_MODE
#define ONLY_MODE_OK(m) ((m) == ONLY_MODE)
#else
#define ONLY_MODE_OK(m) true
#endif
#ifndef PG8_SP2
#define PG8_SP2 true
#endif
#ifndef PG8_ALIGN
#define PG8_ALIGN true
#endif
template <int MODE> __device__ __forceinline__ void run_gemm(LAS unsigned char* lds, const bf16_t* A, int lda, const bf16_t* Bt, int Mr, int N, int K, const pg8::Epi<MODE>& E, int wave_in) {
    pg8::Gemm g{A, Bt, Mr, N, K, lda}; pg8::StaticOrder S; S.init(Mr, N, (int)gridDim.x, (int)blockIdx.x);
#if !defined(NO_GEMM) && (!defined(ONLY_MODE) || 1)
    if (ONLY_MODE_OK(MODE)) pg8::gemm_phase<pg8::Epi<MODE>, pg8::StaticOrder, PG8_ALIGN, PG8_SP2>(lds, g, S, E, wave_in);
#endif
}

__global__ void __launch_bounds__(NTHR, 2) fwd(Args a) {
    extern __shared__ __attribute__((aligned(16))) unsigned char lds_raw[];
    LAS unsigned char* lds = (LAS unsigned char*)lds_raw;
    cg::grid_group grid = cg::this_grid();
    const int ph_lo = a.ph_lo, ph_hi = a.ph_hi;
    const int wave_s = __builtin_amdgcn_readfirstlane((int)threadIdx.x >> 6);
    constexpr int MISC_OFF = 139264;
    if (threadIdx.x < 16) ((LAS unsigned*)(lds + MISC_OFF))[threadIdx.x] = 0u;
    __syncthreads();
    (void)xcd_barrier_post((unsigned*)(a.ws + WS_BAR), (volatile LAS unsigned*)(lds + MISC_OFF) + 8);
    for (int ph = ph_lo; ph < ph_hi; ++ph) {
        CArgs* ap = (CArgs*)__builtin_amdgcn_kernarg_segment_ptr();
        asm volatile("" : "+s"(ap));
        int tid_ = wave_s * 64 + (int)__builtin_amdgcn_mbcnt_hi(~0u, __builtin_amdgcn_mbcnt_lo(~0u, 0u)); asm volatile("" : "+v"(tid_));
        const int tid = tid_, lane = tid & 63, wave = wave_s;
        const int G = gridDim.x, gw = blockIdx.x * NWAVES + wave, NGW = G * NWAVES;
        unsigned char* ws = ap->ws;
        bf16_t* XB = (bf16_t*)(ws + WS_XB); bf16_t* MRG = (bf16_t*)(ws + WS_MRG);
        bf16_t* PROJ = (bf16_t*)(ws + WS_PROJ); bf16_t* YCAT = (bf16_t*)(ws + WS_YCAT); bf16_t* YS = (bf16_t*)(ws + WS_YS); float* SST = (float*)(ws + WS_SST);
        bf16_t* ACT = (bf16_t*)(ws + WS_ACT); float* RAW = (float*)(ws + WS_RAW);
        {
            const int l = ph / PPL, sp = ph % PPL;
            const unsigned char* wl = ws + WS_W;
            float* SS = (float*)(ws + WS_SS);
            float* COEF = (float*)(ws + WS_COEF);
            if (sp == 0) { ssm_coef_phase(ap, l, COEF, gw, lane); convert_phase(ap, l, lds, gw, NGW, wave, lane); if (l == 0) xb_phase(ap->in[0], XB, SS, gw, NGW, lane); }
            else if (sp == 1) { pg8::Epi<pg8::EP_INPROJ> E{PROJ, INW, ap->in[3] + l * 6144, nullptr, 0, nullptr, nullptr, SS + (size_t)(2 * l) * M, nullptr, nullptr}; run_gemm<pg8::EP_INPROJ>(lds, XB, D, (const bf16_t*)(wl + O_WIN), M, INW, D, E, wave); }
            else if (sp == 2) {
                for (int u = blockIdx.x; u < 256; u += G) attn_unit(lds, PROJ, YCAT, ap->in[4] + l * 128, ap->in[5] + l * 128, ap->in[6] + l * 8, u, tid, wave, lane);
                for (int u = blockIdx.x; u < 512; u += G) sg_unit(lds, PROJ, YCAT, ap->in[7] + l * 512, ap->in[8] + l * 512, ap->in[9] + (size_t)l * 4 * 128 * 128, ap->in[10] + l * 512, u, tid, wave, lane);
                for (int u = gw; u < 4096; u += NGW) ssm_unit<false>(ap, COEF, l, PROJ, SST, YS, lds + wave * 4352, u, lane);
            }
            else if (sp == 3) { for (int u = gw; u < 4096; u += NGW) ssm_pass3h(ap, COEF, l, PROJ, SST, YS, lds + wave * 8448, u, lane); }
            else if (sp == 4) { pg8::Epi<pg8::EP_GLU> E{YCAT + 1536, D, ap->in[20] + l * 512, YS, 512, nullptr}; run_gemm<pg8::EP_GLU>(lds, YS, 512, (const bf16_t*)(wl + O_WGLU), M, 512, 512, E, wave); }
            else if (sp == 5) {
                { pg8::Epi<pg8::EP_MERGE0> E{MRG, D, nullptr, PROJ + 3072, INW, nullptr}; run_gemm<pg8::EP_MERGE0>(lds, YCAT, D, (const bf16_t*)(wl + O_WA), M, D, 1024, E, wave); }
#pragma unroll 1
                for (int j = 1; j < 3; ++j) { pg8::Epi<pg8::EP_MERGE1> E{MRG, D, nullptr, PROJ + 3072 + j * D, INW, nullptr};
                    run_gemm<pg8::EP_MERGE1>(lds, YCAT + 512 + 512 * j, D, (const bf16_t*)(wl + (j == 1 ? O_WSG : O_WSSM)), M, D, 512, E, wave); }
            }
            else if (sp == 7) { pg8::Epi<pg8::EP_UPCONV> E{ACT, DFF, ap->in[27] + (size_t)l * 3 * NUP, nullptr, 0, ap->in[28] + (size_t)l * NUP, RAW, SS + (size_t)(2 * l + 1) * M, nullptr, nullptr};
                run_gemm<pg8::EP_UPCONV>(lds, XB, D, (const bf16_t*)(wl + O_WUP), M, NUP, D, E, wave); }
            else if (sp == 8) fixup_phase(RAW, ACT, ap->in[27] + (size_t)l * 3 * NUP, ap->in[28] + (size_t)l * NUP, blockIdx.x * NTHR + tid, G * NTHR);
            else {
                const bf16_t* A; const bf16_t* Bt; int K; float* sso;
                if (sp == 6) { A = MRG; Bt = (const bf16_t*)(wl + O_WOUT); K = D; sso = SS + (size_t)(2 * l + 1) * M; }
                else { A = ACT; Bt = (const bf16_t*)(wl + O_WDN); K = DFF; sso = (l == 0) ? SS + (size_t)2 * M : nullptr; }
                pg8::Epi<pg8::EP_RESID> E{sso ? nullptr : ap->out, D, nullptr, nullptr, 0, nullptr, nullptr, nullptr, XB, sso};
                run_gemm<pg8::EP_RESID>(lds, A, K, Bt, M, D, K, E, wave);
            }
        }
        if (ph + 1 < ph_hi) {
            if (ph_hi < 0) grid.sync();
            { XcdBarrier bar; bar.bar = (unsigned*)(ws + WS_BAR); bar.x = xb_xcc_id(); bar.st = (volatile LAS unsigned*)(lds + MISC_OFF) + 8; xcd_barrier(bar); }
        }
    }
}
}

extern "C" void kernel_launch(void* const* d_in, const int* in_sizes, int n_in, void* d_out, int out_size, void* d_ws, size_t ws_size, hipStream_t stream) {
    using namespace mk;
    static int grid = 0;
    if (grid == 0) {
        if (n_in != 30 || out_size != M * D || ws_size < WS_END) { fprintf(stderr, "kernel_launch: unexpected problem (n_in %d out %d ws %zu need %zu)\n", n_in, out_size, ws_size, (size_t)WS_END); grid = -1; return; }
        int dev = 0, cus = 0, per_cu = 0;
        (void)hipGetDevice(&dev); (void)hipDeviceGetAttribute(&cus, hipDeviceAttributeMultiprocessorCount, dev);
        (void)hipFuncSetAttribute((const void*)fwd, hipFuncAttributeMaxDynamicSharedMemorySize, LDS_BYTES);
        if (hipOccupancyMaxActiveBlocksPerMultiprocessor(&per_cu, (const void*)fwd, NTHR, LDS_BYTES) != hipSuccess || per_cu < 1) { fprintf(stderr, "kernel_launch: occupancy query gave %d\n", per_cu); per_cu = 1; }
        (void)hipGetLastError();
        grid = cus * 1;
    }
    if (grid < 0) return;
    Args a{};
    for (int i = 0; i < 30; ++i) a.in[i] = (const float*)d_in[i];
    a.out = (float*)d_out; a.ws = (unsigned char*)d_ws;
    (void)hipMemsetAsync((unsigned char*)d_ws + WS_SS, 0, (size_t)1 * MiB, stream);
#if MK_MULTI
    for (int p = 0; p < NPH; ++p) { a.ph_lo = p; a.ph_hi = p + 1; hipLaunchKernelGGL(fwd, dim3(grid), dim3(NTHR), LDS_BYTES, stream, a); }
#else
    a.ph_lo = 0; a.ph_hi = NPH;
    void* args[] = {&a};
    hipError_t e = hipLaunchCooperativeKernel((const void*)fwd, dim3(grid), dim3(NTHR), args, LDS_BYTES, stream);
    if (e != hipSuccess) fprintf(stderr, "cooperative launch failed: %s (grid %d)\n", hipGetErrorString(e), grid);
#endif
}
```

```cpp
#include <hip/hip_runtime.h>
#include <hip/hip_cooperative_groups.h>
#include <cstdio>
#include <cstdint>
#include <cmath>
namespace cg = cooperative_groups;
#ifndef REP_CONVERT
#define REP_CONVERT 1
#endif
#ifndef REP_SSM
#define REP_SSM 1
#endif
#ifndef REP_ATT
#define REP_ATT 1
#endif
#ifndef MK_MULTI
#define MK_MULTI 0
#endif
namespace pg8 {
#define PG8_LAS __attribute__((address_space(3)))
typedef unsigned short bf16_t;
typedef short bf16x8 __attribute__((ext_vector_type(8)));
typedef float f32x4 __attribute__((ext_vector_type(4)));
typedef unsigned u32x4 __attribute__((ext_vector_type(4)));
constexpr int BM = 256, BK = 64, HALF = 128, HTB = HALF * BK * 2  , STAGE_BYTES = 8 * HTB, NXCD = 8, WGM = 8;

__host__ __device__ __forceinline__ int lds_byte(int r, int c) { const int st = (r >> 4) * 2 + (c >> 5), rr = r & 15, cc = c & 31, ob = rr * 64 + cc * 2; return st * 1024 + (ob ^ (((ob >> 9) & 1) << 5)); }
__host__ __device__ __forceinline__ void stage_rc(int b, int& R, int& C) { const int st = b / 1024, sb = b % 1024, swz = sb ^ (((sb >> 9) & 1) << 5); R = (st >> 1) * 16 + swz / 64; C = (st & 1) * 32 + (swz % 64) / 2; }
__host__ __device__ __forceinline__ int perm32(int rho) { const int n = rho >> 4, i = rho & 15; return 8 * (i >> 2) + 4 * n + (i & 3); }

struct Unit { int pm, pn; };
struct Gemm { const bf16_t* A; const bf16_t* Bt; int M, N, K, lda; };

struct StaticOrder {
    int nM, nN, nwg, G, c;
    __host__ __device__ void init(int M, int N, int G_, int c_) { nM = M / BM; nN = N / BM; nwg = nM * nN; G = G_; c = c_; }
    __host__ __device__ bool next(int i, Unit& u) const {
        const long L = (long)i * G + c; if (L >= nwg) return false;
        int wgid = (int)L; { const int q = nwg / NXCD, r = nwg % NXCD, xcd = wgid % NXCD, off = wgid / NXCD; wgid = (xcd < r ? xcd * (q + 1) : r * (q + 1) + (xcd - r) * q) + off; }
        const int nig = WGM * nN, gid = wgid / nig, fm = gid * WGM, gsz = (nM - fm) < WGM ? (nM - fm) : WGM;
        u.pm = fm + ((wgid % nig) % gsz); u.pn = (wgid % nig) / gsz; return true;
    }
    __device__ __forceinline__ void a_ready(const Unit&) const {}
    __device__ __forceinline__ void done(const Unit&) const {}
};

__device__ __forceinline__ unsigned cvt_pk_bf16(float lo, float hi) { unsigned r; asm volatile("v_cvt_pk_bf16_f32 %0, %1, %2" : "=v"(r) : "v"(lo), "v"(hi)); return r; }
__device__ __forceinline__ float bf_lo(unsigned w) { return __uint_as_float(w << 16); }
__device__ __forceinline__ float bf_hi(unsigned w) { return __uint_as_float(w & 0xffff0000u); }
__device__ __forceinline__ float sigm(float x) { return __builtin_amdgcn_rcpf(1.f + __expf(-x)); }
__device__ __forceinline__ float gelu_t(float x) { const float p = __builtin_fmaf(x * x, -0.10294324f, -2.30220819f); return x * __builtin_amdgcn_rcpf(1.f + __builtin_amdgcn_exp2f(x * p)); }
__device__ __forceinline__ f32x4 sigm4(f32x4 v) { return (f32x4){sigm(v[0]), sigm(v[1]), sigm(v[2]), sigm(v[3])}; }
__device__ __forceinline__ f32x4 gelu4(f32x4 v) { return (f32x4){gelu_t(v[0]), gelu_t(v[1]), gelu_t(v[2]), gelu_t(v[3])}; }
__device__ __forceinline__ u32x4 pack8(f32x4 a, f32x4 b) { u32x4 w; w.x = cvt_pk_bf16(a[0], a[1]); w.y = cvt_pk_bf16(a[2], a[3]); w.z = cvt_pk_bf16(b[0], b[1]); w.w = cvt_pk_bf16(b[2], b[3]); return w; }
__device__ __forceinline__ void unpack8(u32x4 w, f32x4& a, f32x4& b) { a = (f32x4){bf_lo(w.x), bf_hi(w.x), bf_lo(w.y), bf_hi(w.y)}; b = (f32x4){bf_lo(w.z), bf_hi(w.z), bf_lo(w.w), bf_hi(w.w)}; }
enum { EP_INPROJ = 0, EP_GLU = 1, EP_MERGE0 = 2, EP_MERGE1 = 3, EP_RESID = 4, EP_RAW = 5, EP_UPCONV = 6 };
template <int CTRL> __device__ __forceinline__ float dpp_f(float x) { return __builtin_bit_cast(float, __builtin_amdgcn_update_dpp(0, __builtin_bit_cast(int, x), CTRL, 0xf, 0xf, false)); }
template <int CTRL> __device__ __forceinline__ f32x4 dpp4(f32x4 v) { return (f32x4){dpp_f<CTRL>(v[0]), dpp_f<CTRL>(v[1]), dpp_f<CTRL>(v[2]), dpp_f<CTRL>(v[3])}; }
template <int MODE> struct Epi {
    static constexpr bool PERM = true, AFTER_DRAIN = false;
    void* O; int ldc; const float* bias; const bf16_t* aux; int ldaux; const float* xin; float* raw; const float* ss; bf16_t* xb; float* ssout;
    __device__ __forceinline__ void operator()(const f32x4 (&acc)[2][2][4][2], const Unit& u, int wr, int wc, int fr, int fq) const {
        const int row0 = u.pm * BM + wr * 64 + fr, col0 = u.pn * BM + wc * 32 + 8 * fq;
        if constexpr (MODE == EP_UPCONV) {
            constexpr int NUPc = 11264, DFFc = 5632;
            const int cgl = u.pn * 128 + wc * 32 + 8 * fq, tcol = u.pn * 256 + wc * 32 + 8 * fq;
            float rs[2][4];
#pragma unroll
            for (int ai = 0; ai < 2; ++ai)
#pragma unroll
                for (int m = 0; m < 4; ++m) rs[ai][m] = rsqrtf(ss[row0 + ai * HALF + m * 16] * (1.f / 2048.f) + 1e-6f);
#pragma unroll
            for (int ai = 0; ai < 2; ++ai) {
                const int slab = u.pm * 4 + ai * 2 + wr;
                if (fr < 2) {
#pragma unroll
                    for (int bj = 0; bj < 2; ++bj)
#pragma unroll
                        for (int n = 0; n < 2; ++n) *(f32x4*)(raw + (size_t)(slab * 4 + fr) * NUPc + tcol + bj * 128 + 4 * n) = acc[ai][bj][0][n] * rs[ai][0];
                }
                if (fr >= 14) {
#pragma unroll
                    for (int bj = 0; bj < 2; ++bj)
#pragma unroll
                        for (int n = 0; n < 2; ++n) *(f32x4*)(raw + (size_t)(slab * 4 + fr - 12) * NUPc + tcol + bj * 128 + 4 * n) = acc[ai][bj][3][n] * rs[ai][3];
                }
            }
#pragma unroll
            for (int n = 0; n < 2; ++n) {
                const int c = cgl + 4 * n;
                const f32x4 wg0 = *(const f32x4*)(bias + c), wg1 = *(const f32x4*)(bias + NUPc + c), wg2 = *(const f32x4*)(bias + 2 * NUPc + c), bg = *(const f32x4*)(xin + c);
                const f32x4 wv0 = *(const f32x4*)(bias + DFFc + c), wv1 = *(const f32x4*)(bias + NUPc + DFFc + c), wv2 = *(const f32x4*)(bias + 2 * NUPc + DFFc + c), bv = *(const f32x4*)(xin + DFFc + c);
#pragma unroll
                for (int ai = 0; ai < 2; ++ai) {
                    f32x4 pg1 = (f32x4){0.f, 0.f, 0.f, 0.f}, pg2 = pg1, pv1 = pg1, pv2 = pg1;
#pragma unroll
                    for (int m = 0; m < 4; ++m) {
                        const f32x4 g = acc[ai][0][m][n] * rs[ai][m], v = acc[ai][1][m][n] * rs[ai][m];
                        const f32x4 g1 = dpp4<0x121>(g), g2 = dpp4<0x122>(g), v1 = dpp4<0x121>(v), v2 = dpp4<0x122>(v);
                        const f32x4 gp1 = (fr >= 1) ? g1 : pg1, gp2 = (fr >= 2) ? g2 : pg2, vp1 = (fr >= 1) ? v1 : pv1, vp2 = (fr >= 2) ? v2 : pv2;
                        const f32x4 cgt = bg + wg0 * g + wg1 * gp1 + wg2 * gp2, cvl = bv + wv0 * v + wv1 * vp1 + wv2 * vp2;
                        const f32x4 o = gelu4(cgt) * cvl;
                        typedef unsigned u32x2e __attribute__((ext_vector_type(2)));
                        u32x2e w; w.x = cvt_pk_bf16(o[0], o[1]); w.y = cvt_pk_bf16(o[2], o[3]);
                        if (!(m == 0 && fr < 2)) *(u32x2e*)((bf16_t*)O + (size_t)(row0 + ai * HALF + m * 16) * DFFc + c) = w;
                        pg1 = g1; pg2 = g2; pv1 = v1; pv2 = v2;
                    }
                }
            }
            return;
        }
        int kind = 0;
        if (MODE == EP_INPROJ) kind = (u.pn >= 12) ? 2 : ((u.pn >= 6 && u.pn < 10) ? 1 : 0);
        float rsr[2][4]; f32x4 cb0[2], cb1[2];
#pragma unroll
        for (int bj = 0; bj < 2; ++bj) { cb0[bj] = (f32x4){0.f, 0.f, 0.f, 0.f}; cb1[bj] = cb0[bj]; }
        if (MODE == EP_INPROJ) {
#pragma unroll
            for (int ai = 0; ai < 2; ++ai)
#pragma unroll
                for (int m = 0; m < 4; ++m) rsr[ai][m] = rsqrtf(ss[row0 + ai * HALF + m * 16] * (1.f / 2048.f) + 1e-6f);
            if (kind == 2) {
#pragma unroll
                for (int bj = 0; bj < 2; ++bj) { cb0[bj] = *(const f32x4*)(bias + (col0 + bj * HALF - 3072)); cb1[bj] = *(const f32x4*)(bias + (col0 + bj * HALF - 3072) + 4); }
            }
        }
        if (MODE == EP_GLU) {
#pragma unroll
            for (int bj = 0; bj < 2; ++bj) { cb0[bj] = *(const f32x4*)(bias + col0 + bj * HALF); cb1[bj] = *(const f32x4*)(bias + col0 + bj * HALF + 4); }
        }
#pragma unroll
        for (int ai = 0; ai < 2; ++ai)
#pragma unroll
            for (int m = 0; m < 4; ++m) {
                const size_t row = (size_t)(row0 + ai * HALF + m * 16);
                float ssq = 0.f;
#pragma unroll
                for (int bj = 0; bj < 2; ++bj) {
                    const int col = col0 + bj * HALF;
                    f32x4 v0 = acc[ai][bj][m][0], v1 = acc[ai][bj][m][1];
                    if (MODE == EP_INPROJ) {
                        const float rs = rsr[ai][m];
                        v0 = v0 * rs; v1 = v1 * rs;
                        if (kind == 1) { v0 = gelu4(v0); v1 = gelu4(v1); }
                        else if (kind == 2) { v0 = sigm4(v0 + cb0[bj]); v1 = sigm4(v1 + cb1[bj]); }
                        *(u32x4*)((bf16_t*)O + row * ldc + col) = pack8(v0, v1);
                    } else if (MODE == EP_GLU) {
                        f32x4 y0, y1; unpack8(*(const u32x4*)(aux + row * ldaux + col), y0, y1);
                        v0 = y0 * sigm4(v0 + cb0[bj]); v1 = y1 * sigm4(v1 + cb1[bj]);
                        *(u32x4*)((bf16_t*)O + row * ldc + col) = pack8(v0, v1);
                    } else if (MODE == EP_MERGE0 || MODE == EP_MERGE1) {
                        f32x4 g0, g1; unpack8(*(const u32x4*)(aux + row * ldaux + col), g0, g1);
                        v0 = g0 * v0; v1 = g1 * v1;
                        if (MODE == EP_MERGE1) { f32x4 o0, o1; unpack8(*(const u32x4*)((const bf16_t*)O + row * ldc + col), o0, o1); v0 = v0 + o0; v1 = v1 + o1; }
                        *(u32x4*)((bf16_t*)O + row * ldc + col) = pack8(v0, v1);
                    } else if (MODE == EP_RESID) {
                        f32x4 x0, x1; unpack8(*(const u32x4*)(xb + row * ldc + col), x0, x1); x0 = x0 + v0; x1 = x1 + v1;
                        if (O) { *(f32x4*)((float*)O + row * ldc + col) = x0; *(f32x4*)((float*)O + row * ldc + col + 4) = x1; }
                        if (ssout) {
                            *(u32x4*)(xb + row * ldc + col) = pack8(x0, x1);
                            const float q = (x0[0] * x0[0] + x0[1] * x0[1]) + (x0[2] * x0[2] + x0[3] * x0[3]) + (x1[0] * x1[0] + x1[1] * x1[1]) + (x1[2] * x1[2] + x1[3] * x1[3]);
                            if (bj == 0) ssq = q; else ssq += q;
                        }
                    } else {
                        *(u32x4*)((bf16_t*)O + row * ldc + col) = pack8(v0, v1);
                    }
                }
                if (MODE == EP_RESID) { if (ssout) { ssq += __shfl_xor(ssq, 16); ssq += __shfl_xor(ssq, 32); if (fq == 0) unsafeAtomicAdd(ssout + row, ssq); } }
                if (m == 3) asm volatile("" ::: "memory");
            }
    }
};
template <class Epi, class Sched, bool ALIGN_EPI = false, bool SP2 = false>
__device__ __forceinline__ void gemm_phase(PG8_LAS unsigned char* lds, const Gemm g, const Sched& S, const Epi& E, int wave_in) {
    int tid_ = wave_in * 64 + (int)__builtin_amdgcn_mbcnt_hi(~0u, __builtin_amdgcn_mbcnt_lo(~0u, 0u)); asm volatile("" : "+v"(tid_));
    const int tid = tid_, wid = __builtin_amdgcn_readfirstlane(tid >> 6), lane = tid & 63, wr = wid >> 2, wc = wid & 3, fr = lane & 15, fq = lane >> 4;
    const int K = g.K, nt = K / BK;
    unsigned voffA[2], voffB[2];
#pragma unroll
    for (int i = 0; i < 2; ++i) { int R, C; stage_rc(tid * 16 + i * 8192, R, C); const int Rb = Epi::PERM ? ((R & ~31) + perm32(R & 31)) : R;
        voffA[i] = (unsigned)(R * g.lda + C) * 2u; voffB[i] = (unsigned)(Rb * K + C) * 2u; }
    const size_t kstep = (size_t)(BK * 2);
    const size_t hstep = (size_t)HALF * K * 2;
    const size_t tstep = 2 * hstep; const size_t hstepA = (size_t)HALF * g.lda * 2, tstepA = 2 * hstepA;
    const unsigned ldsw = (unsigned)wid * 1024u;
    const int aoff = lds_byte(wr * 64 + fr, fq * 8), boff = lds_byte(wc * 32 + fr, fq * 8);
#define PG8_SA(b, h) (((b) * 2 + (h)) * HTB)
#define PG8_SB(b, h) ((4 + (b) * 2 + (h)) * HTB)
#define PG8_STAGE(bufoff, gbase, voff) do { _Pragma("unroll") for (int _i = 0; _i < 2; ++_i) \
        __builtin_amdgcn_global_load_lds((const unsigned*)((const char*)(gbase) + (voff)[_i]), (PG8_LAS unsigned*)(lds + (bufoff) + ldsw + _i * 8192), 16, 0, 0); } while (0)
#define PG8_LDA(dst, b, h) do { _Pragma("unroll") for (int m = 0; m < 4; ++m) _Pragma("unroll") for (int k = 0; k < 2; ++k) dst[m][k] = *(const PG8_LAS bf16x8*)(lds + PG8_SA(b, h) + aoff + m * 2048 + k * 1024); } while (0)
#define PG8_LDB(dst, b, h) do { _Pragma("unroll") for (int n = 0; n < 2; ++n) _Pragma("unroll") for (int k = 0; k < 2; ++k) dst[n][k] = *(const PG8_LAS bf16x8*)(lds + PG8_SB(b, h) + boff + n * 2048 + k * 1024); } while (0)
#define PG8_MMA(ai, bj, At, Bt) do { __builtin_amdgcn_s_setprio(1); _Pragma("unroll") for (int m = 0; m < 4; ++m) _Pragma("unroll") for (int n = 0; n < 2; ++n) _Pragma("unroll") for (int k = 0; k < 2; ++k) \
        acc[ai][bj][m][n] = __builtin_amdgcn_mfma_f32_16x16x32_bf16(Bt[n][k], At[m][k], acc[ai][bj][m][n], 0, 0, 0); __builtin_amdgcn_s_setprio(0); } while (0)
#define PG8_WAIT_V(n) asm volatile("s_waitcnt vmcnt(" #n ")" ::: "memory")
#define PG8_WAIT_L(n) asm volatile("s_waitcnt lgkmcnt(" #n ")" ::: "memory")
#define PG8_BAR __builtin_amdgcn_s_barrier()
#define PG8_SCHED __builtin_amdgcn_sched_barrier(0)
    Unit cur, nxt; int ui = 0;
    if (!S.next(0, cur)) return;
    f32x4 acc[2][2][4][2];
#pragma unroll
    for (int a = 0; a < 2; ++a)
#pragma unroll
        for (int b = 0; b < 2; ++b)
#pragma unroll
            for (int m = 0; m < 4; ++m)
#pragma unroll
                for (int n = 0; n < 2; ++n) acc[a][b][m][n] = (f32x4){0.f, 0.f, 0.f, 0.f};
    bf16x8 At[4][2], B0[2][2], B1[2][2];
    const char* cA = (const char*)g.A + (size_t)cur.pm * tstepA; const char* cB = (const char*)g.Bt + (size_t)cur.pn * tstep;
    S.a_ready(cur);
    if constexpr (SP2) {
        PG8_STAGE(PG8_SB(0, 0), cB, voffB); PG8_STAGE(PG8_SB(0, 1), cB + hstep, voffB); PG8_STAGE(PG8_SA(0, 0), cA, voffA); PG8_STAGE(PG8_SA(0, 1), cA + hstepA, voffA);
        if (wr == 1) PG8_BAR;
        PG8_WAIT_V(2); PG8_BAR;
        PG8_STAGE(PG8_SB(1, 0), cB + kstep, voffB); PG8_STAGE(PG8_SA(1, 0), cA + kstep, voffA); PG8_STAGE(PG8_SB(1, 1), cB + hstep + kstep, voffB);
        PG8_WAIT_V(6); PG8_BAR;
    } else {
        PG8_STAGE(PG8_SB(0, 0), cB, voffB); PG8_STAGE(PG8_SA(0, 0), cA, voffA); PG8_STAGE(PG8_SB(0, 1), cB + hstep, voffB); PG8_STAGE(PG8_SA(0, 1), cA + hstepA, voffA);
        if (wr == 1) PG8_BAR;
        PG8_WAIT_V(4); PG8_BAR;
        PG8_STAGE(PG8_SB(1, 0), cB + kstep, voffB); PG8_STAGE(PG8_SA(1, 0), cA + kstep, voffA); PG8_STAGE(PG8_SB(1, 1), cB + hstep + kstep, voffB);
        PG8_WAIT_V(6); PG8_BAR;
    }
    for (;;) {
        const bool has_next = S.next(ui + 1, nxt);
        const char* nA = has_next ? (const char*)g.A + (size_t)nxt.pm * tstepA : cA; const char* nB = has_next ? (const char*)g.Bt + (size_t)nxt.pn * tstep : cB;
        for (int t = 0; t < nt; t += 2) {
            const bool last = (t == nt - 2);
            const char* a1 = cA + (size_t)(t + 1) * kstep;
            const char* a2 = last ? nA : cA + (size_t)(t + 2) * kstep; const char* b2 = last ? nB : cB + (size_t)(t + 2) * kstep;
            const char* a3 = a2 + kstep; const char* b3 = b2 + kstep;
            if (last && has_next) S.a_ready(nxt);
            if constexpr (SP2) {
            PG8_LDB(B0, 0, 0); PG8_LDB(B1, 0, 1); PG8_SCHED; PG8_LDA(At, 0, 0); PG8_STAGE(PG8_SA(1, 1), a1 + hstepA, voffA);
            PG8_WAIT_V(8); PG8_WAIT_L(0); PG8_BAR; PG8_MMA(0, 0, At, B0); PG8_MMA(0, 1, At, B1); PG8_BAR; PG8_SCHED;
            PG8_LDA(At, 0, 1); PG8_STAGE(PG8_SB(0, 0), b2, voffB); PG8_STAGE(PG8_SB(0, 1), b2 + hstep, voffB); PG8_STAGE(PG8_SA(0, 0), a2, voffA);
            PG8_WAIT_V(8); PG8_WAIT_L(0); PG8_BAR; PG8_MMA(1, 0, At, B0); PG8_MMA(1, 1, At, B1); PG8_BAR; PG8_SCHED;
            PG8_LDB(B0, 1, 0); PG8_LDB(B1, 1, 1); PG8_SCHED; PG8_LDA(At, 1, 0); PG8_STAGE(PG8_SA(0, 1), a2 + hstepA, voffA);
            PG8_WAIT_V(8); PG8_WAIT_L(0); PG8_BAR; PG8_MMA(0, 0, At, B0); PG8_MMA(0, 1, At, B1); PG8_BAR; PG8_SCHED;
            PG8_LDA(At, 1, 1); PG8_STAGE(PG8_SB(1, 0), b3, voffB); PG8_STAGE(PG8_SB(1, 1), b3 + hstep, voffB); PG8_STAGE(PG8_SA(1, 0), a3, voffA);
            PG8_WAIT_V(8); PG8_WAIT_L(0); PG8_BAR; PG8_MMA(1, 0, At, B0); PG8_MMA(1, 1, At, B1); PG8_BAR; PG8_SCHED;
            } else {
            PG8_LDB(B0, 0, 0); PG8_SCHED; PG8_LDA(At, 0, 0); PG8_STAGE(PG8_SA(1, 1), a1 + hstepA, voffA);
            PG8_WAIT_L(8); PG8_BAR; PG8_WAIT_L(0); PG8_MMA(0, 0, At, B0); PG8_BAR; PG8_SCHED;
            PG8_LDB(B1, 0, 1); PG8_STAGE(PG8_SB(0, 0), b2, voffB);
            PG8_BAR; PG8_WAIT_L(0); PG8_MMA(0, 1, At, B1); PG8_BAR;
            PG8_LDA(At, 0, 1); PG8_STAGE(PG8_SA(0, 0), a2, voffA);
            PG8_BAR; PG8_WAIT_L(0); PG8_MMA(1, 0, At, B0); PG8_BAR; PG8_SCHED;
            PG8_STAGE(PG8_SB(0, 1), b2 + hstep, voffB);
            PG8_WAIT_V(6); PG8_BAR; PG8_MMA(1, 1, At, B1); PG8_BAR;
            PG8_LDB(B0, 1, 0); PG8_SCHED; PG8_LDA(At, 1, 0); PG8_STAGE(PG8_SA(0, 1), a2 + hstepA, voffA);
            PG8_WAIT_L(8); PG8_BAR; PG8_WAIT_L(0); PG8_MMA(0, 0, At, B0); PG8_BAR; PG8_SCHED;
            PG8_LDB(B1, 1, 1); PG8_STAGE(PG8_SB(1, 0), b3, voffB);
            PG8_BAR; PG8_WAIT_L(0); PG8_MMA(0, 1, At, B1); PG8_BAR;
            PG8_LDA(At, 1, 1); PG8_STAGE(PG8_SA(1, 0), a3, voffA);
            PG8_BAR; PG8_WAIT_L(0); PG8_MMA(1, 0, At, B0); PG8_BAR; PG8_SCHED;
            PG8_STAGE(PG8_SB(1, 1), b3 + hstep, voffB);
            PG8_WAIT_V(6); PG8_BAR; PG8_MMA(1, 1, At, B1); PG8_BAR;
            }
        }
        if constexpr (ALIGN_EPI) { if (wr == 0) PG8_BAR; }
        if constexpr (!Epi::AFTER_DRAIN) { E(acc, cur, wr, wc, fr, fq); S.done(cur); }
        if (!has_next) break;
#pragma unroll
        for (int a = 0; a < 2; ++a)
#pragma unroll
            for (int b = 0; b < 2; ++b)
#pragma unroll
                for (int m = 0; m < 4; ++m)
#pragma unroll
                    for (int n = 0; n < 2; ++n) acc[a][b][m][n] = (f32x4){0.f, 0.f, 0.f, 0.f};
        cur = nxt; cA = nA; cB = nB; ++ui;
        if constexpr (ALIGN_EPI) { if (wr == 1) PG8_BAR; }
    }
    PG8_WAIT_V(0);
    if constexpr (!ALIGN_EPI) { if (wr == 0) PG8_BAR; }
    PG8_BAR;
    if constexpr (Epi::AFTER_DRAIN) { E.fused(acc, cur, wr, wc, fr, fq, lds, wid, lane); S.done(cur); }
#undef PG8_SA
#undef PG8_SB
#undef PG8_STAGE
#undef PG8_LDA
#undef PG8_LDB
#undef PG8_MMA
#undef PG8_WAIT_V
#undef PG8_WAIT_L
#undef PG8_BAR
#undef PG8_SCHED
}
}

namespace mk {
using pg8::bf16_t; using pg8::bf16x8; using pg8::f32x4; using pg8::u32x4; using pg8::bf_lo; using pg8::bf_hi; using pg8::cvt_pk_bf16; using pg8::gelu_t;
#define LAS __attribute__((address_space(3)))
typedef unsigned u32x2 __attribute__((ext_vector_type(2)));
constexpr int M = 16384, D = 2048, SEQ = 8192, INW = 9216, DFF = 5632, NUP = 11264, MH = 8192;
constexpr int NWAVES = 8, NTHR = 512;
constexpr int LDS_BYTES = 143360;
constexpr float EPS = 1e-6f;
constexpr size_t O_WIN = 0, O_WA = O_WIN + (size_t)INW * D * 2, O_WSG = O_WA + (size_t)D * 1024 * 2, O_WSSM = O_WSG + (size_t)D * 512 * 2, O_WOUT = O_WSSM + (size_t)D * 512 * 2,
                 O_WUP = O_WOUT + (size_t)D * D * 2, O_WDN = O_WUP + (size_t)NUP * D * 2, O_WGLU = O_WDN + (size_t)D * DFF * 2, WLAYER = O_WGLU + (size_t)512 * 512 * 2;
constexpr size_t MiB = 1u << 20;
constexpr size_t WS_W = 0, WS_XB = 119 * MiB, WS_MRG = WS_XB + 64 * MiB, WS_PROJ = WS_MRG + 64 * MiB, WS_YCAT = WS_PROJ + 288 * MiB, WS_YS = WS_YCAT + 64 * MiB, WS_SST = WS_YS + 16 * MiB, WS_SS = WS_SST + 2 * MiB, WS_BAR = WS_SS + 512 * 1024, WS_COEF = WS_SS + 768 * 1024, WS_END = WS_SS + 1 * MiB;
static_assert(WLAYER <= 119 * MiB, "one layer of bf16 weights");
constexpr size_t WS_ACT = WS_PROJ, WS_RAW = WS_PROJ + 176 * MiB;
static_assert(WLAYER % 256 == 0 && (size_t)M * INW * 2 == 288 * MiB && (size_t)M * DFF * 2 == 176 * MiB && (size_t)256 * 4 * NUP * 4 <= 112 * MiB, "ws map");
constexpr int PPL = 10, NPH = PPL * 2;

struct Args { const float* in[30]; float* out; unsigned char* ws; int ph_lo, ph_hi; };
typedef __attribute__((address_space(4))) const Args CArgs;

__device__ __forceinline__ float wave_sum(float v) {
#pragma unroll
    for (int o = 1; o < 64; o <<= 1) v += __shfl_xor(v, o);
    return v;
}
__device__ __forceinline__ unsigned f2bf(float f) { unsigned u = __builtin_bit_cast(unsigned, f); return (u + 0x7fffu + ((u >> 16) & 1u)) >> 16; }
__device__ __forceinline__ unsigned pk2(float lo, float hi) { return f2bf(lo) | (f2bf(hi) << 16); }

__device__ __forceinline__ void titem_load(const float* W, int N, int item, int lane, float (&wv)[32]) {
    const int nblk = N / 32, kb = item / nblk, nb = item % nblk;
    const float* wp = W + (size_t)(64 * kb + (lane >> 5)) * N + 32 * nb + (lane & 31);
#pragma unroll
    for (int i = 0; i < 32; ++i) wv[i] = __builtin_nontemporal_load(wp + (size_t)(2 * i) * N);
}
__device__ __forceinline__ void titem_finish(const float (&wv)[32], int K, int N, bf16_t* WT, LAS float* scr, int item, int lane, bool upperm, const float* gain) {
    const int nblk = N / 32, kb = item / nblk, nb = item % nblk, k0 = 64 * kb, n0 = 32 * nb;
    int nd0 = n0; if (upperm) { const int hi = n0 >= 5632, nn = n0 - hi * 5632; nd0 = 256 * (nn >> 7) + 128 * hi + (nn & 127); }
#pragma unroll
    for (int i = 0; i < 32; ++i) scr[(2 * i + (lane >> 5)) * 33 + (lane & 31)] = wv[i];
    asm volatile("s_waitcnt lgkmcnt(0)" ::: "memory");
    const int c = lane & 7;
    f32x4 g0 = (f32x4){1.f, 1.f, 1.f, 1.f}, g1 = g0;
    if (gain) { g0 = *(const f32x4*)(gain + k0 + 8 * c); g1 = *(const f32x4*)(gain + k0 + 8 * c + 4); }
#pragma unroll
    for (int j = 0; j < 4; ++j) { const int n = (lane >> 3) + 8 * j; const LAS float* s = scr + (8 * c) * 33 + n;
        u32x4 o; o.x = cvt_pk_bf16(s[0 * 33] * g0[0], s[1 * 33] * g0[1]); o.y = cvt_pk_bf16(s[2 * 33] * g0[2], s[3 * 33] * g0[3]); o.z = cvt_pk_bf16(s[4 * 33] * g1[0], s[5 * 33] * g1[1]); o.w = cvt_pk_bf16(s[6 * 33] * g1[2], s[7 * 33] * g1[3]);
        *(u32x4*)(WT + (size_t)(nd0 + n) * K + k0 + 8 * c) = o; }
    asm volatile("s_waitcnt lgkmcnt(0)" ::: "memory");
}
__device__ __forceinline__ void convert_phase(CArgs* ap, int l, LAS unsigned char* lds, int gw, int NGW, int wave, int lane) {
    LAS float* scr = (LAS float*)(lds + wave * 8448);
    {
        unsigned char* wb = ap->ws + WS_W;
#pragma unroll 1
        for (int mi = 0; mi < 8; ++mi) {
            const float* W; int K, N; size_t off;
            switch (mi) {
                case 0: W = ap->in[2] + (size_t)l * D * INW; K = D; N = INW; off = O_WIN; break;
                case 1: W = ap->in[21] + (size_t)l * 1024 * D; K = 1024; N = D; off = O_WA; break;
                case 2: W = ap->in[22] + (size_t)l * 512 * D; K = 512; N = D; off = O_WSG; break;
                case 3: W = ap->in[23] + (size_t)l * 512 * D; K = 512; N = D; off = O_WSSM; break;
                case 4: W = ap->in[24] + (size_t)l * D * D; K = D; N = D; off = O_WOUT; break;
                case 5: W = ap->in[26] + (size_t)l * D * NUP; K = D; N = NUP; off = O_WUP; break;
                case 6: W = ap->in[29] + (size_t)l * DFF * D; K = DFF; N = D; off = O_WDN; break;
                default: W = ap->in[19] + (size_t)l * 512 * 512; K = 512; N = 512; off = O_WGLU; break;
            }
            const int nitems = (K / 64) * (N / 32);
            const float* gain = mi == 0 ? ap->in[1] + l * D : (mi == 5 ? ap->in[25] + l * D : nullptr);
            float wc[32], wn[32];
            int it = gw;
            if (it < nitems) titem_load(W, N, it, lane, wc);
            while (it < nitems) {
                const int nx = it + NGW;
                if (nx < nitems) titem_load(W, N, nx, lane, wn);
                titem_finish(wc, K, N, (bf16_t*)(wb + off), scr, it, lane, mi == 5, gain);
#pragma unroll
                for (int i = 0; i < 32; ++i) wc[i] = wn[i];
                it = nx;
            }
        }
    }
}

__device__ __forceinline__ void xb_phase(const float* x, bf16_t* XB, float* SS, int gw, int NGW, int lane) {
    for (int m = 2 * gw; m < M; m += 2 * NGW) {
        const f32x4* xr0 = (const f32x4*)(x + (size_t)m * D) + lane; const f32x4* xr1 = xr0 + D / 4;
        f32x4 v0[8], v1[8]; float s0 = 0.f, s1 = 0.f;
#pragma unroll
        for (int j = 0; j < 8; ++j) { v0[j] = __builtin_nontemporal_load(xr0 + 64 * j); v1[j] = __builtin_nontemporal_load(xr1 + 64 * j); }
#pragma unroll
        for (int j = 0; j < 8; ++j) { s0 += (v0[j][0] * v0[j][0] + v0[j][1] * v0[j][1]) + (v0[j][2] * v0[j][2] + v0[j][3] * v0[j][3]); s1 += (v1[j][0] * v1[j][0] + v1[j][1] * v1[j][1]) + (v1[j][2] * v1[j][2] + v1[j][3] * v1[j][3]); }
        s0 = wave_sum(s0); s1 = wave_sum(s1);
        if (lane == 0) { SS[m] = s0; SS[m + 1] = s1; }
        u32x2* o0 = (u32x2*)(XB + (size_t)m * D) + lane; u32x2* o1 = o0 + D / 4;
#pragma unroll
        for (int j = 0; j < 8; ++j) { u32x2 w; w.x = cvt_pk_bf16(v0[j][0], v0[j][1]); w.y = cvt_pk_bf16(v0[j][2], v0[j][3]); o0[64 * j] = w; w.x = cvt_pk_bf16(v1[j][0], v1[j][1]); w.y = cvt_pk_bf16(v1[j][2], v1[j][3]); o1[64 * j] = w; }
    }
}

__device__ __forceinline__ bf16x8 as_bf8(u32x4 w) { return __builtin_bit_cast(bf16x8, w); }

__device__ __forceinline__ void attn_unit(LAS unsigned char* lds, const bf16_t* PROJ, bf16_t* YCAT, const float* qg, const float* kg, const float* sinks, int unit, int tid, int wave, int lane) {
    const int kvh = unit & 1, blk = (unit >> 1) & 63, b = unit >> 7;
    const int t0 = b * SEQ + blk * 128;
    LAS bf16_t* Ks = (LAS bf16_t*)lds; LAS bf16_t* Vt = (LAS bf16_t*)(lds + 69632);
    {
        const int c16 = tid & 15;
        const f32x4 g0 = *(const f32x4*)(kg + 8 * c16), g1 = *(const f32x4*)(kg + 8 * c16 + 4);
#pragma unroll 2
        for (int pass = 0; pass < 8; ++pass) {
            const int kidx = (tid >> 4) + 32 * pass;
            u32x4 w = {0u, 0u, 0u, 0u};
            if (!(blk == 0 && pass < 4)) w = *(const u32x4*)(PROJ + (size_t)(t0 - 128 + kidx) * INW + 1024 + kvh * 128 + 8 * c16);
            f32x4 v0, v1; pg8::unpack8(w, v0, v1);
            float ss = (v0[0] * v0[0] + v0[1] * v0[1]) + (v0[2] * v0[2] + v0[3] * v0[3]) + (v1[0] * v1[0] + v1[1] * v1[1]) + (v1[2] * v1[2] + v1[3] * v1[3]);
            ss += __shfl_xor(ss, 1); ss += __shfl_xor(ss, 2); ss += __shfl_xor(ss, 4); ss += __shfl_xor(ss, 8);
            const float rs = rsqrtf(ss * (1.f / 128.f) + EPS);
            *(LAS u32x4*)(Ks + kidx * 136 + 8 * c16) = pg8::pack8(v0 * rs * g0, v1 * rs * g1);
        }
    }
    {
#pragma unroll 1
        for (int rg = 0; rg < 4; ++rg) {
            const int kidx = 64 * rg + lane, kk = kidx & 31, pos = (kidx & ~31) + 8 * ((kk >> 2) & 3) + 4 * (kk >> 4) + (kk & 3);
#pragma unroll
            for (int cc = 0; cc < 2; ++cc) {
                const int c16 = 2 * wave + cc;
                u32x4 w = {0u, 0u, 0u, 0u};
                if (!(blk == 0 && rg < 2)) w = *(const u32x4*)(PROJ + (size_t)(t0 - 128 + kidx) * INW + 1280 + kvh * 128 + 8 * c16);
                LAS bf16_t* d = Vt + (8 * c16) * 264 + pos;
                d[0 * 264] = (bf16_t)(w.x & 0xffffu); d[1 * 264] = (bf16_t)(w.x >> 16); d[2 * 264] = (bf16_t)(w.y & 0xffffu); d[3 * 264] = (bf16_t)(w.y >> 16);
                d[4 * 264] = (bf16_t)(w.z & 0xffffu); d[5 * 264] = (bf16_t)(w.z >> 16); d[6 * 264] = (bf16_t)(w.w & 0xffffu); d[7 * 264] = (bf16_t)(w.w >> 16);
            }
        }
    }
    __syncthreads();
    const int fr = lane & 15, fq = lane >> 4, qrow = 16 * wave + fr;
#pragma unroll 1
    for (int hq = 4 * kvh; hq < 4 * kvh + 4; ++hq) {
    bf16x8 qf[4];
    {
        const bf16_t* qp = PROJ + (size_t)(t0 + qrow) * INW + hq * 128 + 8 * fq;
        u32x4 w[4]; float ss = 0.f;
#pragma unroll
        for (int ks = 0; ks < 4; ++ks) { w[ks] = *(const u32x4*)(qp + 32 * ks); f32x4 v0, v1; pg8::unpack8(w[ks], v0, v1);
            ss += (v0[0] * v0[0] + v0[1] * v0[1]) + (v0[2] * v0[2] + v0[3] * v0[3]) + (v1[0] * v1[0] + v1[1] * v1[1]) + (v1[2] * v1[2] + v1[3] * v1[3]); }
        ss += __shfl_xor(ss, 16); ss += __shfl_xor(ss, 32);
        const float rs = rsqrtf(ss * (1.f / 128.f) + EPS) * 0.08838834764831845f;
#pragma unroll
        for (int ks = 0; ks < 4; ++ks) { f32x4 v0, v1; pg8::unpack8(w[ks], v0, v1);
            const f32x4 g0 = *(const f32x4*)(qg + 32 * ks + 8 * fq), g1 = *(const f32x4*)(qg + 32 * ks + 8 * fq + 4);
            qf[ks] = as_bf8(pg8::pack8(v0 * rs * g0, v1 * rs * g1)); }
    }
    const int wp = wave & ~1;
    f32x4 s[10];
#pragma unroll
    for (int rel = 0; rel < 10; ++rel) {
        s[rel] = (f32x4){0.f, 0.f, 0.f, 0.f};
#pragma unroll
        for (int ks = 0; ks < 4; ++ks) {
            const bf16x8 kf = *(const LAS bf16x8*)(Ks + (16 * (wp + rel) + fr) * 136 + 32 * ks + 8 * fq);
            s[rel] = __builtin_amdgcn_mfma_f32_16x16x32_bf16(kf, qf[ks], s[rel], 0, 0, 0);
        }
    }
    const float slope = exp2f(-(float)(hq + 1)), sink = sinks[hq];
    const int qidx = 128 + qrow;
    float mx = -INFINITY;
#pragma unroll
    for (int rel = 0; rel < 10; ++rel)
#pragma unroll
        for (int i = 0; i < 4; ++i) {
            const int kidx = 16 * (wp + rel) + 4 * fq + i, dist = qidx - kidx;
            const bool valid = (dist >= 0) && (dist < 128) && (blk > 0 || kidx >= 128);
            const float val = valid ? s[rel][i] - slope * (float)dist : -INFINITY;
            s[rel][i] = val; mx = fmaxf(mx, val);
        }
    mx = fmaxf(mx, __shfl_xor(mx, 16)); mx = fmaxf(mx, __shfl_xor(mx, 32));
    const float mm = fmaxf(mx, sink);
    float ls = 0.f;
#pragma unroll
    for (int rel = 0; rel < 10; ++rel)
#pragma unroll
        for (int i = 0; i < 4; ++i) { const float p = __expf(s[rel][i] - mm); s[rel][i] = p; ls += p; }
    ls += __shfl_xor(ls, 16); ls += __shfl_xor(ls, 32);
    const float inv = 1.f / (ls + __expf(sink - mm));
    bf16x8 pf[5];
#pragma unroll
    for (int g = 0; g < 5; ++g) pf[g] = as_bf8(pg8::pack8(s[2 * g], s[2 * g + 1]));
    bf16_t* op = YCAT + (size_t)(t0 + qrow) * D + hq * 128 + 4 * fq;
#pragma unroll
    for (int db = 0; db < 8; ++db) {
        f32x4 o = (f32x4){0.f, 0.f, 0.f, 0.f};
#pragma unroll
        for (int g = 0; g < 5; ++g) {
            const bf16x8 vf = *(const LAS bf16x8*)(Vt + (16 * db + fr) * 264 + 32 * ((wp >> 1) + g) + 8 * fq);
            o = __builtin_amdgcn_mfma_f32_16x16x32_bf16(vf, pf[g], o, 0, 0, 0);
        }
        u32x2 w; w.x = cvt_pk_bf16(o[0] * inv, o[1] * inv); w.y = cvt_pk_bf16(o[2] * inv, o[3] * inv);
        *(u32x2*)(op + 16 * db) = w;
    }
    }
    __syncthreads();
}

__device__ __forceinline__ void sg_unit(LAS unsigned char* lds, const bf16_t* PROJ, bf16_t* YCAT, const float* lng, const float* lnb, const float* sgw, const float* sgb, int unit, int tid, int wave, int lane) {
    const int g = unit & 3, ch = (unit >> 2) & 63, b = unit >> 8;
    const int t0 = b * SEQ + ch * 128;
    LAS bf16_t* Zt = (LAS bf16_t*)lds; LAS float* st = (LAS float*)(lds + 34816);
    const bf16_t* zv = PROJ + (size_t)t0 * INW + 2048 + g * 128;
    {
        const int c16 = tid & 15;
#pragma unroll
        for (int pass = 0; pass < 4; ++pass) {
            const int r = (tid >> 4) + 32 * pass;
            f32x4 v0, v1; pg8::unpack8(*(const u32x4*)(zv + (size_t)r * INW + 8 * c16), v0, v1);
            float sm = (v0[0] + v0[1]) + (v0[2] + v0[3]) + (v1[0] + v1[1]) + (v1[2] + v1[3]);
            sm += __shfl_xor(sm, 1); sm += __shfl_xor(sm, 2); sm += __shfl_xor(sm, 4); sm += __shfl_xor(sm, 8);
            const float mean = sm * (1.f / 128.f);
            v0 = v0 - mean; v1 = v1 - mean;
            float q = (v0[0] * v0[0] + v0[1] * v0[1]) + (v0[2] * v0[2] + v0[3] * v0[3]) + (v1[0] * v1[0] + v1[1] * v1[1]) + (v1[2] * v1[2] + v1[3] * v1[3]);
            q += __shfl_xor(q, 1); q += __shfl_xor(q, 2); q += __shfl_xor(q, 4); q += __shfl_xor(q, 8);
            if (c16 == 0) { st[2 * r] = mean; st[2 * r + 1] = rsqrtf(q * (1.f / 128.f) + EPS); }
        }
    }
    __syncthreads();
#pragma unroll 1
    for (int rg = 0; rg < 2; ++rg) {
        const int r = 64 * rg + lane; const float mean = st[2 * r], rstd = st[2 * r + 1];
#pragma unroll
        for (int cc = 0; cc < 2; ++cc) {
            const int c16 = 2 * wave + cc;
            f32x4 v0, v1; pg8::unpack8(*(const u32x4*)(zv + (size_t)r * INW + 8 * c16), v0, v1);
            const f32x4 a0 = *(const f32x4*)(lng + g * 128 + 8 * c16), a1 = *(const f32x4*)(lng + g * 128 + 8 * c16 + 4);
            const f32x4 b0 = *(const f32x4*)(lnb + g * 128 + 8 * c16), b1 = *(const f32x4*)(lnb + g * 128 + 8 * c16 + 4);
            v0 = (v0 - mean) * rstd * a0 + b0; v1 = (v1 - mean) * rstd * a1 + b1;
            LAS bf16_t* d = Zt + (8 * c16) * 136 + r;
            d[0 * 136] = (bf16_t)f2bf(v0[0]); d[1 * 136] = (bf16_t)f2bf(v0[1]); d[2 * 136] = (bf16_t)f2bf(v0[2]); d[3 * 136] = (bf16_t)f2bf(v0[3]);
            d[4 * 136] = (bf16_t)f2bf(v1[0]); d[5 * 136] = (bf16_t)f2bf(v1[1]); d[6 * 136] = (bf16_t)f2bf(v1[2]); d[7 * 136] = (bf16_t)f2bf(v1[3]);
        }
    }
    __syncthreads();
    const int fr = lane & 15, fq = lane >> 4, t = 16 * wave + fr, nks = (wave >> 1) + 1;
    bf16x8 wf[4];
#pragma unroll
    for (int ks = 0; ks < 4; ++ks) {
        u32x4 w = {0u, 0u, 0u, 0u};
        if (ks < nks) {
            const float* wp = sgw + ((size_t)(g * 128 + t)) * 128 + 32 * ks + 8 * fq;
            f32x4 a0 = *(const f32x4*)wp, a1 = *(const f32x4*)(wp + 4);
            const int s0 = 32 * ks + 8 * fq;
#pragma unroll
            for (int i = 0; i < 4; ++i) { if (s0 + i > t) a0[i] = 0.f; if (s0 + 4 + i > t) a1[i] = 0.f; }
            w = pg8::pack8(a0, a1);
        }
        wf[ks] = as_bf8(w);
    }
    const float bs = sgb[g * 128 + t];
    const bf16_t* zu = PROJ + (size_t)(t0 + t) * INW + 1536 + g * 128 + 4 * fq;
    bf16_t* op = YCAT + (size_t)(t0 + t) * D + 1024 + g * 128 + 4 * fq;
#pragma unroll
    for (int cb = 0; cb < 8; ++cb) {
        f32x4 acc = (f32x4){0.f, 0.f, 0.f, 0.f};
#pragma unroll
        for (int ks = 0; ks < 4; ++ks) if (ks < nks) {
            const bf16x8 zf = *(const LAS bf16x8*)(Zt + (16 * cb + fr) * 136 + 32 * ks + 8 * fq);
            acc = __builtin_amdgcn_mfma_f32_16x16x32_bf16(zf, wf[ks], acc, 0, 0, 0);
        }
        const u32x2 zw = *(const u32x2*)(zu + 16 * cb);
        u32x2 w; w.x = cvt_pk_bf16(bf_lo(zw.x) * (acc[0] + bs), bf_hi(zw.x) * (acc[1] + bs)); w.y = cvt_pk_bf16(bf_lo(zw.y) * (acc[2] + bs), bf_hi(zw.y) * (acc[3] + bs));
        *(u32x2*)(op + 16 * cb) = w;
    }
    __syncthreads();
}

template <bool P3> __device__ __forceinline__ void ssm_unit(CArgs* ap, const float* COEF, int l, const bf16_t* PROJ, float* SST, bf16_t* YS, LAS unsigned char* wlds, int unit, int lane) {
    const int c = unit & 63, g = (unit >> 6) & 31, b = unit >> 11;
    const int fr = lane & 15, fq = lane >> 4;
    float pr[4][4], pi[4][4]; bf16x8 bfr[8];
#pragma unroll
    for (int cb = 0; cb < 4; ++cb) {
        const int gp = (l * 32 + g) * 64 + 16 * cb + fr;
        const f32x4 cf = *(const f32x4*)(COEF + (size_t)(g * 64 + 16 * cb + fr) * 4);
        const float abr = cf[0], abi = cf[1];
        pr[cb][0] = abr; pi[cb][0] = abi;
#pragma unroll
        for (int i = 1; i < 4; ++i) { pr[cb][i] = pr[cb][i - 1] * abr - pi[cb][i - 1] * abi; pi[cb][i] = pr[cb][i - 1] * abi + pi[cb][i - 1] * abr; }
        const float cr = cf[2], ci = cf[3];
        u32x4 wre = {0u, 0u, 0u, 0u}, wim = {0u, 0u, 0u, 0u};
        if (fq < 2) {
            const float* br = ap->in[14] + (size_t)gp * 16 + 8 * fq; const float* bi = ap->in[15] + (size_t)gp * 16 + 8 * fq;
            const f32x4 r0 = *(const f32x4*)br, r1 = *(const f32x4*)(br + 4), i0 = *(const f32x4*)bi, i1 = *(const f32x4*)(bi + 4);
            wre = pg8::pack8(cr * r0 - ci * i0, cr * r1 - ci * i1); wim = pg8::pack8(cr * i0 + ci * r0, cr * i1 + ci * r1);
        }
        bfr[cb] = as_bf8(wre); bfr[cb + 4] = as_bf8(wim);
    }
    bf16x8 cmf[4]; float dsk = 0.f;
    if (P3) {
#pragma unroll
        for (int ks = 0; ks < 4; ++ks) {
            const int k0 = 32 * ks + 8 * fq;
            const float* src = (ks < 2 ? ap->in[16] : ap->in[17]) + ((size_t)(l * 32 + g) * 16 + fr) * 64 + (ks < 2 ? k0 : k0 - 64);
            f32x4 c0 = *(const f32x4*)src, c1 = *(const f32x4*)(src + 4);
            if (ks >= 2) { c0 = -c0; c1 = -c1; }
            cmf[ks] = as_bf8(pg8::pack8(c0, c1));
        }
        dsk = ap->in[18][l * 512 + g * 16 + fr];
    }
    float hr[4], hi[4];
#pragma unroll
    for (int cb = 0; cb < 4; ++cb) { hr[cb] = 0.f; hi[cb] = 0.f; }
    if (P3) {
        float tr[4], ti[4];
#pragma unroll
        for (int cb = 0; cb < 4; ++cb) { tr[cb] = pr[cb][3]; ti[cb] = pi[cb][3];
#pragma unroll
            for (int k = 0; k < 5; ++k) { const float nr = tr[cb] * tr[cb] - ti[cb] * ti[cb], ni = 2.f * tr[cb] * ti[cb]; tr[cb] = nr; ti[cb] = ni; } }
        const float* sp = SST + ((size_t)(unit - c) * 64 + fr) * 2;
        for (int cc = 0; cc < c; ++cc) {
#pragma unroll
            for (int cb = 0; cb < 4; ++cb) { const float2 s = *(const float2*)(sp + (size_t)cc * 128 + 32 * cb);
                const float nr = tr[cb] * hr[cb] - ti[cb] * hi[cb] + s.x, ni = tr[cb] * hi[cb] + ti[cb] * hr[cb] + s.y; hr[cb] = nr; hi[cb] = ni; }
        }
    }
    const size_t row0 = (size_t)(b * SEQ + c * 128);
    LAS bf16_t* Hs = (LAS bf16_t*)wlds;
    u32x4 uwn = {0u, 0u, 0u, 0u};
    if (fq < 2) uwn = *(const u32x4*)(PROJ + (row0 + fr) * INW + 2560 + g * 16 + 8 * fq);
#pragma unroll 1
    for (int blk = 0; blk < 8; ++blk) {
        const u32x4 uw = uwn;
        if (fq < 2) uwn = *(const u32x4*)(PROJ + (row0 + 16 * (blk < 7 ? blk + 1 : blk) + fr) * INW + 2560 + g * 16 + 8 * fq);
        const bf16x8 uf = as_bf8(uw);
        f32x4 bu[8];
#pragma unroll
        for (int k = 0; k < 8; ++k) bu[k] = __builtin_amdgcn_mfma_f32_16x16x32_bf16(uf, bfr[k], (f32x4){0.f, 0.f, 0.f, 0.f}, 0, 0, 0);
#pragma unroll
        for (int cb = 0; cb < 4; ++cb) {
            const float ar = pr[cb][0], ai = pi[cb][0], a4r = pr[cb][3], a4i = pi[cb][3];
            float lr_[4], li_[4];
            lr_[0] = bu[cb][0]; li_[0] = bu[cb + 4][0];
#pragma unroll
            for (int i = 1; i < 4; ++i) { lr_[i] = ar * lr_[i - 1] - ai * li_[i - 1] + bu[cb][i]; li_[i] = ar * li_[i - 1] + ai * lr_[i - 1] + bu[cb + 4][i]; }
            float cr = hr[cb], ci = hi[cb];
#pragma unroll
            for (int j = 0; j < 3; ++j) {
                const float er = __shfl(lr_[3], fr + 16 * j), ei = __shfl(li_[3], fr + 16 * j);
                const float nr = a4r * cr - a4i * ci + er, ni = a4r * ci + a4i * cr + ei;
                if (j < fq) { cr = nr; ci = ni; }
            }
            float h_r[4], h_i[4];
#pragma unroll
            for (int i = 0; i < 4; ++i) { h_r[i] = lr_[i] + pr[cb][i] * cr - pi[cb][i] * ci; h_i[i] = li_[i] + pr[cb][i] * ci + pi[cb][i] * cr; }
            hr[cb] = __shfl(h_r[3], fr + 48); hi[cb] = __shfl(h_i[3], fr + 48);
            if (P3) {
#pragma unroll
                for (int i = 0; i < 4; ++i) { Hs[(4 * fq + i) * 136 + 16 * cb + fr] = (bf16_t)f2bf(h_r[i]); Hs[(4 * fq + i) * 136 + 64 + 16 * cb + fr] = (bf16_t)f2bf(h_i[i]); }
            }
        }
        if (P3) {
            f32x4 y = (f32x4){0.f, 0.f, 0.f, 0.f};
            asm volatile("s_waitcnt lgkmcnt(0)" ::: "memory");
            bf16x8 hf[4];
#pragma unroll
            for (int ks = 0; ks < 4; ++ks) hf[ks] = *(const LAS bf16x8*)(Hs + fr * 136 + 32 * ks + 8 * fq);
            asm volatile("s_waitcnt lgkmcnt(0)" ::: "memory");
#pragma unroll
            for (int ks = 0; ks < 4; ++ks) y = __builtin_amdgcn_mfma_f32_16x16x32_bf16(hf[ks], cmf[ks], y, 0, 0, 0);
#pragma unroll
            for (int i = 0; i < 4; ++i) {
                const size_t row = row0 + 16 * blk + 4 * fq + i;
                const float uu = __uint_as_float(((unsigned)PROJ[row * INW + 2560 + g * 16 + fr]) << 16);
                YS[row * 512 + g * 16 + fr] = (bf16_t)f2bf(gelu_t(y[i] + dsk * uu));
            }
        }
    }
    if (!P3) { if (fq == 0) {
#pragma unroll
        for (int cb = 0; cb < 4; ++cb) *(float2*)(SST + ((size_t)unit * 64 + 16 * cb + fr) * 2) = make_float2(hr[cb], hi[cb]); } }
}

__device__ __forceinline__ void ssm_coef_phase(CArgs* ap, int l, float* COEF, int gw, int lane) {
    if (gw < 32) {
        const int g = gw, p = lane;
        const float dt = expf(ap->in[13][l * 32 + g]);
        const float lr = ap->in[11][(l * 32 + g) * 64 + p], li = ap->in[12][(l * 32 + g) * 64 + p];
        const float x = lr * dt, y = li * dt;
        const float ex = expf(x), cs = cosf(y), sn = sinf(y), sh = sinf(0.5f * y);
        const float abr = ex * cs, abi = ex * sn;
        const float nr = expm1f(x) * cs - 2.f * sh * sh, ni = abi;
        const float den = 1.f / (lr * lr + li * li);
        *(f32x4*)(COEF + (size_t)(g * 64 + p) * 4) = (f32x4){abr, abi, (nr * lr + ni * li) * den, (ni * lr - nr * li) * den};
    }
}
__device__ __forceinline__ void ssm_setup(CArgs* ap, const float* COEF, int l, int g, int p, float& abr, float& abi, float (&bbr)[16], float (&bbi)[16]) {
    const f32x4 cf = *(const f32x4*)(COEF + (size_t)(g * 64 + p) * 4);
    abr = cf[0]; abi = cf[1];
    const float cr = cf[2], ci = cf[3];
    const float* br = ap->in[14] + ((size_t)(l * 32 + g) * 64 + p) * 16; const float* bi = ap->in[15] + ((size_t)(l * 32 + g) * 64 + p) * 16;
#pragma unroll
    for (int q = 0; q < 4; ++q) { const f32x4 r4 = *(const f32x4*)(br + 4 * q), i4 = *(const f32x4*)(bi + 4 * q);
#pragma unroll
        for (int i = 0; i < 4; ++i) { bbr[4 * q + i] = cr * r4[i] - ci * i4[i]; bbi[4 * q + i] = cr * i4[i] + ci * r4[i]; } }
}
__device__ __forceinline__ void load_u16(const bf16_t* p, float (&u)[16]) {
    const u32x4 w0 = ((const u32x4*)p)[0], w1 = ((const u32x4*)p)[1];
    u[0] = bf_lo(w0.x); u[1] = bf_hi(w0.x); u[2] = bf_lo(w0.y); u[3] = bf_hi(w0.y); u[4] = bf_lo(w0.z); u[5] = bf_hi(w0.z); u[6] = bf_lo(w0.w); u[7] = bf_hi(w0.w);
    u[8] = bf_lo(w1.x); u[9] = bf_hi(w1.x); u[10] = bf_lo(w1.y); u[11] = bf_hi(w1.y); u[12] = bf_lo(w1.z); u[13] = bf_hi(w1.z); u[14] = bf_lo(w1.w); u[15] = bf_hi(w1.w);
}
__device__ __forceinline__ void ssm_pass1(CArgs* ap, const float* COEF, int l, const bf16_t* PROJ, float* SST, int unit, int lane) {
    const int c = unit & 63, g = (unit >> 6) & 31, b = unit >> 11;
    float abr, abi, bbr[16], bbi[16];
    ssm_setup(ap, COEF, l, g, lane, abr, abi, bbr, bbi);
    const bf16_t* up = PROJ + (size_t)(b * SEQ + c * 128) * INW + 2560 + g * 16;
    float hr = 0.f, hi = 0.f;
#pragma unroll 4
    for (int t = 0; t < 128; ++t) {
        float u[16]; load_u16(up + (size_t)t * INW, u);
        float br = 0.f, bi = 0.f;
#pragma unroll
        for (int k = 0; k < 16; ++k) { br += bbr[k] * u[k]; bi += bbi[k] * u[k]; }
        const float nr = abr * hr - abi * hi + br, ni = abr * hi + abi * hr + bi; hr = nr; hi = ni;
    }
    *(float2*)(SST + ((size_t)unit * 64 + lane) * 2) = make_float2(hr, hi);
}
template <int HALFN> __device__ __forceinline__ void rs_stage(float (&v)[64], int lane) {
    if constexpr (HALFN == 32 || HALFN == 16) {
#pragma unroll
        for (int i = 0; i < HALFN; ++i) {
            float a = v[i], b = v[i + HALFN];
            if constexpr (HALFN == 32) asm volatile("s_nop 1\n\tv_permlane32_swap_b32 %0, %1" : "+v"(a), "+v"(b));
            else asm volatile("s_nop 1\n\tv_permlane16_swap_b32 %0, %1" : "+v"(a), "+v"(b));
            v[i] = a + b;
        }
    } else {
        const bool bit = (lane & HALFN) != 0;
#pragma unroll
        for (int i = 0; i < HALFN; ++i) { const float keep = bit ? v[i + HALFN] : v[i], send = bit ? v[i] : v[i + HALFN]; v[i] = keep + __shfl_xor(send, HALFN); }
    }
}
__device__ __forceinline__ void ssm_pass3(CArgs* ap, const float* COEF, int l, const bf16_t* PROJ, const float* SST, bf16_t* YS, int unit, int lane) {
    const int c = unit & 63, g = (unit >> 6) & 31, b = unit >> 11;
    float abr, abi, bbr[16], bbi[16];
    ssm_setup(ap, COEF, l, g, lane, abr, abi, bbr, bbi);
    typedef float f32x2v __attribute__((ext_vector_type(2)));
    f32x2v cre2[8], cim2[8], bb2[16];
#pragma unroll
    for (int k = 0; k < 8; ++k) { cre2[k] = (f32x2v){ap->in[16][((size_t)(l * 32 + g) * 16 + 2 * k) * 64 + lane], ap->in[16][((size_t)(l * 32 + g) * 16 + 2 * k + 1) * 64 + lane]};
        cim2[k] = (f32x2v){ap->in[17][((size_t)(l * 32 + g) * 16 + 2 * k) * 64 + lane], ap->in[17][((size_t)(l * 32 + g) * 16 + 2 * k + 1) * 64 + lane]}; }
#pragma unroll
    for (int k = 0; k < 16; ++k) bb2[k] = (f32x2v){bbr[k], bbi[k]};
    const float dsk = ap->in[18][l * 512 + g * 16 + (lane & 15)];
    float tr = abr, ti = abi;
#pragma unroll
    for (int k = 0; k < 7; ++k) { const float nr = tr * tr - ti * ti, ni = 2.f * tr * ti; tr = nr; ti = ni; }
    float hr = 0.f, hi = 0.f;
    const float* sp = SST + ((size_t)(unit - c) * 64 + lane) * 2;
    int cc = 0;
    for (; cc + 8 <= c; cc += 8) {
        float2 s8[8];
#pragma unroll
        for (int j = 0; j < 8; ++j) s8[j] = *(const float2*)(sp + (size_t)(cc + j) * 128);
#pragma unroll
        for (int j = 0; j < 8; ++j) { const float nr = tr * hr - ti * hi + s8[j].x, ni = tr * hi + ti * hr + s8[j].y; hr = nr; hi = ni; }
    }
    for (; cc < c; ++cc) { const float2 s = *(const float2*)(sp + (size_t)cc * 128); const float nr = tr * hr - ti * hi + s.x, ni = tr * hi + ti * hr + s.y; hr = nr; hi = ni; }
    const size_t row0 = (size_t)(b * SEQ + c * 128);
    const bf16_t* up = PROJ + row0 * INW + 2560 + g * 16;
    u32x4 wn[8];
#pragma unroll
    for (int tt = 0; tt < 4; ++tt) { wn[2 * tt] = ((const u32x4*)(up + (size_t)tt * INW))[0]; wn[2 * tt + 1] = ((const u32x4*)(up + (size_t)tt * INW))[1]; }
    const int ott = lane >> 4, ok = lane & 15;
    unsigned short uun = up[(size_t)ott * INW + ok];
#pragma unroll 1
    for (int t = 0; t < 128; t += 4) {
        float v[64];
        u32x4 wc[8];
#pragma unroll
        for (int j = 0; j < 8; ++j) wc[j] = wn[j];
        const unsigned short uuc = uun;
        const int tn = (t + 4 < 128) ? t + 4 : t;
#pragma unroll
        for (int tt = 0; tt < 4; ++tt) { wn[2 * tt] = ((const u32x4*)(up + (size_t)(tn + tt) * INW))[0]; wn[2 * tt + 1] = ((const u32x4*)(up + (size_t)(tn + tt) * INW))[1]; }
        uun = up[(size_t)(tn + ott) * INW + ok];
#pragma unroll
        for (int tt = 0; tt < 4; ++tt) {
            const u32x4 w0 = wc[2 * tt], w1 = wc[2 * tt + 1];
            float u[16];
            u[0] = bf_lo(w0.x); u[1] = bf_hi(w0.x); u[2] = bf_lo(w0.y); u[3] = bf_hi(w0.y); u[4] = bf_lo(w0.z); u[5] = bf_hi(w0.z); u[6] = bf_lo(w0.w); u[7] = bf_hi(w0.w);
            u[8] = bf_lo(w1.x); u[9] = bf_hi(w1.x); u[10] = bf_lo(w1.y); u[11] = bf_hi(w1.y); u[12] = bf_lo(w1.z); u[13] = bf_hi(w1.z); u[14] = bf_lo(w1.w); u[15] = bf_hi(w1.w);
            f32x2v b2 = (f32x2v){0.f, 0.f};
#pragma unroll
            for (int k = 0; k < 16; ++k) b2 += bb2[k] * u[k];
            const float nr = abr * hr - abi * hi + b2.x, ni = abr * hi + abi * hr + b2.y; hr = nr; hi = ni;
#pragma unroll
            for (int k = 0; k < 8; ++k) { const f32x2v p = cre2[k] * hr - cim2[k] * hi; v[tt * 16 + 2 * k] = p.x; v[tt * 16 + 2 * k + 1] = p.y; }
        }
        rs_stage<32>(v, lane); rs_stage<16>(v, lane); rs_stage<8>(v, lane); rs_stage<4>(v, lane); rs_stage<2>(v, lane); rs_stage<1>(v, lane);
        const float uu = __uint_as_float(((unsigned)uuc) << 16);
        const float y = gelu_t(v[0] + dsk * uu);
        YS[(row0 + t + ott) * 512 + g * 16 + ok] = (bf16_t)f2bf(y);
    }
}

__device__ __forceinline__ void ssm_pass3h(CArgs* ap, const float* COEF, int l, const bf16_t* PROJ, const float* SST, bf16_t* YS, LAS unsigned char* wlds, int unit, int lane) {
    const int c = unit & 63, g = (unit >> 6) & 31, b = unit >> 11;
    const int fr = lane & 15, fq = lane >> 4;
    float abr, abi, bbr[16], bbi[16];
    ssm_setup(ap, COEF, l, g, lane, abr, abi, bbr, bbi);
    typedef __bf16 bf16x2v __attribute__((ext_vector_type(2)));
    unsigned bbr2[8], bbi2[8];
#pragma unroll
    for (int k = 0; k < 8; ++k) { bbr2[k] = cvt_pk_bf16(bbr[2 * k], bbr[2 * k + 1]); bbi2[k] = cvt_pk_bf16(bbi[2 * k], bbi[2 * k + 1]); }
    float cmB[32];
#pragma unroll
    for (int j = 0; j < 8; ++j) {
        const int k0 = 16 * j + 4 * fq;
        const float* src = (j < 4 ? ap->in[16] : ap->in[17]) + ((size_t)(l * 32 + g) * 16 + fr) * 64 + (j < 4 ? k0 : k0 - 64);
        const f32x4 c4 = *(const f32x4*)src;
#pragma unroll
        for (int r = 0; r < 4; ++r) cmB[4 * j + r] = (j < 4) ? c4[r] : -c4[r];
    }
    const float dsk = ap->in[18][l * 512 + g * 16 + fr];
    float tr = abr, ti = abi;
#pragma unroll
    for (int k = 0; k < 7; ++k) { const float nr = tr * tr - ti * ti, ni = 2.f * tr * ti; tr = nr; ti = ni; }
    float hr = 0.f, hi = 0.f;
    const float* sp = SST + ((size_t)(unit - c) * 64 + lane) * 2;
    int cc = 0;
    for (; cc + 8 <= c; cc += 8) {
        float2 s8[8];
#pragma unroll
        for (int j = 0; j < 8; ++j) s8[j] = *(const float2*)(sp + (size_t)(cc + j) * 128);
#pragma unroll
        for (int j = 0; j < 8; ++j) { const float nr = tr * hr - ti * hi + s8[j].x, ni = tr * hi + ti * hr + s8[j].y; hr = nr; hi = ni; }
    }
    for (; cc < c; ++cc) { const float2 s = *(const float2*)(sp + (size_t)cc * 128); const float nr = tr * hr - ti * hi + s.x, ni = tr * hi + ti * hr + s.y; hr = nr; hi = ni; }
    const size_t row0 = (size_t)(b * SEQ + c * 128);
    const bf16_t* up = PROJ + row0 * INW + 2560 + g * 16;
    LAS float* Hf = (LAS float*)wlds;
    u32x4 wn[8];
#pragma unroll
    for (int tt = 0; tt < 4; ++tt) { wn[2 * tt] = ((const u32x4*)(up + (size_t)tt * INW))[0]; wn[2 * tt + 1] = ((const u32x4*)(up + (size_t)tt * INW))[1]; }
#pragma unroll 1
    for (int blk = 0; blk < 8; ++blk) {
        unsigned short uq[4];
#pragma unroll
        for (int i = 0; i < 4; ++i) uq[i] = up[(size_t)(16 * blk + 4 * fq + i) * INW + fr];
#pragma unroll 1
        for (int q = 0; q < 4; ++q) {
            const int t = 16 * blk + 4 * q;
            u32x4 wc[8];
#pragma unroll
            for (int j = 0; j < 8; ++j) wc[j] = wn[j];
            const int tn = (t + 4 < 128) ? t + 4 : t;
#pragma unroll
            for (int tt = 0; tt < 4; ++tt) { wn[2 * tt] = ((const u32x4*)(up + (size_t)(tn + tt) * INW))[0]; wn[2 * tt + 1] = ((const u32x4*)(up + (size_t)(tn + tt) * INW))[1]; }
#pragma unroll
            for (int tt = 0; tt < 4; ++tt) {
                const u32x4 w0 = wc[2 * tt], w1 = wc[2 * tt + 1];
                const unsigned u2[8] = {w0.x, w0.y, w0.z, w0.w, w1.x, w1.y, w1.z, w1.w};
                float br_ = 0.f, bi_ = 0.f;
#pragma unroll
                for (int k = 0; k < 8; ++k) { br_ = __builtin_amdgcn_fdot2_f32_bf16(__builtin_bit_cast(bf16x2v, bbr2[k]), __builtin_bit_cast(bf16x2v, u2[k]), br_, false);
                                               bi_ = __builtin_amdgcn_fdot2_f32_bf16(__builtin_bit_cast(bf16x2v, bbi2[k]), __builtin_bit_cast(bf16x2v, u2[k]), bi_, false); }
                const float nr = abr * hr - abi * hi + br_, ni = abr * hi + abi * hr + bi_; hr = nr; hi = ni;
                Hf[(4 * q + tt) * 132 + lane] = hr; Hf[(4 * q + tt) * 132 + 64 + lane] = hi;
            }
        }
        asm volatile("s_waitcnt lgkmcnt(0)" ::: "memory");
        f32x4 y = (f32x4){0.f, 0.f, 0.f, 0.f};
#pragma unroll
        for (int j = 0; j < 8; ++j) {
            const f32x4 a4 = *(const LAS f32x4*)(Hf + fr * 132 + 16 * j + 4 * fq);
#pragma unroll
            for (int r = 0; r < 4; ++r) y = __builtin_amdgcn_mfma_f32_16x16x4f32(a4[r], cmB[4 * j + r], y, 0, 0, 0);
        }
        asm volatile("s_waitcnt lgkmcnt(0)" ::: "memory");
#pragma unroll
        for (int i = 0; i < 4; ++i) {
            const size_t row = row0 + 16 * blk + 4 * fq + i;
            YS[row * 512 + g * 16 + fr] = (bf16_t)f2bf(gelu_t(y[i] + dsk * __uint_as_float(((unsigned)uq[i]) << 16)));
        }
    }
}

__device__ __forceinline__ void fixup_phase(const float* RAW, bf16_t* ACT, const float* cw, const float* cb, int gtid, int nthr) {
    constexpr int NC4 = DFF / 4;
    for (int it = gtid; it < 256 * 2 * NC4; it += nthr) {
        const int c = (it % NC4) * 4, r = (it / NC4) & 1, sl = it / (2 * NC4);
        const int tc = (c >> 7) * 256 + (c & 127);
        const float* base = RAW + (size_t)sl * 4 * NUP + tc; const float* prev = base - (size_t)4 * NUP;
        const bool first = (sl & 127) == 0;
        const f32x4 z = (f32x4){0.f, 0.f, 0.f, 0.f};
        const f32x4 g0 = *(const f32x4*)(base + (size_t)r * NUP), v0 = *(const f32x4*)(base + (size_t)r * NUP + 128);
        const f32x4 g63 = first ? z : *(const f32x4*)(prev + (size_t)3 * NUP), v63 = first ? z : *(const f32x4*)(prev + (size_t)3 * NUP + 128);
        f32x4 g1, g2, v1, v2;
        if (r == 1) { g1 = *(const f32x4*)base; v1 = *(const f32x4*)(base + 128); g2 = g63; v2 = v63; }
        else { g1 = g63; v1 = v63; g2 = first ? z : *(const f32x4*)(prev + (size_t)2 * NUP); v2 = first ? z : *(const f32x4*)(prev + (size_t)2 * NUP + 128); }
        const f32x4 cgt = *(const f32x4*)(cb + c) + *(const f32x4*)(cw + c) * g0 + *(const f32x4*)(cw + NUP + c) * g1 + *(const f32x4*)(cw + 2 * NUP + c) * g2;
        const f32x4 cvl = *(const f32x4*)(cb + DFF + c) + *(const f32x4*)(cw + DFF + c) * v0 + *(const f32x4*)(cw + NUP + DFF + c) * v1 + *(const f32x4*)(cw + 2 * NUP + DFF + c) * v2;
        const f32x4 o = pg8::gelu4(cgt) * cvl;
        u32x2 w; w.x = cvt_pk_bf16(o[0], o[1]); w.y = cvt_pk_bf16(o[2], o[3]);
        *(u32x2*)(ACT + (size_t)(64 * sl + r) * DFF + c) = w;
    }
}

#define XB_TMO      128
#define XB_XCNT(j)  (256  + 64 * (j))
#define XB_XSUB(j)  (1280 + 64 * (j))
#define XB_XGEN(j)  (2304 + 64 * (j))
#define XB_TOP      3328
#define XB_TOPGEN   3392
#define XCD_BAR_WORDS 3456
#define XB_SPIN_CAP (1u << 18)

__device__ __forceinline__ unsigned xb_ld(unsigned* p)              { return __hip_atomic_load(p, __ATOMIC_RELAXED, __HIP_MEMORY_SCOPE_AGENT); }
__device__ __forceinline__ unsigned xb_add(unsigned* p, unsigned v) { return __hip_atomic_fetch_add(p, v, __ATOMIC_RELAXED, __HIP_MEMORY_SCOPE_AGENT); }
__device__ __forceinline__ unsigned xb_xcc_id() { return (unsigned)__builtin_amdgcn_s_getreg((3 << 11) | 20) & 0xFu; }
#define XB_SPIN(cond, bar) do { unsigned _sp = 0; while (cond) { __builtin_amdgcn_s_sleep(1); \
    if ((++_sp & 255u) == 0u) { if (xb_ld(&(bar)[XB_TMO])) break; if (_sp > XB_SPIN_CAP) { atomicAdd(&(bar)[XB_TMO], 1u); break; } } } } while (0)

struct XcdBarrier {
    unsigned* bar; unsigned x;
    volatile LAS unsigned* st;
};

__device__ __forceinline__ XcdBarrier xcd_barrier_post(unsigned* bar, volatile LAS unsigned* st) {
    XcdBarrier b; b.bar = bar; b.x = xb_xcc_id(); b.st = st;
    if (threadIdx.x == 0) (void)xb_add(&bar[XB_XCNT(b.x)], 1u);
    return b;
}
__device__ __forceinline__ void xcd_barrier_complete(unsigned* bar, unsigned x, unsigned& nloc, unsigned& nx) {
    const unsigned G = gridDim.x * gridDim.y * gridDim.z;
    unsigned sum, cnt, mine, sp = 0u;
    for (;;) {
        sum = 0u; cnt = 0u; mine = 0u;
#pragma unroll
        for (unsigned j = 0; j < 16; ++j) { const unsigned c = xb_ld(&bar[XB_XCNT(j)]); sum += c; cnt += (c > 0u) ? 1u : 0u; mine = (j == x) ? c : mine; }
        if (sum == G) break;
        __builtin_amdgcn_s_sleep(1);
        if ((++sp & 255u) == 0u) { if (xb_ld(&bar[XB_TMO])) break; if (sp > XB_SPIN_CAP) { atomicAdd(&bar[XB_TMO], 1u); break; } }
    }
    nloc = mine > 0u ? mine : 1u; nx = cnt > 0u ? cnt : 1u;
}

__device__ __forceinline__ void xcd_barrier(const XcdBarrier& b) {
    asm volatile("s_waitcnt vmcnt(0)" ::: "memory");
    __syncthreads();
    if (threadIdx.x == 0) {
        unsigned* bar = b.bar;
        __builtin_amdgcn_s_waitcnt(0);
        unsigned nloc = b.st[0], nx = b.st[1];
        if (nloc == 0u) { xcd_barrier_complete(bar, b.x, nloc, nx); b.st[0] = nloc; b.st[1] = nx; }
        const unsigned old = xb_add(&bar[XB_XSUB(b.x)], 1u);
        const unsigned gen = old / nloc;
        if (old + 1u == (gen + 1u) * nloc) {
            __builtin_amdgcn_fence(__ATOMIC_RELEASE, "agent");
            asm volatile("s_waitcnt vmcnt(0)" ::: "memory");
            const unsigned og = xb_add(&bar[XB_TOP], 1u);
            const unsigned tg = og / nx;
            if (og + 1u == (tg + 1u) * nx) xb_add(&bar[XB_TOPGEN], 1u);
            else XB_SPIN(xb_ld(&bar[XB_TOPGEN]) == tg, bar);
            __builtin_amdgcn_fence(__ATOMIC_ACQUIRE, "agent");
            xb_add(&bar[XB_XGEN(b.x)], 1u);
            asm volatile("s_waitcnt vmcnt(0)" ::: "memory");
        } else {
            XB_SPIN(xb_ld(&bar[XB_XGEN(b.x)]) == gen, bar);
            __builtin_amdgcn_fence(__ATOMIC_ACQUIRE, "agent");
            asm volatile("s_waitcnt vmcnt(0)" ::: "memory");
        }
    }
    __syncthreads();
}

#ifdef ONLY_MODE
#define ONLY_MODE_OK(m) ((m) == ONLY_MODE)
#else
#define ONLY_MODE_OK(m) true
#endif
#ifndef PG8_SP2
#define PG8_SP2 true
#endif
#ifndef PG8_ALIGN
#define PG8_ALIGN true
#endif
template <int MODE> __device__ __forceinline__ void run_gemm(LAS unsigned char* lds, const bf16_t* A, int lda, const bf16_t* Bt, int Mr, int N, int K, const pg8::Epi<MODE>& E, int wave_in) {
    pg8::Gemm g{A, Bt, Mr, N, K, lda}; pg8::StaticOrder S; S.init(Mr, N, (int)gridDim.x, (int)blockIdx.x);
#if !defined(NO_GEMM) && (!defined(ONLY_MODE) || 1)
    if (ONLY_MODE_OK(MODE)) pg8::gemm_phase<pg8::Epi<MODE>, pg8::StaticOrder, PG8_ALIGN, PG8_SP2>(lds, g, S, E, wave_in);
#endif
}

__global__ void __launch_bounds__(NTHR, 2) fwd(Args a) {
    extern __shared__ __attribute__((aligned(16))) unsigned char lds_raw[];
    LAS unsigned char* lds = (LAS unsigned char*)lds_raw;
    cg::grid_group grid = cg::this_grid();
    const int ph_lo = a.ph_lo, ph_hi = a.ph_hi;
    const int wave_s = __builtin_amdgcn_readfirstlane((int)threadIdx.x >> 6);
    constexpr int MISC_OFF = 139264;
    if (threadIdx.x < 16) ((LAS unsigned*)(lds + MISC_OFF))[threadIdx.x] = 0u;
    __syncthreads();
    (void)xcd_barrier_post((unsigned*)(a.ws + WS_BAR), (volatile LAS unsigned*)(lds + MISC_OFF) + 8);
    for (int ph = ph_lo; ph < ph_hi; ++ph) {
        CArgs* ap = (CArgs*)__builtin_amdgcn_kernarg_segment_ptr();
        asm volatile("" : "+s"(ap));
        int tid_ = wave_s * 64 + (int)__builtin_amdgcn_mbcnt_hi(~0u, __builtin_amdgcn_mbcnt_lo(~0u, 0u)); asm volatile("" : "+v"(tid_));
        const int tid = tid_, lane = tid & 63, wave = wave_s;
        const int G = gridDim.x, gw = blockIdx.x * NWAVES + wave, NGW = G * NWAVES;
        unsigned char* ws = ap->ws;
        bf16_t* XB = (bf16_t*)(ws + WS_XB); bf16_t* MRG = (bf16_t*)(ws + WS_MRG);
        bf16_t* PROJ = (bf16_t*)(ws + WS_PROJ); bf16_t* YCAT = (bf16_t*)(ws + WS_YCAT); bf16_t* YS = (bf16_t*)(ws + WS_YS); float* SST = (float*)(ws + WS_SST);
        bf16_t* ACT = (bf16_t*)(ws + WS_ACT); float* RAW = (float*)(ws + WS_RAW);
        {
            const int l = ph / PPL, sp = ph % PPL;
            const unsigned char* wl = ws + WS_W;
            float* SS = (float*)(ws + WS_SS);
            float* COEF = (float*)(ws + WS_COEF);
            if (sp == 0) { ssm_coef_phase(ap, l, COEF, gw, lane); convert_phase(ap, l, lds, gw, NGW, wave, lane); if (l == 0) xb_phase(ap->in[0], XB, SS, gw, NGW, lane); }
            else if (sp == 1) { pg8::Epi<pg8::EP_INPROJ> E{PROJ, INW, ap->in[3] + l * 6144, nullptr, 0, nullptr, nullptr, SS + (size_t)(2 * l) * M, nullptr, nullptr}; run_gemm<pg8::EP_INPROJ>(lds, XB, D, (const bf16_t*)(wl + O_WIN), M, INW, D, E, wave); }
            else if (sp == 2) {
                for (int u = blockIdx.x; u < 256; u += G) attn_unit(lds, PROJ, YCAT, ap->in[4] + l * 128, ap->in[5] + l * 128, ap->in[6] + l * 8, u, tid, wave, lane);
                for (int u = blockIdx.x; u < 512; u += G) sg_unit(lds, PROJ, YCAT, ap->in[7] + l * 512, ap->in[8] + l * 512, ap->in[9] + (size_t)l * 4 * 128 * 128, ap->in[10] + l * 512, u, tid, wave, lane);
                for (int u = gw; u < 4096; u += NGW) ssm_unit<false>(ap, COEF, l, PROJ, SST, YS, lds + wave * 4352, u, lane);
            }
            else if (sp == 3) { for (int u = gw; u < 4096; u += NGW) ssm_pass3h(ap, COEF, l, PROJ, SST, YS, lds + wave * 8448, u, lane); }
            else if (sp == 4) { pg8::Epi<pg8::EP_GLU> E{YCAT + 1536, D, ap->in[20] + l * 512, YS, 512, nullptr}; run_gemm<pg8::EP_GLU>(lds, YS, 512, (const bf16_t*)(wl + O_WGLU), M, 512, 512, E, wave); }
            else if (sp == 5) {
                { pg8::Epi<pg8::EP_MERGE0> E{MRG, D, nullptr, PROJ + 3072, INW, nullptr}; run_gemm<pg8::EP_MERGE0>(lds, YCAT, D, (const bf16_t*)(wl + O_WA), M, D, 1024, E, wave); }
#pragma unroll 1
                for (int j = 1; j < 3; ++j) { pg8::Epi<pg8::EP_MERGE1> E{MRG, D, nullptr, PROJ + 3072 + j * D, INW, nullptr};
                    run_gemm<pg8::EP_MERGE1>(lds, YCAT + 512 + 512 * j, D, (const bf16_t*)(wl + (j == 1 ? O_WSG : O_WSSM)), M, D, 512, E, wave); }
            }
            else if (sp == 7) { pg8::Epi<pg8::EP_UPCONV> E{ACT, DFF, ap->in[27] + (size_t)l * 3 * NUP, nullptr, 0, ap->in[28] + (size_t)l * NUP, RAW, SS + (size_t)(2 * l + 1) * M, nullptr, nullptr};
                run_gemm<pg8::EP_UPCONV>(lds, XB, D, (const bf16_t*)(wl + O_WUP), M, NUP, D, E, wave); }
            else if (sp == 8) fixup_phase(RAW, ACT, ap->in[27] + (size_t)l * 3 * NUP, ap->in[28] + (size_t)l * NUP, blockIdx.x * NTHR + tid, G * NTHR);
            else {
                const bf16_t* A; const bf16_t* Bt; int K; float* sso;
                if (sp == 6) { A = MRG; Bt = (const bf16_t*)(wl + O_WOUT); K = D; sso = SS + (size_t)(2 * l + 1) * M; }
                else { A = ACT; Bt = (const bf16_t*)(wl + O_WDN); K = DFF; sso = (l == 0) ? SS + (size_t)2 * M : nullptr; }
                pg8::Epi<pg8::EP_RESID> E{sso ? nullptr : ap->out, D, nullptr, nullptr, 0, nullptr, nullptr, nullptr, XB, sso};
                run_gemm<pg8::EP_RESID>(lds, A, K, Bt, M, D, K, E, wave);
            }
        }
        if (ph + 1 < ph_hi) {
            if (ph_hi < 0) grid.sync();
            { XcdBarrier bar; bar.bar = (unsigned*)(ws + WS_BAR); bar.x = xb_xcc_id(); bar.st = (volatile LAS unsigned*)(lds + MISC_OFF) + 8; xcd_barrier(bar); }
        }
    }
}
}

extern "C" void kernel_launch(void* const* d_in, const int* in_sizes, int n_in, void* d_out, int out_size, void* d_ws, size_t ws_size, hipStream_t stream) {
    using namespace mk;
    static int grid = 0;
    if (grid == 0) {
        if (n_in != 30 || out_size != M * D || ws_size < WS_END) { fprintf(stderr, "kernel_launch: unexpected problem (n_in %d out %d ws %zu need %zu)\n", n_in, out_size, ws_size, (size_t)WS_END); grid = -1; return; }
        int dev = 0, cus = 0, per_cu = 0;
        (void)hipGetDevice(&dev); (void)hipDeviceGetAttribute(&cus, hipDeviceAttributeMultiprocessorCount, dev);
        (void)hipFuncSetAttribute((const void*)fwd, hipFuncAttributeMaxDynamicSharedMemorySize, LDS_BYTES);
        if (hipOccupancyMaxActiveBlocksPerMultiprocessor(&per_cu, (const void*)fwd, NTHR, LDS_BYTES) != hipSuccess || per_cu < 1) { fprintf(stderr, "kernel_launch: occupancy query gave %d\n", per_cu); per_cu = 1; }
        (void)hipGetLastError();
        grid = cus * 1;
    }
    if (grid < 0) return;
    Args a{};
    for (int i = 0; i < 30; ++i) a.in[i] = (const float*)d_in[i];
    a.out = (float*)d_out; a.ws = (unsigned char*)d_ws;
    (void)hipMemsetAsync((unsigned char*)d_ws + WS_SS, 0, (size_t)1 * MiB, stream);
#if MK_MULTI
    for (int p = 0; p < NPH; ++p) { a.ph_lo = p; a.ph_hi = p + 1; hipLaunchKernelGGL(fwd, dim3(grid), dim3(NTHR), LDS_BYTES, stream, a); }
#else
    a.ph_lo = 0; a.ph_hi = NPH;
    void* args[] = {&a};
    hipError_t e = hipLaunchCooperativeKernel((const void*)fwd, dim3(grid), dim3(NTHR), args, LDS_BYTES, stream);
    if (e != hipSuccess) fprintf(stderr, "cooperative launch failed: %s (grid %d)\n", hipGetErrorString(e), grid);
#endif
}
```
